# Optimizing an MI355X kernel written in HIP

```python
import jax, jax.numpy as jnp
from jax import lax
import numpy as np


D_MODEL = 2048
BATCH = 2
SEQ = 8192
DEPTH = 4

CTX_LEN = 256
GRID_W = 64
N_MIXERS = 3
MIXER_NA = 0
MIXER_GMLP = 1
MIXER_CONV = 2
NA_HEADS = 16
HEAD_DIM = D_MODEL // NA_HEADS
WIN_H = 8
WIN_W = 16
QROWS = 2
GM_WIDTH = 2 * D_MODEL
GM_GROUPS = 16
GM_GROUP_DIM = GM_WIDTH // GM_GROUPS
GM_CHUNK = 128
FFN_DIM = 5504
N_MOD = 6
EPS = 1e-6

kernel_name = 'hybrid_na_gmlp_shortconv_dit_block'


def rms_norm(x, g):
    x32 = x.astype(jnp.float32)
    y = x32 * lax.rsqrt(jnp.mean(x32 * x32, axis=-1, keepdims=True) + EPS)
    return (y * g.astype(jnp.float32)).astype(x.dtype)


def adaln(cond, w, b):
    return jnp.split(jax.nn.silu(cond) @ w + b, N_MOD, axis=-1)


def modulate(x, shift, scale):
    return x * (1.0 + scale) + shift


def dwconv3(z, w, b=None):
    zp = jnp.pad(z, ((0, 0), (1, 1), (0, 0)))
    y = zp[:, :-2] * w[0] + zp[:, 1:-1] * w[1] + zp[:, 2:] * w[2]
    return y if b is None else y + b


def neighbourhood_attention(h, hc, w_qkv, q_g, k_g, rpb, w_o, ctx_out):
    bn, n, d = h.shape
    rows = n // GRID_W
    kh = min(WIN_H, rows)
    nb = min(kh + QROWS - 1, rows)
    n_blk = rows // QROWS
    qw = QROWS * GRID_W
    nk = nb * GRID_W
    scale = HEAD_DIM ** -0.5

    def project(t):
        q, k, v = jnp.split(t @ w_qkv, 3, axis=-1)
        sh = (t.shape[0], t.shape[1], NA_HEADS, HEAD_DIM)
        return rms_norm(q.reshape(sh), q_g), rms_norm(k.reshape(sh), k_g), v.reshape(sh)

    q, k, v = project(h)
    qc, kc, vc = project(hc)
    kg = k.reshape(bn, rows, GRID_W, NA_HEADS, HEAD_DIM)
    vg = v.reshape(bn, rows, GRID_W, NA_HEADS, HEAD_DIM)

    q_row_off = jnp.repeat(jnp.arange(QROWS), GRID_W)
    q_col = jnp.tile(jnp.arange(GRID_W), QROWS)
    k_row_off = jnp.repeat(jnp.arange(nb), GRID_W)
    k_col = jnp.tile(jnp.arange(GRID_W), nb)
    c_start = jnp.clip(q_col - WIN_W // 2, 0, GRID_W - WIN_W)
    col_ok = (k_col[None, :] >= c_start[:, None]) & (k_col[None, :] < c_start[:, None] + WIN_W)
    dc_idx = jnp.clip(k_col[None, :] - q_col[:, None], -(WIN_W - 1), WIN_W - 1) + WIN_W - 1

    def block(args):
        blk, qb = args
        r0 = blk * QROWS
        q_row = r0 + q_row_off
        r_start = jnp.clip(q_row - kh // 2, 0, rows - kh)
        band0 = jnp.minimum(jnp.clip(r0 - kh // 2, 0, rows - kh), rows - nb)
        k_row = band0 + k_row_off
        kb = lax.dynamic_slice_in_dim(kg, band0, nb, axis=1).reshape(bn, nk, NA_HEADS, HEAD_DIM)
        vb = lax.dynamic_slice_in_dim(vg, band0, nb, axis=1).reshape(bn, nk, NA_HEADS, HEAD_DIM)
        ok = col_ok & (k_row[None, :] >= r_start[:, None]) & (k_row[None, :] < r_start[:, None] + kh)
        dr_idx = jnp.clip(k_row[None, :] - q_row[:, None], -(WIN_H - 1), WIN_H - 1) + WIN_H - 1
        bias = rpb[:, dr_idx, dc_idx].astype(jnp.float32)
        s_lat = jnp.einsum('bqhd,bkhd->bhqk', qb, kb).astype(jnp.float32) * scale + bias
        s_lat = jnp.where(ok, s_lat, -jnp.inf)
        s_ctx = jnp.einsum('bqhd,bchd->bhqc', qb, kc).astype(jnp.float32) * scale
        p = jax.nn.softmax(jnp.concatenate([s_lat, s_ctx], axis=-1), axis=-1).astype(vb.dtype)
        return (jnp.einsum('bhqk,bkhd->bqhd', p[..., :nk], vb)
                + jnp.einsum('bhqc,bchd->bqhd', p[..., nk:], vc))

    q_blocks = q.reshape(bn, n_blk, qw, NA_HEADS, HEAD_DIM).transpose(1, 0, 2, 3, 4)
    o = lax.map(block, (jnp.arange(n_blk), q_blocks))
    y = o.transpose(1, 0, 2, 3, 4).reshape(bn, n, d) @ w_o
    yc = None
    if ctx_out:
        s = jnp.einsum('bqhd,bkhd->bhqk', qc, kc).astype(jnp.float32) * scale
        p = jax.nn.softmax(s, axis=-1).astype(vc.dtype)
        yc = jnp.einsum('bhqk,bkhd->bqhd', p, vc).reshape(bn, hc.shape[1], d) @ w_o
    return y, yc


def chunk_gmlp(h, w_in, v_g, w_s, b_s, w_out):
    bn, n, _ = h.shape
    u, v = jnp.split(jax.nn.gelu(h @ w_in), 2, axis=-1)
    v = rms_norm(v, v_g)
    vch = v.reshape(bn, n // GM_CHUNK, GM_CHUNK, GM_GROUPS, GM_GROUP_DIM)
    sv = jnp.einsum('gij,bnjgd->bnigd', w_s, vch) + b_s.T[None, None, :, :, None]
    return (u * sv.reshape(bn, n, GM_WIDTH)) @ w_out


def short_conv(h, w_in, conv_w, w_out):
    b_gate, c_gate, xv = jnp.split(h @ w_in, 3, axis=-1)
    return (b_gate * dwconv3(c_gate * xv, conv_w)) @ w_out


def conv_ffn(h, w_up, conv_w, conv_b, w_down):
    gate, up = jnp.split(dwconv3(h @ w_up, conv_w, conv_b), 2, axis=-1)
    return (jax.nn.silu(gate) * up) @ w_down


def setup_inputs(seed: int = 0) -> dict:
    key = jax.random.key(seed)
    keys = iter(jax.random.split(key, 40))

    def nrm(shape, s):
        return jax.random.normal(next(keys), shape, jnp.float32) * s

    d = D_MODEL
    n_na = len(range(MIXER_NA, DEPTH, N_MIXERS))
    n_gm = len(range(MIXER_GMLP, DEPTH, N_MIXERS))
    n_sc = len(range(MIXER_CONV, DEPTH, N_MIXERS))
    return {
        'x': nrm((BATCH, SEQ, d), 1.0),
        'c': nrm((BATCH, d), 1.0),
        'ctx': nrm((BATCH, CTX_LEN, d), 1.0),
        'c_ctx': nrm((d,), 1.0),
        'norm_mix_g': 1.0 + nrm((DEPTH, d), 0.1),
        'norm_ffn_g': 1.0 + nrm((DEPTH, d), 0.1),
        'w_ada': nrm((DEPTH, d, N_MOD * d), 0.5 * d ** -0.5),
        'b_ada': nrm((DEPTH, N_MOD * d), 0.02),
        'na_w_qkv': nrm((n_na, d, 3 * d), d ** -0.5),
        'na_q_g': 1.0 + nrm((n_na, HEAD_DIM), 0.1),
        'na_k_g': 1.0 + nrm((n_na, HEAD_DIM), 0.1),
        'na_rpb': nrm((n_na, NA_HEADS, 2 * WIN_H - 1, 2 * WIN_W - 1), 0.2),
        'na_w_o': nrm((n_na, d, d), d ** -0.5),
        'gm_w_in': nrm((n_gm, d, 2 * GM_WIDTH), d ** -0.5),
        'gm_v_g': 1.0 + nrm((n_gm, GM_WIDTH), 0.1),
        'gm_w_s': nrm((n_gm, GM_GROUPS, GM_CHUNK, GM_CHUNK), GM_CHUNK ** -0.5),
        'gm_b_s': 1.0 + nrm((n_gm, GM_GROUPS, GM_CHUNK), 0.1),
        'gm_w_out': nrm((n_gm, GM_WIDTH, d), GM_WIDTH ** -0.5),
        'sc_w_in': nrm((n_sc, d, 3 * d), d ** -0.5),
        'sc_conv_w': nrm((n_sc, 3, d), 3 ** -0.5),
        'sc_w_out': nrm((n_sc, d, d), d ** -0.5),
        'ffn_w_up': nrm((DEPTH, d, 2 * FFN_DIM), d ** -0.5),
        'ffn_conv_w': nrm((DEPTH, 3, 2 * FFN_DIM), 3 ** -0.5),
        'ffn_conv_b': nrm((DEPTH, 2 * FFN_DIM), 0.02),
        'ffn_w_down': nrm((DEPTH, FFN_DIM, d), FFN_DIM ** -0.5),
    }


def reference(x, c, ctx, c_ctx, norm_mix_g, norm_ffn_g, w_ada, b_ada,
              na_w_qkv, na_q_g, na_k_g, na_rpb, na_w_o,
              gm_w_in, gm_v_g, gm_w_s, gm_b_s, gm_w_out,
              sc_w_in, sc_conv_w, sc_w_out,
              ffn_w_up, ffn_conv_w, ffn_conv_b, ffn_w_down):
    cond_lat = c[:, None, :]
    cond_ctx = c_ctx[None, None, :]
    for i in range(DEPTH):
        last = i == DEPTH - 1
        m, j = i % N_MIXERS, i // N_MIXERS
        sh1, sc1, g1, sh2, sc2, g2 = adaln(cond_lat, w_ada[i], b_ada[i])
        h = modulate(rms_norm(x, norm_mix_g[i]), sh1, sc1)
        hc = None
        if (not last) or m == MIXER_NA:
            csh1, csc1, cg1, csh2, csc2, cg2 = adaln(cond_ctx, w_ada[i], b_ada[i])
            hc = modulate(rms_norm(ctx, norm_mix_g[i]), csh1, csc1)
        if m == MIXER_NA:
            y, yc = neighbourhood_attention(h, hc, na_w_qkv[j], na_q_g[j], na_k_g[j],
                                            na_rpb[j], na_w_o[j], not last)
        elif m == MIXER_GMLP:
            y = chunk_gmlp(h, gm_w_in[j], gm_v_g[j], gm_w_s[j], gm_b_s[j], gm_w_out[j])
            yc = None if last else chunk_gmlp(hc, gm_w_in[j], gm_v_g[j], gm_w_s[j], gm_b_s[j], gm_w_out[j])
        else:
            y = short_conv(h, sc_w_in[j], sc_conv_w[j], sc_w_out[j])
            yc = None if last else short_conv(hc, sc_w_in[j], sc_conv_w[j], sc_w_out[j])
        x = x + g1 * y
        hf = modulate(rms_norm(x, norm_ffn_g[i]), sh2, sc2)
        x = x + g2 * conv_ffn(hf, ffn_w_up[i], ffn_conv_w[i], ffn_conv_b[i], ffn_w_down[i])
        if not last:
            ctx = ctx + cg1 * yc
            hcf = modulate(rms_norm(ctx, norm_ffn_g[i]), csh2, csc2)
            ctx = ctx + cg2 * conv_ffn(hcf, ffn_w_up[i], ffn_conv_w[i], ffn_conv_b[i], ffn_w_down[i])
    return x
```

```cpp
#include <hip/hip_runtime.h>
#include <cstdio>
#include <cstdint>

#ifndef MK_DEBUG
#define MK_DEBUG 0
#endif

namespace pg8 {
#define PG8_LAS __attribute__((address_space(3)))
typedef unsigned short bf16_t;
typedef short bf16x8 __attribute__((ext_vector_type(8)));
typedef float f32x4 __attribute__((ext_vector_type(4)));
typedef unsigned u32x4 __attribute__((ext_vector_type(4)));
constexpr int BM = 256, BK = 64, HALF = 128, HTB = HALF * BK * 2  , STAGE_BYTES = 8 * HTB, NXCD = 8, WGM = 8;

__host__ __device__ __forceinline__ int lds_byte(int r, int c) { const int st = (r >> 4) * 2 + (c >> 5), rr = r & 15, cc = c & 31, ob = rr * 64 + cc * 2; return st * 1024 + (ob ^ (((ob >> 9) & 1) << 5)); }
__host__ __device__ __forceinline__ void stage_rc(int b, int& R, int& C) { const int st = b / 1024, sb = b % 1024, swz = sb ^ (((sb >> 9) & 1) << 5); R = (st >> 1) * 16 + swz / 64; C = (st & 1) * 32 + (swz % 64) / 2; }
__host__ __device__ __forceinline__ int perm32(int rho) { const int n = rho >> 4, i = rho & 15; return 8 * (i >> 2) + 4 * n + (i & 3); }

struct Unit { int pm, pn; };
struct Gemm { const bf16_t* A; const bf16_t* Bt; int M, N, K; };

struct StaticOrder {
    int nM, nN, nwg, G, c;
    __host__ __device__ void init(int M, int N, int G_, int c_) { nM = M / BM; nN = N / BM; nwg = nM * nN; G = G_; c = c_; }
    __host__ __device__ bool next(int i, Unit& u) const {
        const long L = (long)i * G + c; if (L >= nwg) return false;
        int wgid = (int)L; { const int q = nwg / NXCD, r = nwg % NXCD, xcd = wgid % NXCD, off = wgid / NXCD; wgid = (xcd < r ? xcd * (q + 1) : r * (q + 1) + (xcd - r) * q) + off; }
        const int nig = WGM * nN, gid = wgid / nig, fm = gid * WGM, gsz = (nM - fm) < WGM ? (nM - fm) : WGM;
        u.pm = fm + ((wgid % nig) % gsz); u.pn = (wgid % nig) / gsz; return true;
    }
    __device__ __forceinline__ void a_ready(const Unit&) const {}
    __device__ __forceinline__ void done(const Unit&) const {}
};

typedef __bf16 bf16v2 __attribute__((ext_vector_type(2)));
typedef float f32x2 __attribute__((ext_vector_type(2)));
__device__ __forceinline__ unsigned cvt_pk_bf16(float lo, float hi) { const f32x2 v = {lo, hi}; return __builtin_bit_cast(unsigned, __builtin_convertvector(v, bf16v2)); }

__device__ __forceinline__ float gelu_tanh(float x) {
    const float y2 = x * (1.5957691216f + 0.0713548163f * x * x);
    return x * __builtin_amdgcn_rcpf(1.0f + __builtin_amdgcn_exp2f(-1.4426950409f * y2));
}
__device__ __forceinline__ float silu_f(float x) { return x * __builtin_amdgcn_rcpf(1.0f + __builtin_amdgcn_exp2f(-1.4426950409f * x)); }

struct EpiBf16R {
    static constexpr bool PERM = true, AFTER_DRAIN = false;
    bf16_t* O; int ldc; float* P; bool ACT, STATS;
    __device__ __forceinline__ void operator()(const f32x4 (&acc)[2][2][4][2], const Unit& u, int wr, int wc, int fr, int fq) const {
        const int row0 = u.pm * BM + wr * 64 + fr; const int col0 = u.pn * BM + wc * 32 + 8 * fq;
        float ss[2][2][4];
        if (STATS) {
#pragma unroll
            for (int bj = 0; bj < 2; ++bj)
#pragma unroll
                for (int n = 0; n < 2; ++n)
#pragma unroll
                    for (int e = 0; e < 4; ++e) ss[bj][n][e] = 0.f;
        }
#pragma unroll
        for (int ai = 0; ai < 2; ++ai)
#pragma unroll
            for (int m = 0; m < 4; ++m) { bf16_t* rowp = O + (size_t)(row0 + ai * HALF + m * 16) * ldc + col0;
#pragma unroll
                for (int bj = 0; bj < 2; ++bj) { f32x4 v0 = acc[ai][bj][m][0], v1 = acc[ai][bj][m][1];
                    if (ACT == 1) {
#pragma unroll
                        for (int e = 0; e < 4; ++e) { v0[e] = gelu_tanh(v0[e]); v1[e] = gelu_tanh(v1[e]); } }
                    if (STATS) {
#pragma unroll
                        for (int e = 0; e < 4; ++e) { ss[bj][0][e] += v0[e] * v0[e]; ss[bj][1][e] += v1[e] * v1[e]; } }
                    u32x4 w; w.x = cvt_pk_bf16(v0[0], v0[1]); w.y = cvt_pk_bf16(v0[2], v0[3]); w.z = cvt_pk_bf16(v1[0], v1[1]); w.w = cvt_pk_bf16(v1[2], v1[3]);
                    *(u32x4*)(rowp + bj * HALF) = w; } }
        if (STATS) {
#pragma unroll
            for (int bj = 0; bj < 2; ++bj)
#pragma unroll
                for (int n = 0; n < 2; ++n)
#pragma unroll
                    for (int e = 0; e < 4; ++e) { float s = ss[bj][n][e]; s += __shfl_xor(s, 1); s += __shfl_xor(s, 2); s += __shfl_xor(s, 4); s += __shfl_xor(s, 8); ss[bj][n][e] = s; }
            if (fr == 0) {
                float* pp = P + (size_t)(2 * u.pm + wr) * ldc + col0;
#pragma unroll
                for (int bj = 0; bj < 2; ++bj) { *(f32x4*)(pp + bj * HALF) = (f32x4){ss[bj][0][0], ss[bj][0][1], ss[bj][0][2], ss[bj][0][3]};
                                                 *(f32x4*)(pp + bj * HALF + 4) = (f32x4){ss[bj][1][0], ss[bj][1][1], ss[bj][1][2], ss[bj][1][3]}; }
            }
        }
    }
};

struct EpiRes {
    static constexpr bool PERM = false, AFTER_DRAIN = false;
    const float* xin_lat; const float* xin_ctx; float* xout_lat; float* xout_ctx; const float* gate;
    __device__ __forceinline__ void operator()(const f32x4 (&acc)[2][2][4][2], const Unit& u, int wr, int wc, int fr, int fq) const {
        const int pm = u.pm; const int ci = pm < 32 ? 0 : (pm < 64 ? 1 : 2);
        const float* xi = pm < 64 ? xin_lat + (size_t)pm * BM * 2048 : xin_ctx + (size_t)(pm - 64) * BM * 2048;
        float* xo = pm < 64 ? xout_lat + (size_t)pm * BM * 2048 : xout_ctx + (size_t)(pm - 64) * BM * 2048;
        const int rl0 = wr * 64 + fr, col0 = u.pn * BM + wc * 32 + 4 * fq;
        f32x4 g4[2][2];
#pragma unroll
        for (int bj = 0; bj < 2; ++bj)
#pragma unroll
            for (int n = 0; n < 2; ++n) g4[bj][n] = *(const f32x4*)(gate + (size_t)ci * 12288 + col0 + bj * HALF + n * 16);
#pragma unroll
        for (int ai = 0; ai < 2; ++ai)
#pragma unroll
            for (int m = 0; m < 4; ++m) { const size_t off = (size_t)(rl0 + ai * HALF + m * 16) * 2048 + col0;
#pragma unroll
                for (int bj = 0; bj < 2; ++bj)
#pragma unroll
                    for (int n = 0; n < 2; ++n) { const f32x4 x4 = *(const f32x4*)(xi + off + bj * HALF + n * 16);
                        *(f32x4*)(xo + off + bj * HALF + n * 16) = x4 + g4[bj][n] * acc[ai][bj][m][n]; } }
    }
};
template <class Epi, class Sched, bool ALIGN_EPI = false, bool SP2 = false>
__device__ __forceinline__ void gemm_phase(PG8_LAS unsigned char* lds, const Gemm g, const Sched& S, const Epi& E) {
    int tid_ = threadIdx.x; asm volatile("" : "+v"(tid_)); const int tid = tid_, wid = __builtin_amdgcn_readfirstlane(tid >> 6), lane = tid & 63, wr = wid >> 2, wc = wid & 3, fr = lane & 15, fq = lane >> 4;
    const int K = g.K, nt = K / BK;
    unsigned voffA[2], voffB[2];
#pragma unroll
    for (int i = 0; i < 2; ++i) { int R, C; stage_rc(tid * 16 + i * 8192, R, C); const int Rb = Epi::PERM ? ((R & ~31) + perm32(R & 31)) : R;
        voffA[i] = (unsigned)(R * K + C) * 2u; voffB[i] = (unsigned)(Rb * K + C) * 2u; }
    const size_t kstep = (size_t)(BK * 2);
    const size_t hstep = (size_t)HALF * K * 2;
    const size_t tstep = 2 * hstep;
    const unsigned ldsw = (unsigned)wid * 1024u;
    const int aoff = lds_byte(wr * 64 + fr, fq * 8), boff = lds_byte(wc * 32 + fr, fq * 8);
#define PG8_SA(b, h) (((b) * 2 + (h)) * HTB)
#define PG8_SB(b, h) ((4 + (b) * 2 + (h)) * HTB)
#define PG8_STAGE(bufoff, gbase, voff) do { _Pragma("unroll") for (int _i = 0; _i < 2; ++_i) \
        __builtin_amdgcn_global_load_lds((const unsigned*)((const char*)(gbase) + (voff)[_i]), (PG8_LAS unsigned*)(lds + (bufoff) + ldsw + _i * 8192), 16, 0, 0); } while (0)
#define PG8_LDA(dst, b, h) do { _Pragma("unroll") for (int m = 0; m < 4; ++m) _Pragma("unroll") for (int k = 0; k < 2; ++k) dst[m][k] = *(const PG8_LAS bf16x8*)(lds + PG8_SA(b, h) + aoff + m * 2048 + k * 1024); } while (0)
#define PG8_LDB(dst, b, h) do { _Pragma("unroll") for (int n = 0; n < 2; ++n) _Pragma("unroll") for (int k = 0; k < 2; ++k) dst[n][k] = *(const PG8_LAS bf16x8*)(lds + PG8_SB(b, h) + boff + n * 2048 + k * 1024); } while (0)
#define PG8_MMA(ai, bj, At, Bt) do { __builtin_amdgcn_s_setprio(1); _Pragma("unroll") for (int m = 0; m < 4; ++m) _Pragma("unroll") for (int n = 0; n < 2; ++n) _Pragma("unroll") for (int k = 0; k < 2; ++k) \
        acc[ai][bj][m][n] = __builtin_amdgcn_mfma_f32_16x16x32_bf16(Bt[n][k], At[m][k], acc[ai][bj][m][n], 0, 0, 0); __builtin_amdgcn_s_setprio(0); } while (0)
#define PG8_WAIT_V(n) asm volatile("s_waitcnt vmcnt(" #n ")" ::: "memory")
#define PG8_WAIT_L(n) asm volatile("s_waitcnt lgkmcnt(" #n ")" ::: "memory")
#define PG8_BAR __builtin_amdgcn_s_barrier()
#define PG8_SCHED __builtin_amdgcn_sched_barrier(0)
    Unit cur, nxt; int ui = 0;
    if (!S.next(0, cur)) return;
    f32x4 acc[2][2][4][2];
#pragma unroll
    for (int a = 0; a < 2; ++a)
#pragma unroll
        for (int b = 0; b < 2; ++b)
#pragma unroll
            for (int m = 0; m < 4; ++m)
#pragma unroll
                for (int n = 0; n < 2; ++n) acc[a][b][m][n] = (f32x4){0.f, 0.f, 0.f, 0.f};
    bf16x8 At[4][2], B0[2][2], B1[2][2];
    const char* cA = (const char*)g.A + (size_t)cur.pm * tstep; const char* cB = (const char*)g.Bt + (size_t)cur.pn * tstep;
    S.a_ready(cur);
    if constexpr (SP2) {
        PG8_STAGE(PG8_SB(0, 0), cB, voffB); PG8_STAGE(PG8_SB(0, 1), cB + hstep, voffB); PG8_STAGE(PG8_SA(0, 0), cA, voffA); PG8_STAGE(PG8_SA(0, 1), cA + hstep, voffA);
        if (wr == 1) PG8_BAR;
        PG8_WAIT_V(2); PG8_BAR;
        PG8_STAGE(PG8_SB(1, 0), cB + kstep, voffB); PG8_STAGE(PG8_SA(1, 0), cA + kstep, voffA); PG8_STAGE(PG8_SB(1, 1), cB + hstep + kstep, voffB);
        PG8_WAIT_V(6); PG8_BAR;
    } else {
        PG8_STAGE(PG8_SB(0, 0), cB, voffB); PG8_STAGE(PG8_SA(0, 0), cA, voffA); PG8_STAGE(PG8_SB(0, 1), cB + hstep, voffB); PG8_STAGE(PG8_SA(0, 1), cA + hstep, voffA);
        if (wr == 1) PG8_BAR;
        PG8_WAIT_V(4); PG8_BAR;
        PG8_STAGE(PG8_SB(1, 0), cB + kstep, voffB); PG8_STAGE(PG8_SA(1, 0), cA + kstep, voffA); PG8_STAGE(PG8_SB(1, 1), cB + hstep + kstep, voffB);
        PG8_WAIT_V(6); PG8_BAR;
    }
    for (;;) {
        const bool has_next = S.next(ui + 1, nxt);
        const char* nA = has_next ? (const char*)g.A + (size_t)nxt.pm * tstep : cA; const char* nB = has_next ? (const char*)g.Bt + (size_t)nxt.pn * tstep : cB;
        for (int t = 0; t < nt; t += 2) {
            const bool last = (t == nt - 2);
            const char* a1 = cA + (size_t)(t + 1) * kstep;
            const char* a2 = last ? nA : cA + (size_t)(t + 2) * kstep; const char* b2 = last ? nB : cB + (size_t)(t + 2) * kstep;
            const char* a3 = a2 + kstep; const char* b3 = b2 + kstep;
            if (last && has_next) S.a_ready(nxt);
            if constexpr (SP2) {
            PG8_LDB(B0, 0, 0); PG8_LDB(B1, 0, 1); PG8_SCHED; PG8_LDA(At, 0, 0); PG8_STAGE(PG8_SA(1, 1), a1 + hstep, voffA);
            PG8_WAIT_V(8); PG8_WAIT_L(0); PG8_BAR; PG8_MMA(0, 0, At, B0); PG8_MMA(0, 1, At, B1); PG8_BAR; PG8_SCHED;
            PG8_LDA(At, 0, 1); PG8_STAGE(PG8_SB(0, 0), b2, voffB); PG8_STAGE(PG8_SB(0, 1), b2 + hstep, voffB); PG8_STAGE(PG8_SA(0, 0), a2, voffA);
            PG8_WAIT_V(8); PG8_WAIT_L(0); PG8_BAR; PG8_MMA(1, 0, At, B0); PG8_MMA(1, 1, At, B1); PG8_BAR; PG8_SCHED;
            PG8_LDB(B0, 1, 0); PG8_LDB(B1, 1, 1); PG8_SCHED; PG8_LDA(At, 1, 0); PG8_STAGE(PG8_SA(0, 1), a2 + hstep, voffA);
            PG8_WAIT_V(8); PG8_WAIT_L(0); PG8_BAR; PG8_MMA(0, 0, At, B0); PG8_MMA(0, 1, At, B1); PG8_BAR; PG8_SCHED;
            PG8_LDA(At, 1, 1); PG8_STAGE(PG8_SB(1, 0), b3, voffB); PG8_STAGE(PG8_SB(1, 1), b3 + hstep, voffB); PG8_STAGE(PG8_SA(1, 0), a3, voffA);
            PG8_WAIT_V(8); PG8_WAIT_L(0); PG8_BAR; PG8_MMA(1, 0, At, B0); PG8_MMA(1, 1, At, B1); PG8_BAR; PG8_SCHED;
            } else {
            PG8_LDB(B0, 0, 0); PG8_SCHED; PG8_LDA(At, 0, 0); PG8_STAGE(PG8_SA(1, 1), a1 + hstep, voffA);
            PG8_WAIT_L(8); PG8_BAR; PG8_WAIT_L(0); PG8_MMA(0, 0, At, B0); PG8_BAR; PG8_SCHED;
            PG8_LDB(B1, 0, 1); PG8_STAGE(PG8_SB(0, 0), b2, voffB);
            PG8_BAR; PG8_WAIT_L(0); PG8_MMA(0, 1, At, B1); PG8_BAR;
            PG8_LDA(At, 0, 1); PG8_STAGE(PG8_SA(0, 0), a2, voffA);
            PG8_BAR; PG8_WAIT_L(0); PG8_MMA(1, 0, At, B0); PG8_BAR; PG8_SCHED;
            PG8_STAGE(PG8_SB(0, 1), b2 + hstep, voffB);
            PG8_WAIT_V(6); PG8_BAR; PG8_MMA(1, 1, At, B1); PG8_BAR;
            PG8_LDB(B0, 1, 0); PG8_SCHED; PG8_LDA(At, 1, 0); PG8_STAGE(PG8_SA(0, 1), a2 + hstep, voffA);
            PG8_WAIT_L(8); PG8_BAR; PG8_WAIT_L(0); PG8_MMA(0, 0, At, B0); PG8_BAR; PG8_SCHED;
            PG8_LDB(B1, 1, 1); PG8_STAGE(PG8_SB(1, 0), b3, voffB);
            PG8_BAR; PG8_WAIT_L(0); PG8_MMA(0, 1, At, B1); PG8_BAR;
            PG8_LDA(At, 1, 1); PG8_STAGE(PG8_SA(1, 0), a3, voffA);
            PG8_BAR; PG8_WAIT_L(0); PG8_MMA(1, 0, At, B0); PG8_BAR; PG8_SCHED;
            PG8_STAGE(PG8_SB(1, 1), b3 + hstep, voffB);
            PG8_WAIT_V(6); PG8_BAR; PG8_MMA(1, 1, At, B1); PG8_BAR;
            }
        }
        if constexpr (ALIGN_EPI) { if (wr == 0) PG8_BAR; }
        if constexpr (!Epi::AFTER_DRAIN) { E(acc, cur, wr, wc, fr, fq); S.done(cur); }
        if (!has_next) break;
#pragma unroll
        for (int a = 0; a < 2; ++a)
#pragma unroll
            for (int b = 0; b < 2; ++b)
#pragma unroll
                for (int m = 0; m < 4; ++m)
#pragma unroll
                    for (int n = 0; n < 2; ++n) acc[a][b][m][n] = (f32x4){0.f, 0.f, 0.f, 0.f};
        cur = nxt; cA = nA; cB = nB; ++ui;
        if constexpr (ALIGN_EPI) { if (wr == 1) PG8_BAR; }
    }
    PG8_WAIT_V(0);
    if constexpr (!ALIGN_EPI) { if (wr == 0) PG8_BAR; }
    PG8_BAR;
    if constexpr (Epi::AFTER_DRAIN) { E.fused(acc, cur, wr, wc, fr, fq, lds, wid, lane); S.done(cur); }
#undef PG8_SA
#undef PG8_SB
#undef PG8_STAGE
#undef PG8_LDA
#undef PG8_LDB
#undef PG8_MMA
#undef PG8_WAIT_V
#undef PG8_WAIT_L
#undef PG8_BAR
#undef PG8_SCHED
}
}

constexpr int NWAVES = 8;
constexpr int DM = 2048, NB = 2, SEQ = 8192, DEPTH = 4, CTXL = 256;
constexpr int ML = NB * SEQ;
constexpr int MC = NB * CTXL;
constexpr int MT = ML + MC;
constexpr int NH = 16, HD = 128, GRIDW = 64, GROWS = 128;
constexpr int GMW = 4096, GMG = 16, GMGD = 256, GMC = 128;
constexpr int FFN = 5504, FFN2 = 11008;
constexpr float EPS = 1e-6f;
constexpr float LOG2E = 1.4426950408889634f;
constexpr int NMOD = 6 * DM;

enum { I_X = 0, I_C, I_CTX, I_CCTX, I_NMG, I_NFG, I_WADA, I_BADA, I_NAQKV, I_NAQG, I_NAKG, I_NARPB, I_NAWO, I_GMWIN, I_GMVG, I_GMWS, I_GMBS, I_GMWOUT,
       I_SCWIN, I_SCCW, I_SCWOUT, I_FUP, I_FCW, I_FCB, I_FDN, N_IN };

constexpr size_t MiB = 1u << 20;
constexpr size_t WS_CTL = 0, CTL_ZERO_BYTES = 1 * MiB;
constexpr size_t WS_MOD = 1 * MiB;
constexpr size_t WS_WQKV = 2 * MiB;
constexpr size_t WS_WO = 50 * MiB;
constexpr size_t WS_WGIN = 66 * MiB;
constexpr size_t WS_WGS = 98 * MiB;
constexpr size_t WS_WGOUT = 99 * MiB;
constexpr size_t WS_WCIN = 115 * MiB;
constexpr size_t WS_WCOUT = 139 * MiB;
constexpr size_t WS_WUP = 147 * MiB;
constexpr size_t WS_WDN = 319 * MiB;
constexpr size_t WS_XA = 405 * MiB;
constexpr size_t WS_XB = 537 * MiB;
constexpr size_t WS_H = 669 * MiB;
constexpr size_t WS_ACT = 735 * MiB;
constexpr size_t WS_PST = 913 * MiB;
constexpr size_t WS_BIG = 916 * MiB;
constexpr size_t WS_END = 1316 * MiB;
constexpr size_t BIG_QK = 0, BIG_VT = 132 * MiB, BIG_O = 198 * MiB;
constexpr size_t BIG_U = 0, BIG_GVT = 132 * MiB, BIG_G = 264 * MiB;
constexpr size_t BIG_BCX = 0, BIG_T = 198 * MiB;
constexpr size_t BIG_Z = 0;
constexpr int CW_TMO = 0, CW_BAR = 4096, CW_DIAG = 16384;

constexpr int RING_OFF = 0, RING_BYTES = 131072;
constexpr int LDSCTL_OFF = RING_BYTES, MISC_OFF = LDSCTL_OFF + 320;
constexpr int LDS_BYTES = 147456;

#define GAS __attribute__((address_space(1)))
#define LAS __attribute__((address_space(3)))
typedef unsigned short bf16;
typedef unsigned v4u __attribute__((ext_vector_type(4)));
typedef unsigned v2u __attribute__((ext_vector_type(2)));
typedef float f32x4 __attribute__((ext_vector_type(4)));
typedef float f32x16 __attribute__((ext_vector_type(16)));
typedef short bf16x8 __attribute__((ext_vector_type(8)));
typedef short s16x4 __attribute__((ext_vector_type(4)));
typedef GAS unsigned gu32;
#define RLX_AGENT __ATOMIC_RELAXED, __HIP_MEMORY_SCOPE_AGENT
#define LDS_WAIT() asm volatile("s_waitcnt lgkmcnt(0)" ::: "memory")
__device__ __forceinline__ unsigned pk2(float lo, float hi) { return pg8::cvt_pk_bf16(lo, hi); }
__device__ __forceinline__ float bf2f(bf16 b) { return __uint_as_float(((unsigned)b) << 16); }
__device__ __forceinline__ float bflo(unsigned w) { return __uint_as_float(w << 16); }
__device__ __forceinline__ float bfhi(unsigned w) { return __uint_as_float(w & 0xffff0000u); }
__device__ __forceinline__ float wave_sum(float v) {
#pragma unroll
    for (int o = 1; o < 64; o <<= 1) v += __shfl_xor(v, o);
    return v;
}
__device__ __forceinline__ float swap32_max(float m) { auto rr = __builtin_amdgcn_permlane32_swap(__float_as_uint(m), __float_as_uint(m), false, false); return __builtin_fmaxf(__uint_as_float(rr[0]), __uint_as_float(rr[1])); }
__device__ __forceinline__ float swap32_sum(float m) { auto rr = __builtin_amdgcn_permlane32_swap(__float_as_uint(m), __float_as_uint(m), false, false); return __uint_as_float(rr[0]) + __uint_as_float(rr[1]); }
#define MFMA32(a, b, c) __builtin_amdgcn_mfma_f32_32x32x16_bf16((a), (b), (c), 0, 0, 0)

#define XB_TMO      128
#define XB_XCNT(j)  (256  + 64 * (j))
#define XB_XSUB(j)  (1280 + 64 * (j))
#define XB_XGEN(j)  (2304 + 64 * (j))
#define XB_TOP      3328
#define XB_TOPGEN   3392
#define XCD_BAR_WORDS 3456
#define XB_SPIN_CAP (1u << 18)

__device__ __forceinline__ unsigned xb_ld(unsigned* p)              { return __hip_atomic_load(p, __ATOMIC_RELAXED, __HIP_MEMORY_SCOPE_AGENT); }
__device__ __forceinline__ unsigned xb_add(unsigned* p, unsigned v) { return __hip_atomic_fetch_add(p, v, __ATOMIC_RELAXED, __HIP_MEMORY_SCOPE_AGENT); }
__device__ __forceinline__ unsigned xb_xcc_id() { return (unsigned)__builtin_amdgcn_s_getreg((3 << 11) | 20) & 0xFu; }
#define XB_SPIN(cond, bar) do { unsigned _sp = 0; while (cond) { __builtin_amdgcn_s_sleep(1); \
    if ((++_sp & 255u) == 0u) { if (xb_ld(&(bar)[XB_TMO])) break; if (_sp > XB_SPIN_CAP) { atomicAdd(&(bar)[XB_TMO], 1u); break; } } } } while (0)

struct XcdBarrier {
    unsigned* bar; unsigned x;
    volatile LAS unsigned* st;
};

__device__ __forceinline__ XcdBarrier xcd_barrier_post(unsigned* bar, volatile LAS unsigned* st) {
    XcdBarrier b; b.bar = bar; b.x = xb_xcc_id(); b.st = st;
    if (threadIdx.x == 0) (void)xb_add(&bar[XB_XCNT(b.x)], 1u);
    return b;
}
__device__ __forceinline__ void xcd_barrier_complete(unsigned* bar, unsigned x, unsigned& nloc, unsigned& nx) {
    const unsigned G = gridDim.x * gridDim.y * gridDim.z;
    unsigned sum, cnt, mine, sp = 0u;
    for (;;) {
        sum = 0u; cnt = 0u; mine = 0u;
#pragma unroll
        for (unsigned j = 0; j < 16; ++j) { const unsigned c = xb_ld(&bar[XB_XCNT(j)]); sum += c; cnt += (c > 0u) ? 1u : 0u; mine = (j == x) ? c : mine; }
        if (sum == G) break;
        __builtin_amdgcn_s_sleep(1);
        if ((++sp & 255u) == 0u) { if (xb_ld(&bar[XB_TMO])) break; if (sp > XB_SPIN_CAP) { atomicAdd(&bar[XB_TMO], 1u); break; } }
    }
    nloc = mine > 0u ? mine : 1u; nx = cnt > 0u ? cnt : 1u;
}

__device__ __forceinline__ void xcd_barrier(const XcdBarrier& b) {
    asm volatile("s_waitcnt vmcnt(0)" ::: "memory");
    __syncthreads();
    if (threadIdx.x == 0) {
        unsigned* bar = b.bar;
        __builtin_amdgcn_s_waitcnt(0);
        unsigned nloc = b.st[0], nx = b.st[1];
        if (nloc == 0u) { xcd_barrier_complete(bar, b.x, nloc, nx); b.st[0] = nloc; b.st[1] = nx; }
        const unsigned old = xb_add(&bar[XB_XSUB(b.x)], 1u);
        const unsigned gen = old / nloc;
        if (old + 1u == (gen + 1u) * nloc) {
            __builtin_amdgcn_fence(__ATOMIC_RELEASE, "agent");
            asm volatile("s_waitcnt vmcnt(0)" ::: "memory");
            const unsigned og = xb_add(&bar[XB_TOP], 1u);
            const unsigned tg = og / nx;
            if (og + 1u == (tg + 1u) * nx) xb_add(&bar[XB_TOPGEN], 1u);
            else XB_SPIN(xb_ld(&bar[XB_TOPGEN]) == tg, bar);
            __builtin_amdgcn_fence(__ATOMIC_ACQUIRE, "agent");
            xb_add(&bar[XB_XGEN(b.x)], 1u);
            asm volatile("s_waitcnt vmcnt(0)" ::: "memory");
        } else {
            XB_SPIN(xb_ld(&bar[XB_XGEN(b.x)]) == gen, bar);
            __builtin_amdgcn_fence(__ATOMIC_ACQUIRE, "agent");
            asm volatile("s_waitcnt vmcnt(0)" ::: "memory");
        }
    }
    __syncthreads();
}

struct Frame {
    LAS unsigned char* lds;
    volatile LAS unsigned* MISC;
    gu32* ctl;
    int tid, lane, wave, vcu, G;
    unsigned char* ws;
};
__device__ __forceinline__ int cond_of_row(int r) { return r < SEQ ? 0 : (r < ML ? 1 : 2); }

__device__ __forceinline__ int up_perm_row(int n0) {
    return n0 < FFN ? 256 * (n0 / 128) + (n0 % 128) : 256 * ((n0 - FFN) / 128) + 128 + ((n0 - FFN) % 128);
}
__device__ __forceinline__ void p0_transpose_item(const float* W, int K, int N, bf16* WT, bool perm, LAS float* scr, int item, int lane) {
    const int nblk = N / 32, kb = item / nblk, nb = item % nblk, k0 = 64 * kb, n0 = 32 * nb;
    const int r0 = perm ? up_perm_row(n0) : n0;
#pragma unroll 8
    for (int i = 0; i < 32; ++i) { const int kk = 2 * i + (lane >> 5); scr[kk * 33 + (lane & 31)] = W[(size_t)(k0 + kk) * N + n0 + (lane & 31)]; }
    LDS_WAIT(); asm volatile("" ::: "memory");
    const int c = lane & 7;
#pragma unroll
    for (int j = 0; j < 4; ++j) { const int n = (lane >> 3) + 8 * j; const LAS float* s = scr + (8 * c) * 33 + n;
        v4u o; o.x = pk2(s[0 * 33], s[1 * 33]); o.y = pk2(s[2 * 33], s[3 * 33]); o.z = pk2(s[4 * 33], s[5 * 33]); o.w = pk2(s[6 * 33], s[7 * 33]);
        *(GAS v4u*)(WT + (size_t)(r0 + n) * K + k0 + 8 * c) = o; }
    LDS_WAIT(); asm volatile("" ::: "memory");
}
__device__ __forceinline__ void p0_prologue(Frame& F, const float* c_in, const float* cctx_in, const float* w_ada, const float* b_ada,
                                            const float* na_qkv, const float* na_wo, const float* gm_win, const float* gm_ws, const float* gm_wout,
                                            const float* sc_win, const float* sc_wout, const float* f_up, const float* f_dn) {
    unsigned char* ws = F.ws;
    LAS float* sc = (LAS float*)(F.lds);
    LAS float* red = (LAS float*)(F.lds + 24576);
    for (int i = F.tid; i < 3 * DM; i += NWAVES * 64) { const int ci = i / DM, k = i % DM; const float v = ci < 2 ? c_in[ci * DM + k] : cctx_in[k]; sc[i] = pg8::silu_f(v); }
    __syncthreads();
    float* mod = (float*)(ws + WS_MOD);
    for (int it = F.vcu; it < DEPTH * 192; it += F.G) {
        const int L = it / 192, nb = it % 192, cq = F.tid & 15, ks = F.tid >> 4;
        f32x4 a0 = {0.f, 0.f, 0.f, 0.f}, a1 = a0, a2 = a0;
        const float* wp = w_ada + ((size_t)L * DM + ks * 64) * NMOD + nb * 64 + cq * 4;
#pragma unroll 8
        for (int kk = 0; kk < 64; ++kk) { const f32x4 w = *(const GAS f32x4*)(wp + (size_t)kk * NMOD); const int k = ks * 64 + kk;
            a0 += w * sc[k]; a1 += w * sc[DM + k]; a2 += w * sc[2 * DM + k]; }
        *(LAS f32x4*)(red + (ks * 3 + 0) * 64 + cq * 4) = a0; *(LAS f32x4*)(red + (ks * 3 + 1) * 64 + cq * 4) = a1; *(LAS f32x4*)(red + (ks * 3 + 2) * 64 + cq * 4) = a2;
        __syncthreads();
        if (F.tid < 192) { const int ci = F.tid / 64, col = F.tid % 64; float s = 0.f;
#pragma unroll 8
            for (int q = 0; q < 32; ++q) s += red[(q * 3 + ci) * 64 + col];
            mod[((size_t)L * 3 + ci) * NMOD + nb * 64 + col] = s + b_ada[(size_t)L * NMOD + nb * 64 + col]; }
        __syncthreads();
    }
    LAS float* scr = (LAS float*)(F.lds + RING_OFF + F.wave * 16384);
    const int gw = F.vcu * NWAVES + F.wave, NGW = F.G * NWAVES;
    constexpr int I_QKV = 32 * 192, I_O = 32 * 64, I_GIN = 32 * 256, I_GOUT = 64 * 64, I_CIN = 32 * 192, I_COUT = 32 * 64, I_UP = 32 * 344, I_DN = 86 * 64;
    constexpr int NITEMS = 2 * I_QKV + 2 * I_O + I_GIN + I_GOUT + I_CIN + I_COUT + 4 * I_UP + 4 * I_DN;
    for (int it = gw; it < NITEMS; it += NGW) {
        int r = it;
        if (r < 2 * I_QKV) { const int j = r / I_QKV; p0_transpose_item(na_qkv + (size_t)j * DM * 6144, DM, 6144, (bf16*)(ws + WS_WQKV) + (size_t)j * 6144 * DM, false, scr, r % I_QKV, F.lane); continue; } r -= 2 * I_QKV;
        if (r < 2 * I_O) { const int j = r / I_O; p0_transpose_item(na_wo + (size_t)j * DM * DM, DM, DM, (bf16*)(ws + WS_WO) + (size_t)j * DM * DM, false, scr, r % I_O, F.lane); continue; } r -= 2 * I_O;
        if (r < I_GIN) { p0_transpose_item(gm_win, DM, 8192, (bf16*)(ws + WS_WGIN), false, scr, r, F.lane); continue; } r -= I_GIN;
        if (r < I_GOUT) { p0_transpose_item(gm_wout, GMW, DM, (bf16*)(ws + WS_WGOUT), false, scr, r, F.lane); continue; } r -= I_GOUT;
        if (r < I_CIN) { p0_transpose_item(sc_win, DM, 6144, (bf16*)(ws + WS_WCIN), false, scr, r, F.lane); continue; } r -= I_CIN;
        if (r < I_COUT) { p0_transpose_item(sc_wout, DM, DM, (bf16*)(ws + WS_WCOUT), false, scr, r, F.lane); continue; } r -= I_COUT;
        if (r < 4 * I_UP) { const int j = r / I_UP; p0_transpose_item(f_up + (size_t)j * DM * FFN2, DM, FFN2, (bf16*)(ws + WS_WUP) + (size_t)j * FFN2 * DM, true, scr, r % I_UP, F.lane); continue; } r -= 4 * I_UP;
        { const int j = r / I_DN; p0_transpose_item(f_dn + (size_t)j * FFN * DM, FFN, DM, (bf16*)(ws + WS_WDN) + (size_t)j * DM * FFN, false, scr, r % I_DN, F.lane); }
    }
    { bf16* d = (bf16*)(ws + WS_WGS); const int gt = F.vcu * NWAVES * 64 + F.tid, NT = F.G * NWAVES * 64;
      for (int i = gt; i < GMG * GMC * GMC / 2; i += NT) { const float2 v = *(const float2*)(gm_ws + 2 * (size_t)i); ((unsigned*)d)[i] = pk2(v.x, v.y); } }
}

__device__ __forceinline__ void norm_mod_phase(Frame& F, const float* xlat, const float* xctx, const float* gain, const float* shift0, const float* scale0, bf16* H, int nrows) {
    const int gw = F.vcu * NWAVES + F.wave, NGW = F.G * NWAVES;
    for (int row = gw; row < nrows; row += NGW) {
        const float* src = row < ML ? xlat + (size_t)row * DM : xctx + (size_t)(row - ML) * DM;
        const int ci = cond_of_row(row);
        const GAS f32x4* xr = (const GAS f32x4*)src + F.lane;
        f32x4 v[8]; float s = 0.f;
#pragma unroll
        for (int j = 0; j < 8; ++j) { v[j] = xr[64 * j]; s += (v[j].x * v[j].x + v[j].y * v[j].y) + (v[j].z * v[j].z + v[j].w * v[j].w); }
        const float rstd = 1.0f / sqrtf(wave_sum(s) * (1.0f / DM) + EPS);
        const f32x4* g4 = (const f32x4*)gain + F.lane; const f32x4* sh4 = (const f32x4*)(shift0 + (size_t)ci * NMOD) + F.lane; const f32x4* sc4 = (const f32x4*)(scale0 + (size_t)ci * NMOD) + F.lane;
        GAS v2u* o8 = (GAS v2u*)(H + (size_t)row * DM) + F.lane;
#pragma unroll
        for (int j = 0; j < 8; ++j) { const f32x4 y = v[j] * rstd * g4[64 * j] * (sc4[64 * j] + 1.0f) + sh4[64 * j]; v2u w; w.x = pk2(y.x, y.y); w.y = pk2(y.z, y.w); o8[64 * j] = w; }
    }
}

__device__ __forceinline__ void qknorm_phase(Frame& F, bf16* QK, const float* qg, const float* kg) {
    const int gw = F.vcu * NWAVES + F.wave, NGW = F.G * NWAVES;
    const int d0 = 8 * (F.lane & 15);
    f32x4 gq0 = *(const f32x4*)(qg + d0), gq1 = *(const f32x4*)(qg + d0 + 4), gk0 = *(const f32x4*)(kg + d0), gk1 = *(const f32x4*)(kg + d0 + 4);
    for (int row = gw; row < MT; row += NGW) {
        GAS v4u* p = (GAS v4u*)(QK + (size_t)row * 4096) + F.lane;
        v4u raw[8];
#pragma unroll
        for (int j = 0; j < 8; ++j) raw[j] = p[64 * j];
#pragma unroll
        for (int j = 0; j < 8; ++j) {
            float x[8] = {bflo(raw[j].x), bfhi(raw[j].x), bflo(raw[j].y), bfhi(raw[j].y), bflo(raw[j].z), bfhi(raw[j].z), bflo(raw[j].w), bfhi(raw[j].w)};
            float s = 0.f;
#pragma unroll
            for (int e = 0; e < 8; ++e) s += x[e] * x[e];
            s += __shfl_xor(s, 1); s += __shfl_xor(s, 2); s += __shfl_xor(s, 4); s += __shfl_xor(s, 8);
            const float rstd = 1.0f / sqrtf(s * (1.0f / HD) + EPS);
            const f32x4 g0 = j < 4 ? gq0 : gk0, g1 = j < 4 ? gq1 : gk1;
            v4u w; w.x = pk2(x[0] * rstd * g0.x, x[1] * rstd * g0.y); w.y = pk2(x[2] * rstd * g0.z, x[3] * rstd * g0.w);
            w.z = pk2(x[4] * rstd * g1.x, x[5] * rstd * g1.y); w.w = pk2(x[6] * rstd * g1.z, x[7] * rstd * g1.w);
            p[64 * j] = w;
        }
    }
}

__device__ __forceinline__ void attn_tile(const bf16* kp, const bf16* vp, const bf16x8 (&qf)[8], f32x16 (&ot)[4], float& m, float& lsum,
                                          const bool lat, const float* rpb_h, const int rowoff, const bool row_ok, const unsigned colmask, const int dcb, const float c1) {
    f32x16 S;
#pragma unroll
    for (int i = 0; i < 16; ++i) S[i] = 0.f;
#pragma unroll
    for (int s = 0; s < 8; ++s) { const bf16x8 kf = *(const GAS bf16x8*)(kp + 16 * s); S = MFMA32(kf, qf[s], S); }
    bf16x8 vf[4][2];
#pragma unroll
    for (int nb = 0; nb < 4; ++nb)
#pragma unroll
        for (int s2 = 0; s2 < 2; ++s2) { const bf16* p = vp + (size_t)(32 * nb) * MT + 16 * s2;
            const s16x4 lo = *(const GAS s16x4*)p, hi = *(const GAS s16x4*)(p + 8); vf[nb][s2] = __builtin_shufflevector(lo, hi, 0, 1, 2, 3, 4, 5, 6, 7); }
    float t[16];
    if (lat) {
#pragma unroll
        for (int i = 0; i < 16; ++i) { const int cr = (i & 3) + 8 * (i >> 2); const bool ok = row_ok && ((colmask >> i) & 1u);
            const float bv = rpb_h[ok ? rowoff + dcb + cr : 0];
            t[i] = ok ? S[i] * c1 + bv * LOG2E : -__builtin_inff(); }
    } else {
#pragma unroll
        for (int i = 0; i < 16; ++i) t[i] = S[i] * c1;
    }
    float mx = t[0];
#pragma unroll
    for (int i = 1; i < 16; ++i) mx = __builtin_fmaxf(mx, t[i]);
    mx = swap32_max(mx);
    const float mn = __builtin_fmaxf(m, mx);
    const float alpha = __builtin_amdgcn_exp2f(m - mn);
    m = mn;
    float ps = 0.f; float p[16];
#pragma unroll
    for (int i = 0; i < 16; ++i) { p[i] = __builtin_amdgcn_exp2f(t[i] - mn); ps += p[i]; }
    lsum = lsum * alpha + ps;
#pragma unroll
    for (int nb = 0; nb < 4; ++nb)
#pragma unroll
        for (int i = 0; i < 16; ++i) ot[nb][i] *= alpha;
    v4u w0, w1; w0.x = pk2(p[0], p[1]); w0.y = pk2(p[2], p[3]); w0.z = pk2(p[4], p[5]); w0.w = pk2(p[6], p[7]);
    w1.x = pk2(p[8], p[9]); w1.y = pk2(p[10], p[11]); w1.z = pk2(p[12], p[13]); w1.w = pk2(p[14], p[15]);
    const bf16x8 pf0 = __builtin_bit_cast(bf16x8, w0), pf1 = __builtin_bit_cast(bf16x8, w1);
#pragma unroll
    for (int nb = 0; nb < 4; ++nb) { ot[nb] = MFMA32(vf[nb][0], pf0, ot[nb]); ot[nb] = MFMA32(vf[nb][1], pf1, ot[nb]); }
}
__device__ __forceinline__ void attn_phase(Frame& F, const bf16* QK, const bf16* VT, bf16* O, const float* rpb, const bool ctx_out) {
    const int lane = F.lane, ql = lane & 31, h = lane >> 5;
    const int gw = F.vcu * NWAVES + F.wave, NGW = F.G * NWAVES;
    const int NU = 8192 + (ctx_out ? 256 : 0);
    const float c1 = 0.08838834764831845f * LOG2E;
    for (int u = gw; u < NU; u += NGW) {
        int b, head, qrow, qr = 0, qc = 0, cw0 = 0, rs0 = 0, rs1e = 0;
        if (u < 8192) { const int g = u & 3, rp = (u >> 2) & 63; head = (u >> 8) & 15; b = u >> 12;
            qr = 2 * rp + (ql >> 4); qc = 16 * g + (ql & 15); qrow = b * SEQ + qr * GRIDW + qc; cw0 = g == 0 ? 0 : (g == 1 ? 8 : (g == 2 ? 24 : 32));
            int a0 = 2 * rp - 4; a0 = a0 < 0 ? 0 : (a0 > GROWS - 8 ? GROWS - 8 : a0); int a1 = 2 * rp - 3; a1 = a1 < 0 ? 0 : (a1 > GROWS - 8 ? GROWS - 8 : a1); rs0 = a0; rs1e = a1 + 8; }
        else { const int u2 = u - 8192, qt = u2 & 7; head = (u2 >> 3) & 15; b = u2 >> 7; qrow = ML + CTXL * b + 32 * qt + ql; }
        int rs = qr - 4; rs = rs < 0 ? 0 : (rs > GROWS - 8 ? GROWS - 8 : rs);
        int cs = qc - 8; cs = cs < 0 ? 0 : (cs > GRIDW - 16 ? GRIDW - 16 : cs);
        unsigned colmask = 0u;
#pragma unroll
        for (int i = 0; i < 16; ++i) { const int kc = cw0 + 4 * h + (i & 3) + 8 * (i >> 2); colmask |= (kc >= cs && kc < cs + 16) ? (1u << i) : 0u; }
        const int dcb = cw0 + 4 * h - qc + 15;
        const float* rpb_h = rpb + (size_t)head * 15 * 31;
        bf16x8 qf[8];
        { const bf16* qp = QK + (size_t)qrow * 4096 + head * HD + 8 * h;
#pragma unroll
          for (int s = 0; s < 8; ++s) qf[s] = *(const GAS bf16x8*)(qp + 16 * s); }
        f32x16 ot[4];
#pragma unroll
        for (int nb = 0; nb < 4; ++nb)
#pragma unroll
            for (int i = 0; i < 16; ++i) ot[nb][i] = 0.f;
        float m = -__builtin_inff(), lsum = 0.f;
        const bf16* kbase = QK + 2048 + head * HD + 8 * h;
        const bf16* vbase = VT + (size_t)(head * HD + ql) * MT + 4 * h;
        const int crow0 = ML + CTXL * b;
        for (int t = 0; t < 8; ++t) { const int krow0 = crow0 + 32 * t;
            attn_tile(kbase + (size_t)(krow0 + ql) * 4096, vbase + krow0, qf, ot, m, lsum, false, rpb_h, 0, false, 0u, 0, c1); }
        for (int kr = rs0; kr < rs1e; ++kr) { const int krow0 = b * SEQ + kr * GRIDW + cw0;
            attn_tile(kbase + (size_t)(krow0 + ql) * 4096, vbase + krow0, qf, ot, m, lsum, true, rpb_h, (kr - qr + 7) * 31, kr >= rs && kr < rs + 8, colmask, dcb, c1); }
        const float inv = 1.0f / swap32_sum(lsum);
        bf16* op = O + (size_t)qrow * DM + head * HD + 4 * h;
#pragma unroll
        for (int nb = 0; nb < 4; ++nb)
#pragma unroll
            for (int g4 = 0; g4 < 4; ++g4) { v2u w; w.x = pk2(ot[nb][4 * g4] * inv, ot[nb][4 * g4 + 1] * inv); w.y = pk2(ot[nb][4 * g4 + 2] * inv, ot[nb][4 * g4 + 3] * inv);
                *(GAS v2u*)(op + 32 * nb + 8 * g4) = w; }
    }
}

__device__ __forceinline__ void gm_spatial_phase(Frame& F, const bf16* U, const bf16* VT, bf16* G, const bf16* WS, const float* PST, const float* vg, const float* bs) {
    const int lane = F.lane, ql = lane & 31, h = lane >> 5, w = F.wave;
    LAS float* rsd = (LAS float*)(F.lds + w * 1024);
    for (int u = F.vcu; u < (MT / GMC) * GMG; u += F.G) {
        const int c = u >> 4, g = u & 15;
#pragma unroll
        for (int tt = 0; tt < 2; ++tt) { const int tok = GMC * c + 64 * tt + lane; float s = 0.f;
#pragma unroll 8
            for (int p = 0; p < 32; ++p) s += PST[(size_t)p * MT + tok];
            rsd[64 * tt + lane] = 1.0f / sqrtf(s * (1.0f / GMW) + EPS); }
        LDS_WAIT(); asm volatile("" ::: "memory");
        bf16x8 af[8];
        { const bf16* ap = VT + (size_t)(GMGD * g + 32 * w + ql) * MT + GMC * c + 8 * h;
#pragma unroll
          for (int s = 0; s < 8; ++s) { const v4u raw = *(const GAS v4u*)(ap + 16 * s); const f32x4 r0 = *(const LAS f32x4*)(rsd + 16 * s + 8 * h), r1 = *(const LAS f32x4*)(rsd + 16 * s + 8 * h + 4);
              v4u o; o.x = pk2(bflo(raw.x) * r0.x, bfhi(raw.x) * r0.y); o.y = pk2(bflo(raw.y) * r0.z, bfhi(raw.y) * r0.w);
              o.z = pk2(bflo(raw.z) * r1.x, bfhi(raw.z) * r1.y); o.w = pk2(bflo(raw.w) * r1.z, bfhi(raw.w) * r1.w);
              af[s] = __builtin_bit_cast(bf16x8, o); } }
        f32x16 acc[4];
#pragma unroll
        for (int ib = 0; ib < 4; ++ib)
#pragma unroll
            for (int i = 0; i < 16; ++i) acc[ib][i] = 0.f;
#pragma unroll
        for (int ib = 0; ib < 4; ++ib) { const bf16* bp = WS + ((size_t)g * GMC + 32 * ib + ql) * GMC + 8 * h;
#pragma unroll
            for (int s = 0; s < 8; ++s) { const bf16x8 bfr = *(const GAS bf16x8*)(bp + 16 * s); acc[ib] = MFMA32(af[s], bfr, acc[ib]); } }
#pragma unroll
        for (int ib = 0; ib < 4; ++ib) { const int i = 32 * ib + ql; const size_t row = (size_t)GMC * c + i; const float bsv = bs[g * GMC + i];
#pragma unroll
            for (int g4 = 0; g4 < 4; ++g4) { const int col = GMGD * g + 32 * w + 8 * g4 + 4 * h; const f32x4 v4 = *(const f32x4*)(vg + col);
                const v2u uu = *(const GAS v2u*)(U + row * GMW + col);
                const float o0 = bflo(uu.x) * (v4.x * acc[ib][4 * g4] + bsv), o1 = bfhi(uu.x) * (v4.y * acc[ib][4 * g4 + 1] + bsv);
                const float o2 = bflo(uu.y) * (v4.z * acc[ib][4 * g4 + 2] + bsv), o3 = bfhi(uu.y) * (v4.w * acc[ib][4 * g4 + 3] + bsv);
                v2u wv; wv.x = pk2(o0, o1); wv.y = pk2(o2, o3); *(GAS v2u*)(G + row * GMW + col) = wv; } }
        LDS_WAIT(); asm volatile("" ::: "memory");
    }
}

__device__ __forceinline__ bool has_prev(int r) { return r < ML ? (r & (SEQ - 1)) != 0 : ((r - ML) & (CTXL - 1)) != 0; }
__device__ __forceinline__ bool has_next(int r) { return r < ML ? (r & (SEQ - 1)) != SEQ - 1 : ((r - ML) & (CTXL - 1)) != CTXL - 1; }
__device__ __forceinline__ void unpack8(const v4u r, float (&x)[8]) { x[0] = bflo(r.x); x[1] = bfhi(r.x); x[2] = bflo(r.y); x[3] = bfhi(r.y); x[4] = bflo(r.z); x[5] = bfhi(r.z); x[6] = bflo(r.w); x[7] = bfhi(r.w); }

__device__ __forceinline__ void sc_conv_phase(Frame& F, const bf16* BCX, bf16* T, const float* cw  ) {
    const int gt = F.vcu * NWAVES * 64 + F.tid, NT = F.G * NWAVES * 64;
    constexpr int RB = 16, NOC = DM / 8;
    for (int it = gt; it < (MT / RB) * NOC; it += NT) {
        const int rb = it / NOC, oc = it % NOC, c0 = 8 * oc, r0 = rb * RB;
        float w0[8], w1[8], w2[8];
#pragma unroll
        for (int e = 0; e < 8; ++e) { w0[e] = cw[c0 + e]; w1[e] = cw[DM + c0 + e]; w2[e] = cw[2 * DM + c0 + e]; }
        float pv[8], cv[8], nv[8];
        auto ld = [&](int r, float (&o)[8]) { float a[8], b[8]; unpack8(*(const GAS v4u*)(BCX + (size_t)r * 6144 + DM + c0), a); unpack8(*(const GAS v4u*)(BCX + (size_t)r * 6144 + 2 * DM + c0), b);
#pragma unroll
            for (int e = 0; e < 8; ++e) o[e] = a[e] * b[e]; };
        if (has_prev(r0)) ld(r0 - 1, pv); else {
#pragma unroll
            for (int e = 0; e < 8; ++e) pv[e] = 0.f; }
        ld(r0, cv);
        for (int i = 0; i < RB; ++i) { const int r = r0 + i;
            if (has_next(r)) ld(r + 1, nv); else {
#pragma unroll
                for (int e = 0; e < 8; ++e) nv[e] = 0.f; }
            float bg[8]; unpack8(*(const GAS v4u*)(BCX + (size_t)r * 6144 + c0), bg);
            float y[8];
#pragma unroll
            for (int e = 0; e < 8; ++e) y[e] = bg[e] * (pv[e] * w0[e] + cv[e] * w1[e] + nv[e] * w2[e]);
            v4u o; o.x = pk2(y[0], y[1]); o.y = pk2(y[2], y[3]); o.z = pk2(y[4], y[5]); o.w = pk2(y[6], y[7]);
            *(GAS v4u*)(T + (size_t)r * DM + c0) = o;
#pragma unroll
            for (int e = 0; e < 8; ++e) { pv[e] = cv[e]; cv[e] = nv[e]; } }
    }
}

__device__ __forceinline__ void ffn_act_phase(Frame& F, const bf16* Z, bf16* A, const float* cw  , const float* cb  , int nrows) {
    const int gt = F.vcu * NWAVES * 64 + F.tid, NT = F.G * NWAVES * 64;
    constexpr int RB = 16, NOC = FFN / 8;
    for (int it = gt; it < (nrows / RB) * NOC; it += NT) {
        const int rb = it / NOC, oc = it % NOC, f0 = 8 * oc, r0 = rb * RB;
        const int zg = 256 * (f0 >> 7) + (f0 & 127), zu = zg + 128;
        float wg0[8], wg1[8], wg2[8], wu0[8], wu1[8], wu2[8], bg[8], bu[8];
#pragma unroll
        for (int e = 0; e < 8; ++e) { wg0[e] = cw[f0 + e]; wg1[e] = cw[FFN2 + f0 + e]; wg2[e] = cw[2 * FFN2 + f0 + e]; bg[e] = cb[f0 + e];
            wu0[e] = cw[FFN + f0 + e]; wu1[e] = cw[FFN2 + FFN + f0 + e]; wu2[e] = cw[2 * FFN2 + FFN + f0 + e]; bu[e] = cb[FFN + f0 + e]; }
        float pg[8], cg[8], ng[8], pu[8], cu[8], nu[8];
        auto ld = [&](int r, float (&og)[8], float (&ou)[8]) { unpack8(*(const GAS v4u*)(Z + (size_t)r * FFN2 + zg), og); unpack8(*(const GAS v4u*)(Z + (size_t)r * FFN2 + zu), ou); };
        if (has_prev(r0)) ld(r0 - 1, pg, pu); else {
#pragma unroll
            for (int e = 0; e < 8; ++e) { pg[e] = 0.f; pu[e] = 0.f; } }
        ld(r0, cg, cu);
        for (int i = 0; i < RB; ++i) { const int r = r0 + i;
            if (has_next(r)) ld(r + 1, ng, nu); else {
#pragma unroll
                for (int e = 0; e < 8; ++e) { ng[e] = 0.f; nu[e] = 0.f; } }
            float y[8];
#pragma unroll
            for (int e = 0; e < 8; ++e) { const float yg = pg[e] * wg0[e] + cg[e] * wg1[e] + ng[e] * wg2[e] + bg[e]; const float yu = pu[e] * wu0[e] + cu[e] * wu1[e] + nu[e] * wu2[e] + bu[e]; y[e] = pg8::silu_f(yg) * yu; }
            v4u o; o.x = pk2(y[0], y[1]); o.y = pk2(y[2], y[3]); o.z = pk2(y[4], y[5]); o.w = pk2(y[6], y[7]);
            *(GAS v4u*)(A + (size_t)r * FFN + f0) = o;
#pragma unroll
            for (int e = 0; e < 8; ++e) { pg[e] = cg[e]; cg[e] = ng[e]; pu[e] = cu[e]; cu[e] = nu[e]; } }
    }
}

constexpr int PH_PER_LAYER = 9;
constexpr int NPHASES = 1 + DEPTH * PH_PER_LAYER;
struct Args { const float* in[N_IN]; float* out; unsigned char* ws; int ph_lo, ph_hi; };

__device__ __forceinline__ unsigned long long tab_ld(int i) {
    extern __shared__ __attribute__((aligned(16))) unsigned char lds_[];
    volatile LAS unsigned* t = (volatile LAS unsigned*)((LAS unsigned char*)lds_ + LDSCTL_OFF) + 2 * i;
    const unsigned lo = __builtin_amdgcn_readfirstlane(t[0]), hi = __builtin_amdgcn_readfirstlane(t[1]);
    return ((unsigned long long)hi << 32) | lo;
}
#define INP(i) ((const float*)tab_ld(i))
#define OUTP() ((float*)tab_ld(N_IN))
#define WSP() ((unsigned char*)tab_ld(N_IN + 1))
#define FRAME() Frame F; { extern __shared__ __attribute__((aligned(16))) unsigned char lds_[]; int t_ = threadIdx.x; asm volatile("" : "+v"(t_)); int bx_ = blockIdx.x; asm volatile("" : "+s"(bx_)); \
    F.lds = (LAS unsigned char*)lds_; F.MISC = (volatile LAS unsigned*)(F.lds + MISC_OFF); F.tid = t_; F.lane = t_ & 63; F.wave = __builtin_amdgcn_readfirstlane(t_ >> 6); \
    F.G = gridDim.x; F.vcu = (F.G % 8 == 0) ? (bx_ % 8) * (F.G / 8) + bx_ / 8 : bx_; F.ws = WSP(); F.ctl = (gu32*)(F.ws + WS_CTL); }

__global__ void __launch_bounds__(NWAVES * 64, 2) mk_fwd(Args args) {
    extern __shared__ __attribute__((aligned(16))) unsigned char lds[];
    for (int u = threadIdx.x; u < (LDS_BYTES - LDSCTL_OFF) / 4; u += NWAVES * 64) ((LAS unsigned*)((LAS unsigned char*)lds + LDSCTL_OFF))[u] = 0u;
    __syncthreads();
    if (threadIdx.x == 0) { LAS unsigned long long* t = (LAS unsigned long long*)((LAS unsigned char*)lds + LDSCTL_OFF);
#pragma unroll
        for (int i = 0; i < N_IN; ++i) t[i] = (unsigned long long)args.in[i];
        t[N_IN] = (unsigned long long)args.out; t[N_IN + 1] = (unsigned long long)args.ws; }
    __syncthreads();
    const int lo = args.ph_lo, hi = args.ph_hi;
    if (hi - lo > 1) { (void)xcd_barrier_post((unsigned*)(WSP() + WS_CTL) + CW_BAR, (volatile LAS unsigned*)((LAS unsigned char*)lds + MISC_OFF) + 8); }
#define IN(k) (lo <= (k) && (k) < hi)
#define SEAM(k) do { if (IN((k) + 1)) { XcdBarrier bar_; bar_.bar = (unsigned*)(WSP() + WS_CTL) + CW_BAR; bar_.x = xb_xcc_id(); bar_.st = (volatile LAS unsigned*)((LAS unsigned char*)lds + MISC_OFF) + 8; xcd_barrier(bar_); } } while (0)
#define WSPTRS() unsigned char* ws = F.ws; float* mod = (float*)(ws + WS_MOD); float* XA = (float*)(ws + WS_XA); float* XB = (float*)(ws + WS_XB); \
    bf16* H = (bf16*)(ws + WS_H); bf16* ACT = (bf16*)(ws + WS_ACT); float* PST = (float*)(ws + WS_PST); unsigned char* BIG = ws + WS_BIG; \
    const float* modL = mod + (size_t)L * 3 * NMOD; const float* xin_lat = L == 0 ? INP(I_X) : XA; const float* xin_ctx = L == 0 ? INP(I_CTX) : XA + (size_t)ML * DM; \
    (void)mod; (void)XA; (void)XB; (void)H; (void)ACT; (void)PST; (void)BIG; (void)modL; (void)xin_lat; (void)xin_ctx;

    if (IN(0)) {
        FRAME();
        p0_prologue(F, INP(I_C), INP(I_CCTX), INP(I_WADA), INP(I_BADA), INP(I_NAQKV), INP(I_NAWO), INP(I_GMWIN), INP(I_GMWS), INP(I_GMWOUT),
                    INP(I_SCWIN), INP(I_SCWOUT), INP(I_FUP), INP(I_FDN));
        SEAM(0);
    }
    for (int L = 0; L < DEPTH; ++L) {
        const int base = 1 + PH_PER_LAYER * L, mx = L % 3, jx = L / 3;
        const bool last = (L == DEPTH - 1);
        const int rows = last ? ML : MT;
        if (IN(base + 0)) { FRAME(); WSPTRS(); norm_mod_phase(F, xin_lat, xin_ctx, INP(I_NMG) + (size_t)L * DM, modL + 0 * DM, modL + 1 * DM, H, MT); SEAM(base + 0); }
        if (IN(base + 1)) { FRAME(); WSPTRS();
            const bf16* Wa; int Na; bf16* Oa; bool acta;
            const bf16* Wb; int Mb; bf16* Ob; bool actb, statb;
            if (mx == 0) { Wa = (const bf16*)(ws + WS_WQKV) + (size_t)jx * 6144 * DM; Na = 4096; Oa = (bf16*)(BIG + BIG_QK); acta = false;
                           Wb = Wa + (size_t)4096 * DM; Mb = 2048; Ob = (bf16*)(BIG + BIG_VT); actb = false; statb = false; }
            else if (mx == 1) { Wa = (const bf16*)(ws + WS_WGIN); Na = 4096; Oa = (bf16*)(BIG + BIG_U); acta = true;
                           Wb = Wa + (size_t)4096 * DM; Mb = 4096; Ob = (bf16*)(BIG + BIG_GVT); actb = true; statb = true; }
            else { Wa = (const bf16*)(ws + WS_WCIN); Na = 6144; Oa = (bf16*)(BIG + BIG_BCX); acta = false; Wb = nullptr; Mb = 0; Ob = nullptr; actb = false; statb = false; }
            { pg8::Gemm g{H, Wa, MT, Na, DM}; pg8::StaticOrder S; S.init(MT, Na, F.G, (int)blockIdx.x);
              pg8::EpiBf16R E{Oa, Na, nullptr, acta, false};
              pg8::gemm_phase<pg8::EpiBf16R, pg8::StaticOrder, true, true>(F.lds + RING_OFF, g, S, E); }
            if (Mb) { pg8::Gemm g{Wb, H, Mb, MT, DM}; pg8::StaticOrder S; S.init(Mb, MT, F.G, (int)blockIdx.x);
              pg8::EpiBf16R E{Ob, MT, PST, actb, statb};
              pg8::gemm_phase<pg8::EpiBf16R, pg8::StaticOrder, true, true>(F.lds + RING_OFF, g, S, E); }
            SEAM(base + 1);
        }
        if (IN(base + 2)) { FRAME(); WSPTRS(); if (mx == 0) { qknorm_phase(F, (bf16*)(BIG + BIG_QK), INP(I_NAQG) + jx * HD, INP(I_NAKG) + jx * HD); } SEAM(base + 2); }
        if (IN(base + 3)) { FRAME(); WSPTRS();
            if (mx == 0) attn_phase(F, (const bf16*)(BIG + BIG_QK), (const bf16*)(BIG + BIG_VT), (bf16*)(BIG + BIG_O), INP(I_NARPB) + (size_t)jx * NH * 15 * 31, !last);
            else if (mx == 1) gm_spatial_phase(F, (const bf16*)(BIG + BIG_U), (const bf16*)(BIG + BIG_GVT), (bf16*)(BIG + BIG_G), (const bf16*)(ws + WS_WGS), PST, INP(I_GMVG), INP(I_GMBS));
            else sc_conv_phase(F, (const bf16*)(BIG + BIG_BCX), (bf16*)(BIG + BIG_T), INP(I_SCCW));
            SEAM(base + 3);
        }
        if (IN(base + 4)) { FRAME(); WSPTRS();
            const bf16* Ao; const bf16* Wo; int Ko;
            if (mx == 0) { Ao = (const bf16*)(BIG + BIG_O); Wo = (const bf16*)(ws + WS_WO) + (size_t)jx * DM * DM; Ko = DM; }
            else if (mx == 1) { Ao = (const bf16*)(BIG + BIG_G); Wo = (const bf16*)(ws + WS_WGOUT); Ko = GMW; }
            else { Ao = (const bf16*)(BIG + BIG_T); Wo = (const bf16*)(ws + WS_WCOUT); Ko = DM; }
            pg8::Gemm g{Ao, Wo, rows, DM, Ko}; pg8::StaticOrder S; S.init(rows, DM, F.G, (int)blockIdx.x);
            pg8::EpiRes E{xin_lat, xin_ctx, XB, XB + (size_t)ML * DM, modL + 2 * DM};
            pg8::gemm_phase<pg8::EpiRes, pg8::StaticOrder, true, true>(F.lds + RING_OFF, g, S, E);
            SEAM(base + 4);
        }
        if (IN(base + 5)) { FRAME(); WSPTRS(); norm_mod_phase(F, XB, XB + (size_t)ML * DM, INP(I_NFG) + (size_t)L * DM, modL + 3 * DM, modL + 4 * DM, H, rows); SEAM(base + 5); }
        if (IN(base + 6)) { FRAME(); WSPTRS();
            pg8::Gemm g{H, (const bf16*)(ws + WS_WUP) + (size_t)L * FFN2 * DM, rows, FFN2, DM}; pg8::StaticOrder S; S.init(rows, FFN2, F.G, (int)blockIdx.x);
            pg8::EpiBf16R E{(bf16*)(BIG + BIG_Z), FFN2, nullptr, false, false};
            pg8::gemm_phase<pg8::EpiBf16R, pg8::StaticOrder, true, true>(F.lds + RING_OFF, g, S, E);
            SEAM(base + 6);
        }
        if (IN(base + 7)) { FRAME(); WSPTRS(); ffn_act_phase(F, (const bf16*)(BIG + BIG_Z), ACT, INP(I_FCW) + (size_t)L * 3 * FFN2, INP(I_FCB) + (size_t)L * FFN2, rows); SEAM(base + 7); }
        if (IN(base + 8)) { FRAME(); WSPTRS();
            pg8::Gemm g{ACT, (const bf16*)(ws + WS_WDN) + (size_t)L * DM * FFN, rows, DM, FFN}; pg8::StaticOrder S; S.init(rows, DM, F.G, (int)blockIdx.x);
            float* xo_lat = last ? OUTP() : XA;
            pg8::EpiRes E{XB, XB + (size_t)ML * DM, xo_lat, XA + (size_t)ML * DM, modL + 5 * DM};
            pg8::gemm_phase<pg8::EpiRes, pg8::StaticOrder, true, true>(F.lds + RING_OFF, g, S, E);
            SEAM(base + 8);
        }
    }
#undef IN
#undef SEAM
}

#if MK_DEBUG
__device__ __forceinline__ unsigned hash32(unsigned x) { x ^= x >> 16; x *= 0x7feb352du; x ^= x >> 15; x *= 0x846ca68bu; x ^= x >> 16; return x; }
__device__ __forceinline__ bf16 f2bf_rne(float f) { unsigned u = __float_as_uint(f); u += 0x7fffu + ((u >> 16) & 1u); return (bf16)(u >> 16); }
__device__ __forceinline__ void diag_max(unsigned* d, float e) { if (!(e == e)) e = 1e30f; atomicMax(d, __float_as_uint(e)); }
__device__ __forceinline__ float relerr(float got, float ref, float fl) { return fabsf(got - ref) / (fabsf(ref) + fl); }
__device__ __forceinline__ int pick_row(unsigned s, int nrows) {
    const int edges[16] = {0, 1, 63, 64, 255, 256, 8191, 8192, 16383, 16384, 16385, 16639, 16640, 16895, 8127, 16320};
    if ((s & 3u) == 0u) { int r = edges[(s >> 2) & 15]; return r < nrows ? r : r % nrows; }
    return (int)(hash32(s * 2654435761u + 17u) % (unsigned)nrows);
}
__device__ __forceinline__ float dot_bf(const bf16* a, const bf16* b, int K) { float s = 0.f; for (int k = 0; k < K; ++k) s += bf2f(a[k]) * bf2f(b[k]); return s; }
__device__ __forceinline__ float ref_gelu(float x) { return 0.5f * x * (1.0f + tanhf(0.7978845608f * (x + 0.044715f * x * x * x))); }
__device__ __forceinline__ float ref_silu(float x) { return x / (1.0f + expf(-x)); }

__global__ void __launch_bounds__(256) mk_check(Args args, int ph) {
    unsigned char* ws = args.ws; unsigned* dg = (unsigned*)ws + CW_DIAG + ph; unsigned* dg2 = (unsigned*)ws + CW_DIAG + 64 + ph;
    const unsigned s = blockIdx.x * blockDim.x + threadIdx.x;
    const float* mod = (const float*)(ws + WS_MOD);
    const float* XA = (const float*)(ws + WS_XA); const float* XB = (const float*)(ws + WS_XB);
    const bf16* H = (const bf16*)(ws + WS_H); const bf16* ACT = (const bf16*)(ws + WS_ACT); const float* PST = (const float*)(ws + WS_PST);
    unsigned char* BIG = ws + WS_BIG;
    if (ph == 0) {
        { const int L = s & 3, ci = (s >> 2) % 3, n = hash32(s) % NMOD; float r = 0.f;
          for (int k = 0; k < DM; ++k) { const float c = ci < 2 ? args.in[I_C][ci * DM + k] : args.in[I_CCTX][k]; r += ref_silu(c) * args.in[I_WADA][((size_t)L * DM + k) * NMOD + n]; }
          r += args.in[I_BADA][(size_t)L * NMOD + n];
          diag_max(dg, relerr(mod[((size_t)L * 3 + ci) * NMOD + n], r, 1e-2f)); }
        { const unsigned hsh = hash32(s + 77u); const int which = s % 12; const float* W; const bf16* WT; int K, N; bool perm = false; int j = (s / 12) & 3;
          switch (which) {
            case 0: case 1: j &= 1; W = args.in[I_NAQKV] + (size_t)j * DM * 6144; WT = (const bf16*)(ws + WS_WQKV) + (size_t)j * 6144 * DM; K = DM; N = 6144; break;
            case 2: j &= 1; W = args.in[I_NAWO] + (size_t)j * DM * DM; WT = (const bf16*)(ws + WS_WO) + (size_t)j * DM * DM; K = DM; N = DM; break;
            case 3: W = args.in[I_GMWIN]; WT = (const bf16*)(ws + WS_WGIN); K = DM; N = 8192; break;
            case 4: W = args.in[I_GMWOUT]; WT = (const bf16*)(ws + WS_WGOUT); K = GMW; N = DM; break;
            case 5: W = args.in[I_SCWIN]; WT = (const bf16*)(ws + WS_WCIN); K = DM; N = 6144; break;
            case 6: W = args.in[I_SCWOUT]; WT = (const bf16*)(ws + WS_WCOUT); K = DM; N = DM; break;
            case 7: case 8: case 9: W = args.in[I_FUP] + (size_t)j * DM * FFN2; WT = (const bf16*)(ws + WS_WUP) + (size_t)j * FFN2 * DM; K = DM; N = FFN2; perm = true; break;
            default: W = args.in[I_FDN] + (size_t)j * FFN * DM; WT = (const bf16*)(ws + WS_WDN) + (size_t)j * DM * FFN; K = FFN; N = DM; break; }
          const int k = hsh % K, n = (hsh >> 12) % N; int row = n;
          if (perm) row = n < FFN ? 256 * (n / 128) + n % 128 : 256 * ((n - FFN) / 128) + 128 + (n - FFN) % 128;
          diag_max(dg2, relerr(bf2f(WT[(size_t)row * K + k]), bf2f(f2bf_rne(W[(size_t)k * N + n])), 1e-6f));
          const int i = hsh % (GMG * GMC * GMC); diag_max(dg2, relerr(bf2f(((const bf16*)(ws + WS_WGS))[i]), bf2f(f2bf_rne(args.in[I_GMWS][i])), 1e-6f)); }
        return;
    }
    const int L = (ph - 1) / PH_PER_LAYER, j = (ph - 1) % PH_PER_LAYER, mx = L % 3, jx = L / 3; const bool last = L == DEPTH - 1;
    const float* modL = mod + (size_t)L * 3 * NMOD;
    const float* xin_lat = L == 0 ? args.in[I_X] : XA; const float* xin_ctx = L == 0 ? args.in[I_CTX] : XA + (size_t)ML * DM;
    const int rows = last ? ML : MT;
    if (j == 0 || j == 5) {
        const int nr = j == 0 ? MT : rows; const int r = pick_row(s, nr); const int ci = cond_of_row(r);
        const float* src = j == 0 ? (r < ML ? xin_lat + (size_t)r * DM : xin_ctx + (size_t)(r - ML) * DM) : XB + (size_t)r * DM;
        const float* gain = (j == 0 ? args.in[I_NMG] : args.in[I_NFG]) + (size_t)L * DM; const float* sh = modL + (j == 0 ? 0 : 3) * DM + (size_t)ci * NMOD; const float* sc = sh + DM;
        if (s >= 4096) return;
        float ss = 0.f; for (int k = 0; k < DM; ++k) ss += src[k] * src[k];
        const float rstd = 1.0f / sqrtf(ss / DM + EPS);
        for (int q = 0; q < 4; ++q) { const int c = hash32(s * 4 + q) % DM; const float ref = src[c] * rstd * gain[c] * (1.0f + sc[c]) + sh[c]; diag_max(dg, relerr(bf2f(H[(size_t)r * DM + c]), ref, 2e-2f)); }
        return;
    }
    if (j == 1) {
        if (s >= 8192) return;
        const bf16* Wa; int Na; const bf16* Oa; bool acta; const bf16* Wb; int Mb; const bf16* Ob; bool actb;
        if (mx == 0) { Wa = (const bf16*)(ws + WS_WQKV) + (size_t)jx * 6144 * DM; Na = 4096; Oa = (const bf16*)(BIG + BIG_QK); acta = false; Wb = Wa + (size_t)4096 * DM; Mb = 2048; Ob = (const bf16*)(BIG + BIG_VT); actb = false; }
        else if (mx == 1) { Wa = (const bf16*)(ws + WS_WGIN); Na = 4096; Oa = (const bf16*)(BIG + BIG_U); acta = true; Wb = Wa + (size_t)4096 * DM; Mb = 4096; Ob = (const bf16*)(BIG + BIG_GVT); actb = true; }
        else { Wa = (const bf16*)(ws + WS_WCIN); Na = 6144; Oa = (const bf16*)(BIG + BIG_BCX); acta = false; Wb = nullptr; Mb = 0; Ob = nullptr; actb = false; }
        const int r = pick_row(s, MT);
        { const int c = hash32(s + 5u) % Na; float ref = dot_bf(H + (size_t)r * DM, Wa + (size_t)c * DM, DM); if (acta) ref = ref_gelu(ref); diag_max(dg, relerr(bf2f(Oa[(size_t)r * Na + c]), ref, 5e-2f)); }
        if (Mb) { const int f = hash32(s + 9u) % Mb; float ref = dot_bf(H + (size_t)r * DM, Wb + (size_t)f * DM, DM); if (actb) ref = ref_gelu(ref); diag_max(dg2, relerr(bf2f(Ob[(size_t)f * MT + r]), ref, 5e-2f)); }
        if (mx == 1 && s < 512) { float s1 = 0.f, s2 = 0.f; for (int p = 0; p < 32; ++p) s1 += PST[(size_t)p * MT + r]; for (int f = 0; f < GMW; ++f) { const float v = bf2f(Ob[(size_t)f * MT + r]); s2 += v * v; }
            diag_max(dg2, 10.f * relerr(s1, s2, 1e-3f)); }
        return;
    }
    if (j == 2) {
        if (mx != 0 || s >= 8192) return;
        const bf16* QK = (const bf16*)(BIG + BIG_QK); const int r = pick_row(s, MT), hh = hash32(s + 3u) % 32; const float* g = (hh < 16 ? args.in[I_NAQG] : args.in[I_NAKG]) + jx * HD;
        float ss = 0.f; for (int d = 0; d < HD; ++d) { const float v = bf2f(QK[(size_t)r * 4096 + hh * HD + d]) / g[d]; ss += v * v; }
        diag_max(dg, fabsf(ss / HD - 1.0f));
        return;
    }
    if (j == 3) {
        if (mx == 0) {
            if (s >= 2048) return;
            const bf16* QK = (const bf16*)(BIG + BIG_QK); const bf16* VT = (const bf16*)(BIG + BIG_VT); const bf16* O = (const bf16*)(BIG + BIG_O);
            const int r = pick_row(s, last ? ML : MT), head = hash32(s + 11u) % NH; const float* rpb = args.in[I_NARPB] + ((size_t)jx * NH + head) * 15 * 31;
            const bf16* q = QK + (size_t)r * 4096 + head * HD; const float scale = 0.08838834764831845f;
            const int b = r < ML ? r / SEQ : (r - ML) / CTXL; const int d0 = hash32(s + 13u) % HD, d1 = (d0 + 37) % HD;
            float mxv = -1e30f, l = 0.f, o0 = 0.f, o1 = 0.f;
            for (int pass = 0; pass < 2; ++pass) {
                if (r < ML) { const int pos = r % SEQ, qr = pos / GRIDW, qc = pos % GRIDW; int rs = qr - 4; rs = rs < 0 ? 0 : (rs > 120 ? 120 : rs); int cs = qc - 8; cs = cs < 0 ? 0 : (cs > 48 ? 48 : cs);
                    for (int kr = rs; kr < rs + 8; ++kr) for (int kc = cs; kc < cs + 16; ++kc) { const int krow = b * SEQ + kr * GRIDW + kc;
                        const float sc = dot_bf(q, QK + (size_t)krow * 4096 + 2048 + head * HD, HD) * scale + rpb[(kr - qr + 7) * 31 + (kc - qc + 15)];
                        if (pass == 0) mxv = fmaxf(mxv, sc); else { const float p = expf(sc - mxv); l += p; o0 += p * bf2f(VT[(size_t)(head * HD + d0) * MT + krow]); o1 += p * bf2f(VT[(size_t)(head * HD + d1) * MT + krow]); } } }
                for (int kk = 0; kk < CTXL; ++kk) { const int krow = ML + b * CTXL + kk; const float sc = dot_bf(q, QK + (size_t)krow * 4096 + 2048 + head * HD, HD) * scale;
                    if (pass == 0) mxv = fmaxf(mxv, sc); else { const float p = expf(sc - mxv); l += p; o0 += p * bf2f(VT[(size_t)(head * HD + d0) * MT + krow]); o1 += p * bf2f(VT[(size_t)(head * HD + d1) * MT + krow]); } }
            }
            diag_max(dg, relerr(bf2f(O[(size_t)r * DM + head * HD + d0]), o0 / l, 2e-2f)); diag_max(dg, relerr(bf2f(O[(size_t)r * DM + head * HD + d1]), o1 / l, 2e-2f));
        } else if (mx == 1) {
            if (s >= 8192) return;
            const bf16* U = (const bf16*)(BIG + BIG_U); const bf16* VT = (const bf16*)(BIG + BIG_GVT); const bf16* G = (const bf16*)(BIG + BIG_G); const bf16* WS = (const bf16*)(ws + WS_WGS);
            const int r = pick_row(s, MT), col = hash32(s + 21u) % GMW, c = r / GMC, i = r % GMC, g = col / GMGD; float acc = 0.f;
            for (int jj = 0; jj < GMC; ++jj) { const int tok = c * GMC + jj; float s1 = 0.f; for (int p = 0; p < 32; ++p) s1 += PST[(size_t)p * MT + tok]; const float rstd = 1.0f / sqrtf(s1 / GMW + EPS);
                acc += bf2f(WS[((size_t)g * GMC + i) * GMC + jj]) * bf2f(VT[(size_t)col * MT + tok]) * rstd; }
            const float ref = bf2f(U[(size_t)r * GMW + col]) * (args.in[I_GMVG][col] * acc + args.in[I_GMBS][g * GMC + i]);
            diag_max(dg, relerr(bf2f(G[(size_t)r * GMW + col]), ref, 3e-2f));
        } else {
            if (s >= 16384) return;
            const bf16* BCX = (const bf16*)(BIG + BIG_BCX); const bf16* T = (const bf16*)(BIG + BIG_T); const float* cw = args.in[I_SCCW];
            const int r = pick_row(s, MT), c = hash32(s + 31u) % DM; float y = 0.f;
            for (int t = 0; t < 3; ++t) { const int rr = r + t - 1; const bool ok = t == 1 || (t == 0 ? has_prev(r) : has_next(r)); if (ok) y += cw[t * DM + c] * bf2f(BCX[(size_t)rr * 6144 + DM + c]) * bf2f(BCX[(size_t)rr * 6144 + 2 * DM + c]); }
            y *= bf2f(BCX[(size_t)r * 6144 + c]);
            diag_max(dg, relerr(bf2f(T[(size_t)r * DM + c]), y, 2e-2f));
        }
        return;
    }
    if (j == 4 || j == 8) {
        if (s >= 8192) return;
        const bf16* Ao; const bf16* Wo; int Ko; const float* xi; const float* xo; const float* gate;
        const int r = pick_row(s, rows), c = hash32(s + 41u) % DM, ci = cond_of_row(r);
        if (j == 4) { if (mx == 0) { Ao = (const bf16*)(BIG + BIG_O); Wo = (const bf16*)(ws + WS_WO) + (size_t)jx * DM * DM; Ko = DM; } else if (mx == 1) { Ao = (const bf16*)(BIG + BIG_G); Wo = (const bf16*)(ws + WS_WGOUT); Ko = GMW; } else { Ao = (const bf16*)(BIG + BIG_T); Wo = (const bf16*)(ws + WS_WCOUT); Ko = DM; }
            xi = r < ML ? xin_lat + (size_t)r * DM : xin_ctx + (size_t)(r - ML) * DM; xo = XB + (size_t)r * DM; gate = modL + 2 * DM + (size_t)ci * NMOD; }
        else { Ao = ACT; Wo = (const bf16*)(ws + WS_WDN) + (size_t)L * DM * FFN; Ko = FFN; xi = XB + (size_t)r * DM; xo = (last ? args.out : (float*)XA) + (size_t)r * DM; gate = modL + 5 * DM + (size_t)ci * NMOD; }
        const float d = dot_bf(Ao + (size_t)r * Ko, Wo + (size_t)c * Ko, Ko); const float ref = xi[c] + gate[c] * d;
        diag_max(dg, fabsf(xo[c] - ref) / (fabsf(gate[c] * d) + 2e-2f));
        return;
    }
    if (j == 6) {
        if (s >= 8192) return;
        const int r = pick_row(s, rows), c = hash32(s + 51u) % FFN2; const bf16* Z = (const bf16*)(BIG + BIG_Z);
        const float ref = dot_bf(H + (size_t)r * DM, (const bf16*)(ws + WS_WUP) + ((size_t)L * FFN2 + c) * DM, DM);
        diag_max(dg, relerr(bf2f(Z[(size_t)r * FFN2 + c]), ref, 5e-2f));
        return;
    }
    if (j == 7) {
        if (s >= 16384) return;
        const int r = pick_row(s, rows), f = hash32(s + 61u) % FFN; const bf16* Z = (const bf16*)(BIG + BIG_Z); const float* cw = args.in[I_FCW] + (size_t)L * 3 * FFN2; const float* cb = args.in[I_FCB] + (size_t)L * FFN2;
        const int zg = 256 * (f / 128) + f % 128, zu = zg + 128; float yg = cb[f], yu = cb[FFN + f];
        for (int t = 0; t < 3; ++t) { const int rr = r + t - 1; const bool ok = t == 1 || (t == 0 ? has_prev(r) : has_next(r)); if (ok) { yg += cw[t * FFN2 + f] * bf2f(Z[(size_t)rr * FFN2 + zg]); yu += cw[t * FFN2 + FFN + f] * bf2f(Z[(size_t)rr * FFN2 + zu]); } }
        diag_max(dg, relerr(bf2f(ACT[(size_t)r * FFN + f]), ref_silu(yg) * yu, 2e-2f));
        return;
    }
}
__global__ void mk_diag_final(Args args) {
    const unsigned* d = (const unsigned*)args.ws + CW_DIAG; const unsigned* bar = (const unsigned*)args.ws + CW_BAR;
    if (threadIdx.x == 0 && blockIdx.x == 0) {
        for (int p = 0; p < NPHASES; ++p) { const float e1 = __uint_as_float(d[p]), e2 = __uint_as_float(d[64 + p]);
            if (e1 > 0.05f) { args.out[0] = (10.f + p) * 1e3f * (e1 > 0.5f ? 100.f : 1.f); return; }
            if (e2 > 0.05f) { args.out[0] = (10.f + p) * 1e6f * (e2 > 0.5f ? 100.f : 1.f); return; } }
        if (bar[XB_TMO] != 0u) args.out[0] = 7.7e12f;
    }
}
#endif

extern "C" void kernel_launch(void* const* d_in, const int* in_sizes, int n_in, void* d_out, int out_size, void* d_ws, size_t ws_size, hipStream_t stream) {
    static int grid = 0;
    if (grid == 0) {
        if (n_in != N_IN || in_sizes[0] != ML * DM || out_size != ML * DM || ws_size < WS_END) {
            fprintf(stderr, "kernel_launch: unexpected problem: n_in %d in0 %d out %d ws %zu (need %zu); nothing launched\n", n_in, n_in > 0 ? in_sizes[0] : -1, out_size, ws_size, (size_t)WS_END); grid = -1; return; }
        int dev = 0, cus = 0, per_cu = 0;
        if (hipGetDevice(&dev) != hipSuccess || hipDeviceGetAttribute(&cus, hipDeviceAttributeMultiprocessorCount, dev) != hipSuccess) { grid = -1; return; }
        if (hipFuncSetAttribute((const void*)mk_fwd, hipFuncAttributeMaxDynamicSharedMemorySize, LDS_BYTES) != hipSuccess) { fprintf(stderr, "kernel_launch: hipFuncSetAttribute failed\n"); grid = -1; return; }
        if (hipOccupancyMaxActiveBlocksPerMultiprocessor(&per_cu, (const void*)mk_fwd, NWAVES * 64, LDS_BYTES) != hipSuccess || per_cu < 1) { fprintf(stderr, "kernel_launch: occupancy query says %d blocks per CU\n", per_cu); }
        (void)hipGetLastError();
        grid = cus;
    }
    if (grid < 0) return;
    if (hipMemsetAsync((char*)d_ws + WS_CTL, 0, CTL_ZERO_BYTES, stream) != hipSuccess) return;
    Args a{};
    for (int i = 0; i < N_IN; ++i) a.in[i] = (const float*)d_in[i];
    a.out = (float*)d_out; a.ws = (unsigned char*)d_ws;
#if MK_DEBUG
    for (int ph = 0; ph < NPHASES; ++ph) {
        a.ph_lo = ph; a.ph_hi = ph + 1;
        hipLaunchKernelGGL(mk_fwd, dim3(grid), dim3(NWAVES * 64), LDS_BYTES, stream, a);
        hipLaunchKernelGGL(mk_check, dim3(128), dim3(256), 0, stream, a, ph);
    }
    hipLaunchKernelGGL(mk_diag_final, dim3(1), dim3(64), 0, stream, a);
#else
    a.ph_lo = 0; a.ph_hi = NPHASES;
    hipLaunchKernelGGL(mk_fwd, dim3(grid), dim3(NWAVES * 64), LDS_BYTES, stream, a);
#endif
    const hipError_t le = hipPeekAtLastError();
    if (le != hipSuccess) fprintf(stderr, "kernel_launch: launch failed: %s\n", hipGetErrorName(le));
}
```

```cpp
#include <hip/hip_runtime.h>
#include <cstdio>
#include <cstdint>

#ifndef MK_STAMP
#define MK_STAMP 0
#endif
#ifndef MK_STAMP_SEL
#define MK_STAMP_SEL 0
#endif
#ifndef MK_REPS
#define MK_REPS 0
#endif
#ifndef MK_REPL
#define MK_REPL 15
#endif
enum { MK_RB_PRO = 0, MK_RB_NORM = 1, MK_RB_GIN = 2, MK_RB_CORE = 3, MK_RB_GOUT = 4, MK_RB_UP = 5, MK_RB_ACT = 6, MK_RB_DOWN = 7 };
#define REPN(bit) (1 + (((MK_REPS >> (bit)) & 1) & ((MK_REPL >> L) & 1)))
#ifndef MK_STAGGER_TICKS
#define MK_STAGGER_TICKS 0
#endif
#ifndef MK_DOUBLE_BAR
#define MK_DOUBLE_BAR 0
#endif
#ifndef MK_DEFER_CONVERT
#define MK_DEFER_CONVERT 1
#endif
#ifndef MK_DS1
#define MK_DS1 128
#endif
#ifndef MK_DS2
#define MK_DS2 128
#endif
#ifndef MK_DS3
#define MK_DS3 256
#endif
#ifndef MK_DOWN_REV
#define MK_DOWN_REV false
#endif
#ifndef MK_WGM_UP
#define MK_WGM_UP 4
#endif
#ifndef MK_WGM_OUT
#define MK_WGM_OUT 4
#endif
#ifndef MK_WGM_DOWN
#define MK_WGM_DOWN 8
#endif
#ifndef MK_WGM_IN0
#define MK_WGM_IN0 4
#endif
#ifndef MK_WGM_IN1
#define MK_WGM_IN1 4
#endif
#ifndef MK_EPI_PROBE
#define MK_EPI_PROBE 0
#endif
#ifndef MK_RES_BF16
#define MK_RES_BF16 1
#endif
#ifndef MK_NT_B
#define MK_NT_B 0
#endif
#ifndef MK_XSTAG_UP
#define MK_XSTAG_UP 0
#endif
#ifndef MK_XSTAG_IN
#define MK_XSTAG_IN 0
#endif
#ifndef MK_FFN_LD
#define MK_FFN_LD 6144
#endif
#ifndef MK_FFN_HALVES
#define MK_FFN_HALVES 0
#endif
namespace pg8 {
#define PG8_LAS __attribute__((address_space(3)))
typedef unsigned short bf16_t;
typedef short bf16x8 __attribute__((ext_vector_type(8)));
typedef float f32x4 __attribute__((ext_vector_type(4)));
typedef unsigned u32x4 __attribute__((ext_vector_type(4)));
constexpr int BM = 256, BK = 64, HALF = 128, HTB = HALF * BK * 2  , STAGE_BYTES = 8 * HTB, NXCD = 8, WGM = 4;

__host__ __device__ __forceinline__ int lds_byte(int r, int c) { const int st = (r >> 4) * 2 + (c >> 5), rr = r & 15, cc = c & 31, ob = rr * 64 + cc * 2; return st * 1024 + (ob ^ (((ob >> 9) & 1) << 5)); }
__host__ __device__ __forceinline__ void stage_rc(int b, int& R, int& C) { const int st = b / 1024, sb = b % 1024, swz = sb ^ (((sb >> 9) & 1) << 5); R = (st >> 1) * 16 + swz / 64; C = (st & 1) * 32 + (swz % 64) / 2; }
__host__ __device__ __forceinline__ int perm32(int rho) { const int n = rho >> 4, i = rho & 15; return 8 * (i >> 2) + 4 * n + (i & 3); }

struct Unit { int pm, pn, kt0, ktn, ks, which; };
struct Gemm { const bf16_t* A; const bf16_t* Bt; int M, N, K; int panel_rows; const bf16_t* A2; const bf16_t* Bt2; int ldk; };

struct StaticOrder {
    int nM, nN, nwg, G, c, wgm, pm0;
    __host__ __device__ void init(int M, int N, int G_, int c_) { nM = M / BM; nN = N / BM; nwg = nM * nN; G = G_; c = c_; wgm = WGM; pm0 = 0; }
    __host__ __device__ __forceinline__ bool next(int i, Unit& u) const {
        const long L = (long)i * G + c; if (L >= nwg) return false;
        int wgid = (int)L; { const int q = nwg / NXCD, r = nwg % NXCD, xcd = wgid % NXCD, off = wgid / NXCD; wgid = (xcd < r ? xcd * (q + 1) : r * (q + 1) + (xcd - r) * q) + off; }
        const int nig = wgm * nN, gid = wgid / nig, fm = gid * wgm, gsz = (nM - fm) < wgm ? (nM - fm) : wgm;
        u.pm = pm0 + fm + ((wgid % nig) % gsz); u.pn = (wgid % nig) / gsz; u.kt0 = 0; u.ktn = 0; u.ks = -1; u.which = 0; return true;
    }
    __device__ __forceinline__ void a_ready(const Unit&) const {}
    __device__ __forceinline__ void done(const Unit&) const {}
};

struct SplitOrder {
    StaticOrder lat; int nN, S, C, G, c, nlat, nctx; bool rev;
    __host__ __device__ void init(int N, int K, int S_, bool has_ctx, int G_, int c_, int nlatp = 64, int pm0_ = 0) { lat.init(nlatp * BM, N, G_, c_); lat.pm0 = pm0_; nN = N / BM; S = S_; C = K / 128; G = G_; c = c_; nlat = nlatp * nN; nctx = has_ctx ? 2 * nN * S : 0; rev = false; }
    __host__ __device__ __forceinline__ bool next(int i, Unit& u) const {
        const long L = (long)i * G + c;
        if (L < nlat) { const bool ok = lat.next(i, u); if (rev) u.pm = 63 - u.pm; return ok; }
        const int r = (int)(L - nlat); if (r >= nctx) return false;
        const int ks = r % S, q = r / S; u.pn = q % nN; u.pm = 64 + q / nN;
        const int c0 = (C * ks) / S, c1 = (C * (ks + 1)) / S; u.kt0 = 2 * c0; u.ktn = 2 * (c1 - c0); u.ks = ks; u.which = 0; return true;
    }
    __device__ __forceinline__ void a_ready(const Unit&) const {}
    __device__ __forceinline__ void done(const Unit&) const {}
};

__host__ __device__ __forceinline__ void static_map(int nM, int nN, int L, int& pm, int& pn, int wgm) {
    const int nwg = nM * nN; int wgid = L; { const int q = nwg / NXCD, r = nwg % NXCD, xcd = wgid % NXCD, off = wgid / NXCD; wgid = (xcd < r ? xcd * (q + 1) : r * (q + 1) + (xcd - r) * q) + off; }
    const int nig = wgm * nN, gid = wgid / nig, fm = gid * wgm, gsz = (nM - fm) < wgm ? (nM - fm) : wgm;
    pm = fm + ((wgid % nig) % gsz); pn = (wgid % nig) / gsz;
}
struct DualOrder {
    int nN0, nM1, G, c, n0, n1, c0, wgm0, wgm1;
    __host__ __device__ __forceinline__ void init(int N0, int M1, int G_, int c_) { nN0 = N0 / BM; nM1 = M1 / BM; G = G_; c = c_; n0 = 64 * nN0; n1 = 64 * nM1; c0 = 2 * nN0; wgm0 = WGM; wgm1 = WGM; }
    __host__ __device__ __forceinline__ bool next(int i, Unit& u) const {
        int L = i * G + c; int pm = 0, pn = 0, wh = 0; bool ok = true;
        if (L < n0) { static_map(64, nN0, L, pm, pn, wgm0); wh = 0; }
        else if (L < n0 + n1) { static_map(nM1, 64, L - n0, pm, pn, wgm1); wh = 1; }
        else if (L < n0 + n1 + c0) { const int r = L - n0 - n1; pm = 64 + r / nN0; pn = r % nN0; wh = 0; }
        else if (L < n0 + n1 + c0 + 2 * nM1) { const int r = L - n0 - n1 - c0; pm = r % nM1; pn = 64 + r / nM1; wh = 1; }
        else ok = false;
        u.pm = pm; u.pn = pn; u.kt0 = 0; u.ktn = 0; u.ks = -1; u.which = wh; return ok;
    }
    __device__ __forceinline__ void a_ready(const Unit&) const {}
    __device__ __forceinline__ void done(const Unit&) const {}
};

typedef __bf16 bf16v2 __attribute__((ext_vector_type(2)));
typedef float f32x2 __attribute__((ext_vector_type(2)));
__device__ __forceinline__ unsigned cvt_pk_bf16(float lo, float hi) { const f32x2 v = {lo, hi}; return __builtin_bit_cast(unsigned, __builtin_convertvector(v, bf16v2)); }

__device__ __forceinline__ float gelu_tanh(float x) {
    const float y2 = x * (1.5957691216f + 0.0713548163f * x * x);
    return x * __builtin_amdgcn_rcpf(1.0f + __builtin_amdgcn_exp2f(-1.4426950409f * y2));
}
template <int CTRL> __device__ __forceinline__ float dpp(float x) { return __builtin_bit_cast(float, __builtin_amdgcn_mov_dpp(__builtin_bit_cast(int, x), CTRL, 0xf, 0xf, true)); }
__device__ __forceinline__ float row16_sum(float s) { s += dpp<0xB1>(s); s += dpp<0x4E>(s); s += dpp<0x141>(s); s += dpp<0x128>(s); return s; }
__device__ __forceinline__ float xrow16_sum(float x) {
    auto s = __builtin_amdgcn_permlane16_swap(__float_as_uint(x), __float_as_uint(x), false, false); x = __uint_as_float(s[0]) + __uint_as_float(s[1]);
    auto t = __builtin_amdgcn_permlane32_swap(__float_as_uint(x), __float_as_uint(x), false, false); return __uint_as_float(t[0]) + __uint_as_float(t[1]);
}
__device__ __forceinline__ float silu_f(float x) { return x * __builtin_amdgcn_rcpf(1.0f + __builtin_amdgcn_exp2f(-1.4426950409f * x)); }

template <int MODE, bool ACT, bool STATS> struct EpiBf16T {
    static constexpr bool PERM = true, AFTER_DRAIN = false, PERM_A = false, PROBE_TWICE = false, NT_B = false;
    bf16_t* O; int ldc; float* P; PG8_LAS float* part; const float* qg; const float* kg;
    __device__ __forceinline__ void operator()(const f32x4 (&acc)[2][2][4][2], const Unit& u, int wr, int wc, int fr, int fq) const {
        const int row0 = u.pm * BM + wr * 64 + fr; const int col0 = u.pn * BM + wc * 32 + 8 * fq;
        float ss[2][2][4];
        if (STATS) {
#pragma unroll
            for (int bj = 0; bj < 2; ++bj)
#pragma unroll
                for (int n = 0; n < 2; ++n)
#pragma unroll
                    for (int e = 0; e < 4; ++e) ss[bj][n][e] = 0.f;
        }
        f32x4 gn0 = {1.f, 1.f, 1.f, 1.f}, gn1 = gn0;
        if (MODE == 1) {
#pragma unroll
            for (int ai = 0; ai < 2; ++ai)
#pragma unroll
                for (int m = 0; m < 4; ++m)
#pragma unroll
                    for (int bj = 0; bj < 2; ++bj) { const f32x4 a = acc[ai][bj][m][0], b = acc[ai][bj][m][1];
                        float sq = (a[0] * a[0] + a[1] * a[1]) + (a[2] * a[2] + a[3] * a[3]) + (b[0] * b[0] + b[1] * b[1]) + (b[2] * b[2] + b[3] * b[3]);
                        sq = xrow16_sum(sq);
                        if (fq == 0) part[(ai * HALF + wr * 64 + m * 16 + fr) * 8 + bj * 4 + wc] = sq; }
            asm volatile("s_waitcnt lgkmcnt(0)" ::: "memory"); __builtin_amdgcn_s_barrier(); asm volatile("" ::: "memory");
            const float* gp = (u.pn < 8 ? qg : kg) + wc * 32 + 8 * fq; gn0 = *(const f32x4*)gp; gn1 = *(const f32x4*)(gp + 4);
        }
#pragma unroll
        for (int ai = 0; ai < 2; ++ai)
#pragma unroll
            for (int m = 0; m < 4; ++m) { const int row = row0 + ai * HALF + m * 16; bf16_t* rowp = O + (size_t)row * ldc + col0;
#pragma unroll
                for (int bj = 0; bj < 2; ++bj) { f32x4 v0 = acc[ai][bj][m][0], v1 = acc[ai][bj][m][1];
                    bf16_t* dst = rowp + bj * HALF;
                    if (MODE == 1) dst = O + ((size_t)((2 * u.pn + bj) * 8 + 2 * wc + (fq >> 1)) * ldc + row) * 16 + 8 * (fq & 1);
                    if (MODE == 3) { const int tok = col0 + bj * HALF; dst = O + ((size_t)((row >> 5) * (ldc >> 4) + (tok >> 4)) * 32 + (row & 31)) * 16 + (tok & 8); }
                    if (MODE == 2) { const int tok = col0 + bj * HALF; dst = O + ((size_t)((row >> 7) * (ldc >> 3) + (tok >> 3)) * 128 + (row & 127)) * 8; }
                    if (ACT == 1) {
#pragma unroll
                        for (int e = 0; e < 4; ++e) { v0[e] = gelu_tanh(v0[e]); v1[e] = gelu_tanh(v1[e]); } }
                    if (STATS) {
#pragma unroll
                        for (int e = 0; e < 4; ++e) { ss[bj][0][e] += v0[e] * v0[e]; ss[bj][1][e] += v1[e] * v1[e]; } }
                    if (MODE == 1) { const f32x4 p4 = *(const PG8_LAS f32x4*)(part + (ai * HALF + wr * 64 + m * 16 + fr) * 8 + bj * 4);
                        const float rsd = __builtin_amdgcn_rsqf(((p4[0] + p4[1]) + (p4[2] + p4[3])) * (1.0f / 128.0f) + 1e-6f); v0 = v0 * rsd * gn0; v1 = v1 * rsd * gn1; }
                    u32x4 w; w.x = cvt_pk_bf16(v0[0], v0[1]); w.y = cvt_pk_bf16(v0[2], v0[3]); w.z = cvt_pk_bf16(v1[0], v1[1]); w.w = cvt_pk_bf16(v1[2], v1[3]);
                    *(u32x4*)dst = w; } }
        if (STATS) {
#pragma unroll
            for (int bj = 0; bj < 2; ++bj)
#pragma unroll
                for (int n = 0; n < 2; ++n)
#pragma unroll
                    for (int e = 0; e < 4; ++e) { ss[bj][n][e] = row16_sum(ss[bj][n][e]); }
            if (fr == 0) {
                float* pp = P + (size_t)(2 * u.pm + wr) * ldc + col0;
#pragma unroll
                for (int bj = 0; bj < 2; ++bj) { *(f32x4*)(pp + bj * HALF) = (f32x4){ss[bj][0][0], ss[bj][0][1], ss[bj][0][2], ss[bj][0][3]};
                                                 *(f32x4*)(pp + bj * HALF + 4) = (f32x4){ss[bj][1][0], ss[bj][1][1], ss[bj][1][2], ss[bj][1][3]}; }
            }
        }
    }
};

struct EpiBf16R {
    static constexpr bool PERM = true, AFTER_DRAIN = false, PERM_A = false, PROBE_TWICE = false, NT_B = false;
    bf16_t* O; int ldc; float* P; bool ACT, STATS; int MODE; PG8_LAS float* part; const float* qg; const float* kg;
    __device__ __forceinline__ void operator()(const f32x4 (&acc)[2][2][4][2], const Unit& u, int wr, int wc, int fr, int fq) const {
        const int row0 = u.pm * BM + wr * 64 + fr; const int col0 = u.pn * BM + wc * 32 + 8 * fq;
        float ss[2][2][4];
        if (STATS) {
#pragma unroll
            for (int bj = 0; bj < 2; ++bj)
#pragma unroll
                for (int n = 0; n < 2; ++n)
#pragma unroll
                    for (int e = 0; e < 4; ++e) ss[bj][n][e] = 0.f;
        }
        f32x4 gn0 = {1.f, 1.f, 1.f, 1.f}, gn1 = gn0;
        if (MODE == 1) {
#pragma unroll
            for (int ai = 0; ai < 2; ++ai)
#pragma unroll
                for (int m = 0; m < 4; ++m)
#pragma unroll
                    for (int bj = 0; bj < 2; ++bj) { const f32x4 a = acc[ai][bj][m][0], b = acc[ai][bj][m][1];
                        float sq = (a[0] * a[0] + a[1] * a[1]) + (a[2] * a[2] + a[3] * a[3]) + (b[0] * b[0] + b[1] * b[1]) + (b[2] * b[2] + b[3] * b[3]);
                        sq = xrow16_sum(sq);
                        if (fq == 0) part[(ai * HALF + wr * 64 + m * 16 + fr) * 8 + bj * 4 + wc] = sq; }
            asm volatile("s_waitcnt lgkmcnt(0)" ::: "memory"); __builtin_amdgcn_s_barrier(); asm volatile("" ::: "memory");
            const float* gp = (u.pn < 8 ? qg : kg) + wc * 32 + 8 * fq; gn0 = *(const f32x4*)gp; gn1 = *(const f32x4*)(gp + 4);
        }
#pragma unroll
        for (int ai = 0; ai < 2; ++ai)
#pragma unroll
            for (int m = 0; m < 4; ++m) { const int row = row0 + ai * HALF + m * 16; bf16_t* rowp = O + (size_t)row * ldc + col0;
#pragma unroll
                for (int bj = 0; bj < 2; ++bj) { f32x4 v0 = acc[ai][bj][m][0], v1 = acc[ai][bj][m][1];
                    bf16_t* dst = rowp + bj * HALF;
                    if (MODE == 1) dst = O + ((size_t)((2 * u.pn + bj) * 8 + 2 * wc + (fq >> 1)) * ldc + row) * 16 + 8 * (fq & 1);
                    if (MODE == 3) { const int tok = col0 + bj * HALF; dst = O + ((size_t)((row >> 5) * (ldc >> 4) + (tok >> 4)) * 32 + (row & 31)) * 16 + (tok & 8); }
                    if (MODE == 2) { const int tok = col0 + bj * HALF; dst = O + ((size_t)((row >> 7) * (ldc >> 3) + (tok >> 3)) * 128 + (row & 127)) * 8; }
                    if (ACT == 1) {
#pragma unroll
                        for (int e = 0; e < 4; ++e) { v0[e] = gelu_tanh(v0[e]); v1[e] = gelu_tanh(v1[e]); } }
                    if (STATS) {
#pragma unroll
                        for (int e = 0; e < 4; ++e) { ss[bj][0][e] += v0[e] * v0[e]; ss[bj][1][e] += v1[e] * v1[e]; } }
                    if (MODE == 1) { const f32x4 p4 = *(const PG8_LAS f32x4*)(part + (ai * HALF + wr * 64 + m * 16 + fr) * 8 + bj * 4);
                        const float rsd = 1.0f / sqrtf(((p4[0] + p4[1]) + (p4[2] + p4[3])) * (1.0f / 128.0f) + 1e-6f); v0 = v0 * rsd * gn0; v1 = v1 * rsd * gn1; }
                    u32x4 w; w.x = cvt_pk_bf16(v0[0], v0[1]); w.y = cvt_pk_bf16(v0[2], v0[3]); w.z = cvt_pk_bf16(v1[0], v1[1]); w.w = cvt_pk_bf16(v1[2], v1[3]);
                    *(u32x4*)dst = w; } }
        if (STATS) {
#pragma unroll
            for (int bj = 0; bj < 2; ++bj)
#pragma unroll
                for (int n = 0; n < 2; ++n)
#pragma unroll
                    for (int e = 0; e < 4; ++e) { ss[bj][n][e] = row16_sum(ss[bj][n][e]); }
            if (fr == 0) {
                float* pp = P + (size_t)(2 * u.pm + wr) * ldc + col0;
#pragma unroll
                for (int bj = 0; bj < 2; ++bj) { *(f32x4*)(pp + bj * HALF) = (f32x4){ss[bj][0][0], ss[bj][0][1], ss[bj][0][2], ss[bj][0][3]};
                                                 *(f32x4*)(pp + bj * HALF + 4) = (f32x4){ss[bj][1][0], ss[bj][1][1], ss[bj][1][2], ss[bj][1][3]}; }
            }
        }
    }
};

__device__ __forceinline__ void bf8_to_f32(const u32x4 r, f32x4& lo, f32x4& hi) {
    lo = (f32x4){__uint_as_float(r.x << 16), __uint_as_float(r.x & 0xffff0000u), __uint_as_float(r.y << 16), __uint_as_float(r.y & 0xffff0000u)};
    hi = (f32x4){__uint_as_float(r.z << 16), __uint_as_float(r.z & 0xffff0000u), __uint_as_float(r.w << 16), __uint_as_float(r.w & 0xffff0000u)};
}
template <bool IN32, bool OUT32> struct EpiResT {
    static constexpr bool PERM = true, AFTER_DRAIN = false, PERM_A = false, PROBE_TWICE = false, NT_B = (MK_NT_B & 2) != 0;
    const void* xin_lat; const void* xin_ctx; void* xout_lat; void* xout_ctx; const float* gate; float* slab;
    __device__ __forceinline__ void operator()(const f32x4 (&acc)[2][2][4][2], const Unit& u, int wr, int wc, int fr, int fq) const {
        const int col0 = u.pn * BM + wc * 32 + 8 * fq;
        if (u.ks >= 0) {
            float* sp = slab + ((size_t)u.ks * 512 + (u.pm - 64) * BM + wr * 64 + fr) * 2048 + col0;
#pragma unroll
            for (int ai = 0; ai < 2; ++ai)
#pragma unroll
                for (int m = 0; m < 4; ++m)
#pragma unroll
                    for (int bj = 0; bj < 2; ++bj)
#pragma unroll
                        for (int n = 0; n < 2; ++n) *(f32x4*)(sp + (size_t)(ai * HALF + m * 16) * 2048 + bj * HALF + 4 * n) = acc[ai][bj][m][n];
            return;
        }
        const int pm = u.pm; const int ci = pm < 32 ? 0 : (pm < 64 ? 1 : 2);
        const size_t pbase = (size_t)(pm < 64 ? pm : pm - 64) * BM * 2048 + (size_t)(wr * 64 + fr) * 2048 + col0;
        const char* xi = (const char*)(pm < 64 ? xin_lat : xin_ctx) + pbase * (IN32 ? 4 : 2);
        char* xo = (char*)(pm < 64 ? xout_lat : xout_ctx) + pbase * (OUT32 ? 4 : 2);
        f32x4 g4[2][2];
#pragma unroll
        for (int bj = 0; bj < 2; ++bj)
#pragma unroll
            for (int n = 0; n < 2; ++n) g4[bj][n] = *(const f32x4*)(gate + (size_t)ci * 12288 + col0 + bj * HALF + 4 * n);
#pragma unroll
        for (int ai = 0; ai < 2; ++ai) {
            f32x4 xv[4][2][2]; u32x4 xr[4][2];
#pragma unroll
            for (int m = 0; m < 4; ++m) { const size_t off = (size_t)(ai * HALF + m * 16) * 2048;
#pragma unroll
                for (int bj = 0; bj < 2; ++bj) {
                    if (IN32) { xv[m][bj][0] = __builtin_nontemporal_load((const f32x4*)(xi + (off + bj * HALF) * 4)); xv[m][bj][1] = __builtin_nontemporal_load((const f32x4*)(xi + (off + bj * HALF + 4) * 4)); }
                    else xr[m][bj] = __builtin_nontemporal_load((const u32x4*)(xi + (off + bj * HALF) * 2)); } }
#pragma unroll
            for (int m = 0; m < 4; ++m) { const size_t off = (size_t)(ai * HALF + m * 16) * 2048;
#pragma unroll
                for (int bj = 0; bj < 2; ++bj) {
                    f32x4 a0, a1; if (IN32) { a0 = xv[m][bj][0]; a1 = xv[m][bj][1]; } else bf8_to_f32(xr[m][bj], a0, a1);
                    const f32x4 r0 = a0 + g4[bj][0] * acc[ai][bj][m][0], r1 = a1 + g4[bj][1] * acc[ai][bj][m][1];
                    if (OUT32) { *(f32x4*)(xo + (off + bj * HALF) * 4) = r0; *(f32x4*)(xo + (off + bj * HALF + 4) * 4) = r1; }
                    else { u32x4 w; w.x = cvt_pk_bf16(r0[0], r0[1]); w.y = cvt_pk_bf16(r0[2], r0[3]); w.z = cvt_pk_bf16(r1[0], r1[1]); w.w = cvt_pk_bf16(r1[2], r1[3]); *(u32x4*)(xo + (off + bj * HALF) * 2) = w; } } }
        }
    }
};

template <int CTRL> __device__ __forceinline__ float dpp_upd(float old, float src) {
    return __builtin_bit_cast(float, __builtin_amdgcn_update_dpp(__builtin_bit_cast(int, old), __builtin_bit_cast(int, src), CTRL, 0xf, 0xf, false)); }
struct EpiAct {
    static constexpr bool PERM = true, AFTER_DRAIN = false, PERM_A = true, PROBE_TWICE = (MK_EPI_PROBE == 1), NT_B = (MK_NT_B & 1) != 0;
    bf16_t* A; const float* cw; const float* cb; int rows; PG8_LAS float* halo; int ld;
    __device__ __forceinline__ void operator()(const f32x4 (&acc)[2][2][4][2], const Unit& u, int wr, int wc, int fr, int fq) const {
        typedef unsigned u32x2 __attribute__((ext_vector_type(2)));
        const int cl = wc * 32 + 8 * fq;
        if (fr == 0) {
#pragma unroll
            for (int ai = 0; ai < 2; ++ai)
#pragma unroll
                for (int bj = 0; bj < 2; ++bj)
#pragma unroll
                    for (int n = 0; n < 2; ++n) *(PG8_LAS f32x4*)(halo + ((2 * ai + wr) * 2 + 0) * 256 + bj * HALF + cl + 4 * n) = acc[ai][bj][0][n];
        }
        if (fr == 15) {
#pragma unroll
            for (int ai = 0; ai < 2; ++ai)
#pragma unroll
                for (int bj = 0; bj < 2; ++bj)
#pragma unroll
                    for (int n = 0; n < 2; ++n) *(PG8_LAS f32x4*)(halo + ((2 * ai + wr) * 2 + 1) * 256 + bj * HALF + cl + 4 * n) = acc[ai][bj][3][n];
        }
        asm volatile("s_waitcnt lgkmcnt(0)" ::: "memory"); __builtin_amdgcn_s_barrier(); asm volatile("" ::: "memory");
        unsigned pmask = 0u, nmask = 0u, omask = 0u;
#pragma unroll
        for (int ai = 0; ai < 2; ++ai)
#pragma unroll
            for (int m = 0; m < 4; ++m) { const int t = ai * HALF + wr * 64 + 4 * fr + m, g = u.pm * 254 - 1 + t; const unsigned bit = 1u << (ai * 4 + m);
                const int pos = g < 16384 ? (g & 8191) : ((g - 16384) & 255); const int last = g < 16384 ? 8191 : 255;
                if (pos != 0) pmask |= bit; if (pos != last) nmask |= bit; if (t >= 1 && t <= 254 && g >= 0 && g < rows) omask |= bit; }
#pragma unroll
        for (int n = 0; n < 2; ++n) {
            const int f = HALF * u.pn + cl + 4 * n;
            const f32x4 wg0 = *(const f32x4*)(cw + f), wg1 = *(const f32x4*)(cw + 11008 + f), wg2 = *(const f32x4*)(cw + 22016 + f), bg = *(const f32x4*)(cb + f);
            const f32x4 wu0 = *(const f32x4*)(cw + 5504 + f), wu1 = *(const f32x4*)(cw + 11008 + 5504 + f), wu2 = *(const f32x4*)(cw + 22016 + 5504 + f), bu = *(const f32x4*)(cb + 5504 + f);
#pragma unroll
            for (int ai = 0; ai < 2; ++ai) {
                const int seg = 2 * ai + wr, sp = seg > 0 ? seg - 1 : 0, sn = seg < 3 ? seg + 1 : 3;
                const f32x4 hpg = *(const PG8_LAS f32x4*)(halo + (sp * 2 + 1) * 256 + cl + 4 * n), hpu = *(const PG8_LAS f32x4*)(halo + (sp * 2 + 1) * 256 + HALF + cl + 4 * n);
                const f32x4 hng = *(const PG8_LAS f32x4*)(halo + (sn * 2 + 0) * 256 + cl + 4 * n), hnu = *(const PG8_LAS f32x4*)(halo + (sn * 2 + 0) * 256 + HALF + cl + 4 * n);
#pragma unroll
                for (int m = 0; m < 4; ++m) {
                    const unsigned bit = 1u << (ai * 4 + m); const bool pok = (pmask & bit) != 0u, nok = (nmask & bit) != 0u;
                    float o[4];
#pragma unroll
                    for (int e = 0; e < 4; ++e) {
                        const float zg = acc[ai][0][m][n][e], zu = acc[ai][1][m][n][e];
                        const float pg = m > 0 ? acc[ai][0][m > 0 ? m - 1 : 0][n][e] : dpp_upd<0x111>(hpg[e], acc[ai][0][3][n][e]);
                        const float pu = m > 0 ? acc[ai][1][m > 0 ? m - 1 : 0][n][e] : dpp_upd<0x111>(hpu[e], acc[ai][1][3][n][e]);
                        const float ng = m < 3 ? acc[ai][0][m < 3 ? m + 1 : 3][n][e] : dpp_upd<0x101>(hng[e], acc[ai][0][0][n][e]);
                        const float nu = m < 3 ? acc[ai][1][m < 3 ? m + 1 : 3][n][e] : dpp_upd<0x101>(hnu[e], acc[ai][1][0][n][e]);
                        float yg = wg1[e] * zg + bg[e], yu = wu1[e] * zu + bu[e];
                        yg += pok ? wg0[e] * pg : 0.f; yu += pok ? wu0[e] * pu : 0.f;
                        yg += nok ? wg2[e] * ng : 0.f; yu += nok ? wu2[e] * nu : 0.f;
                        o[e] = silu_f(yg) * yu;
                    }
                    if (omask & bit) { const int g = u.pm * 254 - 1 + ai * HALF + wr * 64 + 4 * fr + m;
                        *(u32x2*)(A + (size_t)g * ld + f) = (u32x2){cvt_pk_bf16(o[0], o[1]), cvt_pk_bf16(o[2], o[3])}; }
                }
            }
        }
    }
};

template <int M0, bool A0, bool S0, int M1, bool A1, bool S1> struct EpiDualT {
    static constexpr bool PERM = true, AFTER_DRAIN = false, PERM_A = false, PROBE_TWICE = (MK_EPI_PROBE == 3), NT_B = false;
    EpiBf16T<M0, A0, S0> e0; EpiBf16T<M1, A1, S1> e1;
    __device__ __forceinline__ void operator()(const f32x4 (&acc)[2][2][4][2], const Unit& u, int wr, int wc, int fr_, int fq_) const {
        int fr = fr_, fq = fq_; asm volatile("" : "+v"(fr), "+v"(fq));
        if (u.which == 0) e0(acc, u, wr, wc, fr, fq); else e1(acc, u, wr, wc, fr, fq); }
};

struct EpiDual {
    static constexpr bool PERM = true, AFTER_DRAIN = false, PERM_A = false, PROBE_TWICE = (MK_EPI_PROBE == 3), NT_B = false;
    EpiBf16R e0, e1;
    __device__ __forceinline__ void operator()(const f32x4 (&acc)[2][2][4][2], const Unit& u, int wr, int wc, int fr, int fq) const {
        EpiBf16R e;
        const bool w = u.which != 0;
        e.O = w ? e1.O : e0.O; e.ldc = w ? e1.ldc : e0.ldc; e.P = w ? e1.P : e0.P; e.ACT = w ? e1.ACT : e0.ACT; e.STATS = w ? e1.STATS : e0.STATS; e.MODE = w ? e1.MODE : e0.MODE;
        e.part = e0.part; e.qg = e0.qg; e.kg = e0.kg;
        e(acc, u, wr, wc, fr, fq); }
};
template <class Epi, class Sched, bool ALIGN_EPI = false, bool SP2 = false>
__device__ __forceinline__ void gemm_phase(PG8_LAS unsigned char* lds, const Gemm g, const Sched& S, const Epi& E, const int wave_idx) {
    int tid_ = wave_idx * 64 + (int)__builtin_amdgcn_mbcnt_hi(~0u, __builtin_amdgcn_mbcnt_lo(~0u, 0u)); asm volatile("" : "+v"(tid_)); const int tid = tid_, wid = __builtin_amdgcn_readfirstlane(tid >> 6), lane = tid & 63, wr = wid >> 2, wc = wid & 3, fr = lane & 15, fq = lane >> 4;
    const int K = g.K, nt = K / BK, LD = g.ldk ? g.ldk : g.K;
    unsigned voffA[2], voffB[2];
#pragma unroll
    for (int i = 0; i < 2; ++i) { int R, C; stage_rc(tid * 16 + i * 8192, R, C); const int Rb = Epi::PERM ? ((R & ~31) + perm32(R & 31)) : R;
        const int Ra = Epi::PERM_A ? ((R & ~63) + 4 * (R & 15) + ((R & 63) >> 4)) : R;
        voffA[i] = (unsigned)(Ra * LD + C) * 2u; voffB[i] = (unsigned)(Rb * LD + C) * 2u; }
    const size_t kstep = (size_t)(BK * 2);
    const size_t hstep = (size_t)HALF * LD * 2;
    const size_t tstep = 2 * hstep; const size_t tstepA = (size_t)g.panel_rows * LD * 2;
    const unsigned ldsw = (unsigned)wid * 1024u;
    const int aoff = lds_byte(wr * 64 + fr, fq * 8), boff = lds_byte(wc * 32 + fr, fq * 8);
#define PG8_SA(b, h) (((b) * 2 + (h)) * HTB)
#define PG8_SB(b, h) ((4 + (b) * 2 + (h)) * HTB)
#define PG8_STAGE_(bufoff, gbase, voff, aux) do { _Pragma("unroll") for (int _i = 0; _i < 2; ++_i) \
        __builtin_amdgcn_global_load_lds((const unsigned*)((const char*)(gbase) + (voff)[_i]), (PG8_LAS unsigned*)(lds + (bufoff) + ldsw + _i * 8192), 16, 0, aux); } while (0)
#define PG8_STAGE(bufoff, gbase, voff) PG8_STAGE_(bufoff, gbase, voff, 0)
#define PG8_STAGEB(bufoff, gbase, voff) do { if (Epi::NT_B) PG8_STAGE_(bufoff, gbase, voff, 2); else PG8_STAGE_(bufoff, gbase, voff, 0); } while (0)
#define PG8_LDA(dst, b, h) do { _Pragma("unroll") for (int m = 0; m < 4; ++m) _Pragma("unroll") for (int k = 0; k < 2; ++k) dst[m][k] = *(const PG8_LAS bf16x8*)(lds + PG8_SA(b, h) + aoff + m * 2048 + k * 1024); } while (0)
#define PG8_LDB(dst, b, h) do { _Pragma("unroll") for (int n = 0; n < 2; ++n) _Pragma("unroll") for (int k = 0; k < 2; ++k) dst[n][k] = *(const PG8_LAS bf16x8*)(lds + PG8_SB(b, h) + boff + n * 2048 + k * 1024); } while (0)
#define PG8_MMA(ai, bj, At, Bt) do { __builtin_amdgcn_s_setprio(1); _Pragma("unroll") for (int m = 0; m < 4; ++m) _Pragma("unroll") for (int n = 0; n < 2; ++n) _Pragma("unroll") for (int k = 0; k < 2; ++k) \
        acc[ai][bj][m][n] = __builtin_amdgcn_mfma_f32_16x16x32_bf16(Bt[n][k], At[m][k], acc[ai][bj][m][n], 0, 0, 0); __builtin_amdgcn_s_setprio(0); } while (0)
#define PG8_WAIT_V(n) asm volatile("s_waitcnt vmcnt(" #n ")" ::: "memory")
#define PG8_WAIT_L(n) asm volatile("s_waitcnt lgkmcnt(" #n ")" ::: "memory")
#define PG8_BAR __builtin_amdgcn_s_barrier()
#define PG8_SCHED __builtin_amdgcn_sched_barrier(0)
    Unit cur, nxt; int ui = 0;
    if (!S.next(0, cur)) return;
    f32x4 acc[2][2][4][2];
#pragma unroll
    for (int a = 0; a < 2; ++a)
#pragma unroll
        for (int b = 0; b < 2; ++b)
#pragma unroll
            for (int m = 0; m < 4; ++m)
#pragma unroll
                for (int n = 0; n < 2; ++n) acc[a][b][m][n] = (f32x4){0.f, 0.f, 0.f, 0.f};
    bf16x8 At[4][2], B0[2][2], B1[2][2];
    const char* cA = (const char*)(cur.which ? g.A2 : g.A) + (size_t)cur.pm * tstepA + (size_t)cur.kt0 * kstep; const char* cB = (const char*)(cur.which ? g.Bt2 : g.Bt) + (size_t)cur.pn * tstep + (size_t)cur.kt0 * kstep;
    S.a_ready(cur);
    if constexpr (SP2) {
        PG8_STAGEB(PG8_SB(0, 0), cB, voffB); PG8_STAGEB(PG8_SB(0, 1), cB + hstep, voffB); PG8_STAGE(PG8_SA(0, 0), cA, voffA); PG8_STAGE(PG8_SA(0, 1), cA + hstep, voffA);
        if (wr == 1) PG8_BAR;
        PG8_WAIT_V(2); PG8_BAR;
        PG8_STAGEB(PG8_SB(1, 0), cB + kstep, voffB); PG8_STAGE(PG8_SA(1, 0), cA + kstep, voffA); PG8_STAGEB(PG8_SB(1, 1), cB + hstep + kstep, voffB);
        PG8_WAIT_V(6); PG8_BAR;
    } else {
        PG8_STAGEB(PG8_SB(0, 0), cB, voffB); PG8_STAGE(PG8_SA(0, 0), cA, voffA); PG8_STAGEB(PG8_SB(0, 1), cB + hstep, voffB); PG8_STAGE(PG8_SA(0, 1), cA + hstep, voffA);
        if (wr == 1) PG8_BAR;
        PG8_WAIT_V(4); PG8_BAR;
        PG8_STAGEB(PG8_SB(1, 0), cB + kstep, voffB); PG8_STAGE(PG8_SA(1, 0), cA + kstep, voffA); PG8_STAGEB(PG8_SB(1, 1), cB + hstep + kstep, voffB);
        PG8_WAIT_V(6); PG8_BAR;
    }
    for (;;) {
        const bool has_next = S.next(ui + 1, nxt);
        const char* nA = has_next ? (const char*)(nxt.which ? g.A2 : g.A) + (size_t)nxt.pm * tstepA + (size_t)nxt.kt0 * kstep : cA; const char* nB = has_next ? (const char*)(nxt.which ? g.Bt2 : g.Bt) + (size_t)nxt.pn * tstep + (size_t)nxt.kt0 * kstep : cB;
        const int ntc = cur.ktn ? cur.ktn : nt;
        for (int t = 0; t < ntc; t += 2) {
            const bool last = (t == ntc - 2);
            const char* a1 = cA + (size_t)(t + 1) * kstep;
            const char* a2 = last ? nA : cA + (size_t)(t + 2) * kstep; const char* b2 = last ? nB : cB + (size_t)(t + 2) * kstep;
            const char* a3 = a2 + kstep; const char* b3 = b2 + kstep;
            if (last && has_next) S.a_ready(nxt);
            if constexpr (SP2) {
            PG8_LDB(B0, 0, 0); PG8_LDB(B1, 0, 1); PG8_SCHED; PG8_LDA(At, 0, 0); PG8_STAGE(PG8_SA(1, 1), a1 + hstep, voffA);
            PG8_WAIT_V(8); PG8_WAIT_L(0); PG8_BAR; PG8_MMA(0, 0, At, B0); PG8_MMA(0, 1, At, B1); PG8_BAR; PG8_SCHED;
            PG8_LDA(At, 0, 1); PG8_STAGEB(PG8_SB(0, 0), b2, voffB); PG8_STAGEB(PG8_SB(0, 1), b2 + hstep, voffB); PG8_STAGE(PG8_SA(0, 0), a2, voffA);
            PG8_WAIT_V(8); PG8_WAIT_L(0); PG8_BAR; PG8_MMA(1, 0, At, B0); PG8_MMA(1, 1, At, B1); PG8_BAR; PG8_SCHED;
            PG8_LDB(B0, 1, 0); PG8_LDB(B1, 1, 1); PG8_SCHED; PG8_LDA(At, 1, 0); PG8_STAGE(PG8_SA(0, 1), a2 + hstep, voffA);
            PG8_WAIT_V(8); PG8_WAIT_L(0); PG8_BAR; PG8_MMA(0, 0, At, B0); PG8_MMA(0, 1, At, B1); PG8_BAR; PG8_SCHED;
            PG8_LDA(At, 1, 1); PG8_STAGEB(PG8_SB(1, 0), b3, voffB); PG8_STAGEB(PG8_SB(1, 1), b3 + hstep, voffB); PG8_STAGE(PG8_SA(1, 0), a3, voffA);
            PG8_WAIT_V(8); PG8_WAIT_L(0); PG8_BAR; PG8_MMA(1, 0, At, B0); PG8_MMA(1, 1, At, B1); PG8_BAR; PG8_SCHED;
            } else {
            PG8_LDB(B0, 0, 0); PG8_SCHED; PG8_LDA(At, 0, 0); PG8_STAGE(PG8_SA(1, 1), a1 + hstep, voffA);
            PG8_WAIT_L(8); PG8_BAR; PG8_WAIT_L(0); PG8_MMA(0, 0, At, B0); PG8_BAR; PG8_SCHED;
            PG8_LDB(B1, 0, 1); PG8_STAGEB(PG8_SB(0, 0), b2, voffB);
            PG8_BAR; PG8_WAIT_L(0); PG8_MMA(0, 1, At, B1); PG8_BAR;
            PG8_LDA(At, 0, 1); PG8_STAGE(PG8_SA(0, 0), a2, voffA);
            PG8_BAR; PG8_WAIT_L(0); PG8_MMA(1, 0, At, B0); PG8_BAR; PG8_SCHED;
            PG8_STAGEB(PG8_SB(0, 1), b2 + hstep, voffB);
            PG8_WAIT_V(6); PG8_BAR; PG8_MMA(1, 1, At, B1); PG8_BAR;
            PG8_LDB(B0, 1, 0); PG8_SCHED; PG8_LDA(At, 1, 0); PG8_STAGE(PG8_SA(0, 1), a2 + hstep, voffA);
            PG8_WAIT_L(8); PG8_BAR; PG8_WAIT_L(0); PG8_MMA(0, 0, At, B0); PG8_BAR; PG8_SCHED;
            PG8_LDB(B1, 1, 1); PG8_STAGEB(PG8_SB(1, 0), b3, voffB);
            PG8_BAR; PG8_WAIT_L(0); PG8_MMA(0, 1, At, B1); PG8_BAR;
            PG8_LDA(At, 1, 1); PG8_STAGE(PG8_SA(1, 0), a3, voffA);
            PG8_BAR; PG8_WAIT_L(0); PG8_MMA(1, 0, At, B0); PG8_BAR; PG8_SCHED;
            PG8_STAGEB(PG8_SB(1, 1), b3 + hstep, voffB);
            PG8_WAIT_V(6); PG8_BAR; PG8_MMA(1, 1, At, B1); PG8_BAR;
            }
        }
        if constexpr (ALIGN_EPI) { if (wr == 0) PG8_BAR; }
        if constexpr (!Epi::AFTER_DRAIN) { E(acc, cur, wr, wc, fr, fq); if constexpr (Epi::PROBE_TWICE) { asm volatile("" ::: "memory"); E(acc, cur, wr, wc, fr, fq); } S.done(cur); }
        if (!has_next) break;
#pragma unroll
        for (int a = 0; a < 2; ++a)
#pragma unroll
            for (int b = 0; b < 2; ++b)
#pragma unroll
                for (int m = 0; m < 4; ++m)
#pragma unroll
                    for (int n = 0; n < 2; ++n) acc[a][b][m][n] = (f32x4){0.f, 0.f, 0.f, 0.f};
        cur = nxt; cA = nA; cB = nB; ++ui;
        if constexpr (ALIGN_EPI) { if (wr == 1) PG8_BAR; }
    }
    PG8_WAIT_V(0);
    if constexpr (!ALIGN_EPI) { if (wr == 0) PG8_BAR; }
    PG8_BAR;
    if constexpr (Epi::AFTER_DRAIN) { E.fused(acc, cur, wr, wc, fr, fq, lds, wid, lane); S.done(cur); }
#undef PG8_SA
#undef PG8_SB
#undef PG8_STAGE
#undef PG8_STAGE_
#undef PG8_STAGEB
#undef PG8_LDA
#undef PG8_LDB
#undef PG8_MMA
#undef PG8_WAIT_V
#undef PG8_WAIT_L
#undef PG8_BAR
#undef PG8_SCHED
}
}

constexpr int NWAVES = 8;
constexpr int DM = 2048, NB = 2, SEQ = 8192, DEPTH = 4, CTXL = 256;
constexpr int ML = NB * SEQ;
constexpr int MC = NB * CTXL;
constexpr int MT = ML + MC;
constexpr int NH = 16, HD = 128, GRIDW = 64, GROWS = 128;
constexpr int GMW = 4096, GMG = 16, GMGD = 256, GMC = 128;
constexpr int FFN = 5504, FFN2 = 11008;
constexpr int FFN_LD = MK_FFN_LD;
constexpr float EPS = 1e-6f;
constexpr float LOG2E = 1.4426950408889634f;
constexpr int NMOD = 6 * DM;

enum { I_X = 0, I_C, I_CTX, I_CCTX, I_NMG, I_NFG, I_WADA, I_BADA, I_NAQKV, I_NAQG, I_NAKG, I_NARPB, I_NAWO, I_GMWIN, I_GMVG, I_GMWS, I_GMBS, I_GMWOUT,
       I_SCWIN, I_SCCW, I_SCWOUT, I_FUP, I_FCW, I_FCB, I_FDN, N_IN };

constexpr size_t MiB = 1u << 20;
constexpr size_t WS_CTL = 0, CTL_ZERO_BYTES = 1 * MiB;
constexpr size_t WS_MOD = 1 * MiB;
constexpr size_t WS_WQKV = 2 * MiB;
constexpr size_t WS_WO = 50 * MiB;
constexpr size_t WS_WGIN = 66 * MiB;
constexpr size_t WS_WGS = 98 * MiB;
constexpr size_t WS_WGOUT = 99 * MiB;
constexpr size_t WS_WCIN = 115 * MiB;
constexpr size_t WS_WCOUT = 139 * MiB;
constexpr size_t WS_WUP = 147 * MiB;
constexpr size_t WS_XA = 405 * MiB;
constexpr size_t WS_XB = 537 * MiB;
constexpr size_t WS_H = 669 * MiB + 4096;
constexpr size_t WS_ACT = 738 * MiB;
constexpr size_t WS_PST = 936 * MiB;
constexpr size_t WS_BIG = 939 * MiB;
constexpr size_t WS_SLAB = 1339 * MiB;
constexpr size_t WS_WDN = 1371 * MiB;
constexpr size_t WS_END = 1467 * MiB;
constexpr size_t BIG_QK = 0, BIG_VT = 132 * MiB, BIG_O = 198 * MiB;
constexpr size_t BIG_U = 0, BIG_GVT = 132 * MiB, BIG_G = 264 * MiB;
constexpr size_t BIG_BCX = 0, BIG_T = 198 * MiB;
constexpr size_t BIG_Z = 0;
constexpr int CW_TMO = 0, CW_BAR = 4096, CW_DIAG = 16384, CW_STAMP = 20480;

constexpr int RING_OFF = 0, RING_BYTES = 131072;
constexpr int LDSCTL_OFF = RING_BYTES, MISC_OFF = LDSCTL_OFF + 320, HALO_OFF = LDSCTL_OFF + 1024;
constexpr int LDS_BYTES = 147456;

#define GAS __attribute__((address_space(1)))
#define LAS __attribute__((address_space(3)))
typedef unsigned short bf16;
typedef unsigned v4u __attribute__((ext_vector_type(4)));
typedef unsigned v2u __attribute__((ext_vector_type(2)));
typedef float f32x4 __attribute__((ext_vector_type(4)));
typedef float f32x16 __attribute__((ext_vector_type(16)));
typedef short bf16x8 __attribute__((ext_vector_type(8)));
typedef short s16x4 __attribute__((ext_vector_type(4)));
typedef GAS unsigned gu32;
#define RLX_AGENT __ATOMIC_RELAXED, __HIP_MEMORY_SCOPE_AGENT
#define LDS_WAIT() asm volatile("s_waitcnt lgkmcnt(0)" ::: "memory")
__device__ __forceinline__ unsigned pk2(float lo, float hi) { return pg8::cvt_pk_bf16(lo, hi); }
__device__ __forceinline__ float bf2f(bf16 b) { return __uint_as_float(((unsigned)b) << 16); }
__device__ __forceinline__ float bflo(unsigned w) { return __uint_as_float(w << 16); }
__device__ __forceinline__ float bfhi(unsigned w) { return __uint_as_float(w & 0xffff0000u); }
__device__ __forceinline__ float wave_sum(float v) { return pg8::xrow16_sum(pg8::row16_sum(v)); }
__device__ __forceinline__ float swap32_max(float m) { auto rr = __builtin_amdgcn_permlane32_swap(__float_as_uint(m), __float_as_uint(m), false, false); return __builtin_fmaxf(__uint_as_float(rr[0]), __uint_as_float(rr[1])); }
__device__ __forceinline__ float swap32_sum(float m) { auto rr = __builtin_amdgcn_permlane32_swap(__float_as_uint(m), __float_as_uint(m), false, false); return __uint_as_float(rr[0]) + __uint_as_float(rr[1]); }
#define MFMA32(a, b, c) __builtin_amdgcn_mfma_f32_32x32x16_bf16((a), (b), (c), 0, 0, 0)

#define XB_TMO      128
#define XB_XCNT(j)  (256  + 64 * (j))
#define XB_XSUB(j)  (1280 + 64 * (j))
#define XB_XGEN(j)  (2304 + 64 * (j))
#define XB_TOP      3328
#define XB_TOPGEN   3392
#define XCD_BAR_WORDS 3456
#define XB_SPIN_CAP (1u << 18)

__device__ __forceinline__ unsigned xb_ld(unsigned* p)              { return __hip_atomic_load(p, __ATOMIC_RELAXED, __HIP_MEMORY_SCOPE_AGENT); }
__device__ __forceinline__ unsigned xb_add(unsigned* p, unsigned v) { return __hip_atomic_fetch_add(p, v, __ATOMIC_RELAXED, __HIP_MEMORY_SCOPE_AGENT); }
__device__ __forceinline__ unsigned xb_xcc_id() { return (unsigned)__builtin_amdgcn_s_getreg((3 << 11) | 20) & 0xFu; }
#define XB_SPIN(cond, bar) do { unsigned _sp = 0; while (cond) { __builtin_amdgcn_s_sleep(1); \
    if ((++_sp & 255u) == 0u) { if (xb_ld(&(bar)[XB_TMO])) break; if (_sp > XB_SPIN_CAP) { atomicAdd(&(bar)[XB_TMO], 1u); break; } } } } while (0)

struct XcdBarrier {
    unsigned* bar; unsigned x;
    volatile LAS unsigned* st;
};

__device__ __forceinline__ XcdBarrier xcd_barrier_post(unsigned* bar, volatile LAS unsigned* st) {
    XcdBarrier b; b.bar = bar; b.x = xb_xcc_id(); b.st = st;
    if (threadIdx.x == 0) (void)xb_add(&bar[XB_XCNT(b.x)], 1u);
    return b;
}
__device__ __forceinline__ void xcd_barrier_complete(unsigned* bar, unsigned x, unsigned& nloc, unsigned& nx) {
    const unsigned G = gridDim.x * gridDim.y * gridDim.z;
    unsigned sum, cnt, mine, sp = 0u;
    for (;;) {
        sum = 0u; cnt = 0u; mine = 0u;
#pragma unroll
        for (unsigned j = 0; j < 16; ++j) { const unsigned c = xb_ld(&bar[XB_XCNT(j)]); sum += c; cnt += (c > 0u) ? 1u : 0u; mine = (j == x) ? c : mine; }
        if (sum == G) break;
        __builtin_amdgcn_s_sleep(1);
        if ((++sp & 255u) == 0u) { if (xb_ld(&bar[XB_TMO])) break; if (sp > XB_SPIN_CAP) { atomicAdd(&bar[XB_TMO], 1u); break; } }
    }
    nloc = mine > 0u ? mine : 1u; nx = cnt > 0u ? cnt : 1u;
}

__device__ __forceinline__ void xcd_barrier(const XcdBarrier& b) {
    asm volatile("s_waitcnt vmcnt(0)" ::: "memory");
    __syncthreads();
    if (threadIdx.x == 0) {
        unsigned* bar = b.bar;
        __builtin_amdgcn_s_waitcnt(0);
        unsigned nloc = b.st[0], nx = b.st[1];
        if (nloc == 0u) { xcd_barrier_complete(bar, b.x, nloc, nx); b.st[0] = nloc; b.st[1] = nx; }
        const unsigned old = xb_add(&bar[XB_XSUB(b.x)], 1u);
        const unsigned gen = old / nloc;
        if (old + 1u == (gen + 1u) * nloc) {
            __builtin_amdgcn_fence(__ATOMIC_RELEASE, "agent");
            asm volatile("s_waitcnt vmcnt(0)" ::: "memory");
            const unsigned og = xb_add(&bar[XB_TOP], 1u);
            const unsigned tg = og / nx;
            if (og + 1u == (tg + 1u) * nx) xb_add(&bar[XB_TOPGEN], 1u);
            else XB_SPIN(xb_ld(&bar[XB_TOPGEN]) == tg, bar);
            __builtin_amdgcn_fence(__ATOMIC_ACQUIRE, "agent");
            xb_add(&bar[XB_XGEN(b.x)], 1u);
            asm volatile("s_waitcnt vmcnt(0)" ::: "memory");
        } else {
            XB_SPIN(xb_ld(&bar[XB_XGEN(b.x)]) == gen, bar);
            __builtin_amdgcn_fence(__ATOMIC_ACQUIRE, "agent");
            asm volatile("s_waitcnt vmcnt(0)" ::: "memory");
        }
    }
    __syncthreads();
}

struct Frame {
    LAS unsigned char* lds;
    volatile LAS unsigned* MISC;
    gu32* ctl;
    int tid, lane, wave, vcu, G;
    unsigned char* ws;
};
__device__ __forceinline__ int cond_of_row(int r) { return r < SEQ ? 0 : (r < ML ? 1 : 2); }
__device__ __forceinline__ void unpack8(const v4u r, float (&x)[8]) { x[0] = bflo(r.x); x[1] = bfhi(r.x); x[2] = bflo(r.y); x[3] = bfhi(r.y); x[4] = bflo(r.z); x[5] = bfhi(r.z); x[6] = bflo(r.w); x[7] = bfhi(r.w); }

__device__ __forceinline__ int up_perm_row(int n0) {
    return n0 < FFN ? 256 * (n0 / 128) + (n0 % 128) : 256 * ((n0 - FFN) / 128) + 128 + ((n0 - FFN) % 128);
}
__device__ __forceinline__ void p0_transpose_item(const float* W, int K, int N, bf16* WT, bool perm, LAS unsigned* scr, int item, int lane, int ldw = 0) {
    if (ldw == 0) ldw = K;
    const int nblk = N / 64, kb = item / nblk, nb = item % nblk, k0 = 64 * kb, n0 = 64 * nb;
    const int r0 = perm ? up_perm_row(n0) : n0;
    const int rsub = lane >> 4, c4 = lane & 15;
    f32x4 va[8], vb[8];
    const float* src = W + (size_t)(k0 + 2 * rsub) * N + n0 + 4 * c4;
#pragma unroll
    for (int t = 0; t < 8; ++t) { va[t] = __builtin_nontemporal_load((const f32x4*)(src + (size_t)(8 * t) * N)); vb[t] = __builtin_nontemporal_load((const f32x4*)(src + (size_t)(8 * t + 1) * N)); }
#pragma unroll
    for (int t = 0; t < 8; ++t) { const int p = 4 * t + rsub;
#pragma unroll
        for (int e = 0; e < 4; ++e) scr[(4 * c4 + e) * 33 + p] = pk2(va[t][e], vb[t][e]); }
    LDS_WAIT(); asm volatile("" ::: "memory");
    const int r = lane >> 3, c = lane & 7;
#pragma unroll
    for (int j = 0; j < 8; ++j) { const int n = 8 * j + r; const LAS unsigned* sp = scr + n * 33 + 4 * c;
        v4u o; o.x = sp[0]; o.y = sp[1]; o.z = sp[2]; o.w = sp[3];
        *(GAS v4u*)(WT + (size_t)(r0 + n) * ldw + k0 + 8 * c) = o; }
    LDS_WAIT(); asm volatile("" ::: "memory");
}
__device__ __forceinline__ void p0_prologue(Frame& F, const float* c_in, const float* cctx_in, const float* w_ada, const float* b_ada,
                                            const float* na_qkv, const float* na_wo, const float* gm_win, const float* gm_ws, const float* gm_wout,
                                            const float* sc_win, const float* sc_wout, const float* f_up, const float* f_dn) {
    unsigned char* ws = F.ws;
    LAS float* sc = (LAS float*)(F.lds);
    LAS float* red = (LAS float*)(F.lds + 24576);
    __syncthreads();
    for (int i = F.tid; i < 3 * DM; i += NWAVES * 64) { const int ci = i / DM, k = i % DM; const float v = ci < 2 ? c_in[ci * DM + k] : cctx_in[k]; sc[i] = pg8::silu_f(v); }
    __syncthreads();
    float* mod = (float*)(ws + WS_MOD);
    for (int it = F.vcu; it < DEPTH * 192; it += F.G) {
        const int L = it / 192, nb = it % 192, cq = F.tid & 15, ks = F.tid >> 4;
        f32x4 a0 = {0.f, 0.f, 0.f, 0.f}, a1 = a0, a2 = a0;
        const float* wp = w_ada + ((size_t)L * DM + ks * 64) * NMOD + nb * 64 + cq * 4;
#pragma unroll 8
        for (int kk = 0; kk < 64; ++kk) { const f32x4 w = *(const GAS f32x4*)(wp + (size_t)kk * NMOD); const int k = ks * 64 + kk;
            a0 += w * sc[k]; a1 += w * sc[DM + k]; a2 += w * sc[2 * DM + k]; }
        *(LAS f32x4*)(red + (ks * 3 + 0) * 64 + cq * 4) = a0; *(LAS f32x4*)(red + (ks * 3 + 1) * 64 + cq * 4) = a1; *(LAS f32x4*)(red + (ks * 3 + 2) * 64 + cq * 4) = a2;
        __syncthreads();
        if (F.tid < 192) { const int ci = F.tid / 64, col = F.tid % 64; float s = 0.f;
#pragma unroll 8
            for (int q = 0; q < 32; ++q) s += red[(q * 3 + ci) * 64 + col];
            mod[((size_t)L * 3 + ci) * NMOD + nb * 64 + col] = s + b_ada[(size_t)L * NMOD + nb * 64 + col]; }
        __syncthreads();
    }
    { bf16* d = (bf16*)(ws + WS_WGS); const int gt = F.vcu * NWAVES * 64 + F.tid, NT = F.G * NWAVES * 64;
      for (int o = gt; o < GMG * GMC * GMC / 8; o += NT) { const int i = o & 31, h = (o >> 5) & 1, sx = (o >> 6) & 7, ib = (o >> 9) & 3, g = o >> 11;
          const float* src = gm_ws + ((size_t)g * GMC + 32 * ib + i) * GMC + 16 * sx + 8 * h; const f32x4 a = *(const f32x4*)src, b = *(const f32x4*)(src + 4);
          v4u w; w.x = pk2(a.x, a.y); w.y = pk2(a.z, a.w); w.z = pk2(b.x, b.y); w.w = pk2(b.z, b.w); *(GAS v4u*)(d + (size_t)o * 8) = w; } }
}

template <bool X32, bool FX32, bool RES32_>
__device__ __forceinline__ void norm_mod_phase(Frame& F, const void* xlat, const void* xctx, const float* gain, const float* shift0, const float* scale0, bf16* H, int nrows,
                                               const float* slab, int nsl, const void* fx_in, const float* fx_gate, void* fx_out) {
    const int gw = F.vcu * NWAVES + F.wave, NGW = F.G * NWAVES;
    for (int row = gw; row < nrows; row += NGW) {
        const int ci = cond_of_row(row);
        const float* shp = shift0 + (size_t)ci * NMOD; const float* scp = scale0 + (size_t)ci * NMOD;
        if (slab != nullptr && row >= ML) {
            f32x4 v[8]; float s = 0.f;
            const f32x4* g4 = (const f32x4*)(fx_gate + 2 * (size_t)NMOD) + F.lane;
#pragma unroll
            for (int j = 0; j < 8; ++j) { f32x4 a = {0.f, 0.f, 0.f, 0.f};
                for (int q = 0; q < nsl; ++q) a += *((const GAS f32x4*)(slab + ((size_t)q * MC + (row - ML)) * DM) + F.lane + 64 * j);
                f32x4 xin;
                if (FX32) xin = *((const GAS f32x4*)((const float*)fx_in + (size_t)(row - ML) * DM) + F.lane + 64 * j);
                else { const v2u r = *((const GAS v2u*)((const bf16*)fx_in + (size_t)(row - ML) * DM) + F.lane + 64 * j); xin = (f32x4){bflo(r.x), bfhi(r.x), bflo(r.y), bfhi(r.y)}; }
                v[j] = xin + g4[64 * j] * a;
                if (RES32_) *((GAS f32x4*)((float*)fx_out + (size_t)(row - ML) * DM) + F.lane + 64 * j) = v[j];
                else { v2u w; w.x = pk2(v[j].x, v[j].y); w.y = pk2(v[j].z, v[j].w); *((GAS v2u*)((bf16*)fx_out + (size_t)(row - ML) * DM) + F.lane + 64 * j) = w;
                       v[j] = (f32x4){bflo(w.x), bfhi(w.x), bflo(w.y), bfhi(w.y)}; }
                s += (v[j].x * v[j].x + v[j].y * v[j].y) + (v[j].z * v[j].z + v[j].w * v[j].w); }
            const float rstd = 1.0f / sqrtf(wave_sum(s) * (1.0f / DM) + EPS);
            const f32x4* gg = (const f32x4*)gain + F.lane; const f32x4* sh4 = (const f32x4*)shp + F.lane; const f32x4* sc4 = (const f32x4*)scp + F.lane;
            GAS v2u* o8 = (GAS v2u*)(H + (size_t)row * DM) + F.lane;
#pragma unroll
            for (int j = 0; j < 8; ++j) { const f32x4 y = v[j] * rstd * gg[64 * j] * (sc4[64 * j] + 1.0f) + sh4[64 * j]; v2u w; w.x = pk2(y.x, y.y); w.y = pk2(y.z, y.w); o8[64 * j] = w; }
        } else if (X32) {
            const float* src = row < ML ? (const float*)xlat + (size_t)row * DM : (const float*)xctx + (size_t)(row - ML) * DM;
            const GAS f32x4* xr = (const GAS f32x4*)src + F.lane;
            f32x4 v[8]; float s = 0.f;
#pragma unroll
            for (int j = 0; j < 8; ++j) { v[j] = xr[64 * j]; s += (v[j].x * v[j].x + v[j].y * v[j].y) + (v[j].z * v[j].z + v[j].w * v[j].w); }
            const float rstd = 1.0f / sqrtf(wave_sum(s) * (1.0f / DM) + EPS);
            const f32x4* gg = (const f32x4*)gain + F.lane; const f32x4* sh4 = (const f32x4*)shp + F.lane; const f32x4* sc4 = (const f32x4*)scp + F.lane;
            GAS v2u* o8 = (GAS v2u*)(H + (size_t)row * DM) + F.lane;
#pragma unroll
            for (int j = 0; j < 8; ++j) { const f32x4 y = v[j] * rstd * gg[64 * j] * (sc4[64 * j] + 1.0f) + sh4[64 * j]; v2u w; w.x = pk2(y.x, y.y); w.y = pk2(y.z, y.w); o8[64 * j] = w; }
        } else {
            const bf16* src = row < ML ? (const bf16*)xlat + (size_t)row * DM : (const bf16*)xctx + (size_t)(row - ML) * DM;
            const GAS v4u* xr = (const GAS v4u*)src + F.lane;
            v4u raw[4]; float s = 0.f;
#pragma unroll
            for (int j = 0; j < 4; ++j) raw[j] = xr[64 * j];
#pragma unroll
            for (int j = 0; j < 4; ++j) { float x[8]; unpack8(raw[j], x);
#pragma unroll
                for (int e = 0; e < 8; ++e) s += x[e] * x[e]; }
            const float rstd = 1.0f / sqrtf(wave_sum(s) * (1.0f / DM) + EPS);
            GAS v4u* o16 = (GAS v4u*)(H + (size_t)row * DM) + F.lane;
#pragma unroll
            for (int j = 0; j < 4; ++j) { float x[8]; unpack8(raw[j], x); const int c = 8 * F.lane + 512 * j;
                const f32x4 g0 = *(const f32x4*)(gain + c), g1 = *(const f32x4*)(gain + c + 4), s0 = *(const f32x4*)(scp + c), s1 = *(const f32x4*)(scp + c + 4), h0 = *(const f32x4*)(shp + c), h1 = *(const f32x4*)(shp + c + 4);
                v4u w; w.x = pk2(x[0] * rstd * g0.x * (s0.x + 1.0f) + h0.x, x[1] * rstd * g0.y * (s0.y + 1.0f) + h0.y); w.y = pk2(x[2] * rstd * g0.z * (s0.z + 1.0f) + h0.z, x[3] * rstd * g0.w * (s0.w + 1.0f) + h0.w);
                w.z = pk2(x[4] * rstd * g1.x * (s1.x + 1.0f) + h1.x, x[5] * rstd * g1.y * (s1.y + 1.0f) + h1.y); w.w = pk2(x[6] * rstd * g1.z * (s1.z + 1.0f) + h1.z, x[7] * rstd * g1.w * (s1.w + 1.0f) + h1.w);
                o16[64 * j] = w; }
        }
    }
}

struct AttnTileDesc { unsigned koff, voff; int boff; bool lat, row_ok; };
#define ALD16(dst, voff, sbase, imm) asm volatile("global_load_dwordx4 %0, %1, %2 offset:" #imm : "=v"(dst) : "v"(voff), "s"(sbase))
#define ALD4(dst, voff, sbase) asm volatile("global_load_dword %0, %1, %2" : "=v"(dst) : "v"(voff), "s"(sbase))
struct AttnBases { const char* kpl[8]; const char* vt; const char* rpb; };
__device__ __forceinline__ void attn_issue_k(const AttnBases& B, unsigned koff, bf16x8 (&kf)[8]) {
    ALD16(kf[0], koff, B.kpl[0], 0); ALD16(kf[1], koff, B.kpl[1], 0); ALD16(kf[2], koff, B.kpl[2], 0); ALD16(kf[3], koff, B.kpl[3], 0);
    ALD16(kf[4], koff, B.kpl[4], 0); ALD16(kf[5], koff, B.kpl[5], 0); ALD16(kf[6], koff, B.kpl[6], 0); ALD16(kf[7], koff, B.kpl[7], 0);
}
__device__ __forceinline__ void attn_issue_v(const AttnBases& B, unsigned voff, bf16x8 (&vf)[4][2]) {
    const unsigned v1 = voff + 4096u;
    ALD16(vf[0][0], voff, B.vt, 0); ALD16(vf[1][0], voff, B.vt, 512); ALD16(vf[2][0], voff, B.vt, 1024); ALD16(vf[3][0], voff, B.vt, 1536);
    ALD16(vf[0][1], v1, B.vt, 0); ALD16(vf[1][1], v1, B.vt, 512); ALD16(vf[2][1], v1, B.vt, 1024); ALD16(vf[3][1], v1, B.vt, 1536);
}
#define AWAIT8(n, a) asm volatile("s_waitcnt vmcnt(" #n ")" : "+v"(a[0]), "+v"(a[1]), "+v"(a[2]), "+v"(a[3]), "+v"(a[4]), "+v"(a[5]), "+v"(a[6]), "+v"(a[7]))
#define AWAITV(n, a) asm volatile("s_waitcnt vmcnt(" #n ")" : "+v"(a[0][0]), "+v"(a[1][0]), "+v"(a[2][0]), "+v"(a[3][0]), "+v"(a[0][1]), "+v"(a[1][1]), "+v"(a[2][1]), "+v"(a[3][1]))
__device__ __forceinline__ void attn_tile(const AttnBases& B, bf16x8 (&kf)[8], bf16x8 (&vf)[4][2], const AttnTileDesc& d, const AttnTileDesc& dn, const LAS float* btab,
                                          const bf16x8 (&qf)[8], f32x16 (&ot)[4], float& m, float& lsum, const unsigned colmask, const float c1) {
    float bvv[16];
#pragma unroll
    for (int i = 0; i < 16; ++i) bvv[i] = btab[d.boff + 16 * (i >> 3) + (i & 7)];
    f32x16 S;
#pragma unroll
    for (int i = 0; i < 16; ++i) S[i] = 0.f;
    AWAIT8(8, kf);
#pragma unroll
    for (int s = 0; s < 8; ++s) S = MFMA32(kf[s], qf[s], S);
    __builtin_amdgcn_sched_barrier(0);
    attn_issue_k(B, dn.koff, kf);
    __builtin_amdgcn_sched_barrier(0);
    float t[16];
    { const unsigned msk = d.lat ? (d.row_ok ? colmask : 0u) : 0xffffu; const float bsc = d.lat ? LOG2E : 0.f;
#pragma unroll
      for (int i = 0; i < 16; ++i) t[i] = ((msk >> i) & 1u) ? S[i] * c1 + bvv[i] * bsc : -__builtin_inff(); }
    float mx = t[0];
#pragma unroll
    for (int i = 1; i < 16; ++i) mx = __builtin_fmaxf(mx, t[i]);
    mx = swap32_max(mx);
    if (__any(mx > m + 8.0f)) {
        const float mn = __builtin_fmaxf(m, mx);
        const float alpha = __builtin_amdgcn_exp2f(m - mn);
        m = mn; lsum *= alpha;
#pragma unroll
        for (int nb = 0; nb < 4; ++nb)
#pragma unroll
            for (int i = 0; i < 16; ++i) ot[nb][i] *= alpha;
    }
    float ps = 0.f; float p[16];
#pragma unroll
    for (int i = 0; i < 16; ++i) { p[i] = __builtin_amdgcn_exp2f(t[i] - m); ps += p[i]; }
    lsum += ps;
    v4u w0, w1; w0.x = pk2(p[0], p[1]); w0.y = pk2(p[2], p[3]); w0.z = pk2(p[4], p[5]); w0.w = pk2(p[6], p[7]);
    w1.x = pk2(p[8], p[9]); w1.y = pk2(p[10], p[11]); w1.z = pk2(p[12], p[13]); w1.w = pk2(p[14], p[15]);
    const bf16x8 pf0 = __builtin_bit_cast(bf16x8, w0), pf1 = __builtin_bit_cast(bf16x8, w1);
    AWAITV(8, vf);
#pragma unroll
    for (int nb = 0; nb < 4; ++nb) { ot[nb] = MFMA32(vf[nb][0], pf0, ot[nb]); ot[nb] = MFMA32(vf[nb][1], pf1, ot[nb]); }
    __builtin_amdgcn_sched_barrier(0);
    attn_issue_v(B, dn.voff, vf);
    __builtin_amdgcn_sched_barrier(0);
}
__device__ __forceinline__ void attn_phase(Frame& F, const bf16* QK, const bf16* VT, bf16* O, const float* rpb, const bool ctx_out) {
    const int lane = F.lane, ql = lane & 31, h = lane >> 5;
    const int gw = F.vcu * NWAVES + F.wave, NGW = F.G * NWAVES;
    const int NU = 8192 + (ctx_out ? 256 : 0);
    const float c1 = 0.08838834764831845f * LOG2E;
    for (int u = gw; u < NU; u += NGW) {
        int b, head, qrow, qr = 0, qc = 0, cw0 = 0, rs0 = 0, rs1e = 0;
        if (u < 8192) { const int g = u & 3, rp = (u >> 2) & 63; head = (u >> 8) & 15; b = u >> 12;
            qr = 2 * rp + (ql >> 4); qc = 16 * g + (ql & 15); qrow = b * SEQ + qr * GRIDW + qc; cw0 = g == 0 ? 0 : (g == 1 ? 8 : (g == 2 ? 24 : 32));
            int a0 = 2 * rp - 4; a0 = a0 < 0 ? 0 : (a0 > GROWS - 8 ? GROWS - 8 : a0); int a1 = 2 * rp - 3; a1 = a1 < 0 ? 0 : (a1 > GROWS - 8 ? GROWS - 8 : a1); rs0 = a0; rs1e = a1 + 8; }
        else { const int u2 = u - 8192, qt = u2 & 7; head = (u2 >> 3) & 15; b = u2 >> 7; qrow = ML + CTXL * b + 32 * qt + ql; }
        int rs = qr - 4; rs = rs < 0 ? 0 : (rs > GROWS - 8 ? GROWS - 8 : rs);
        int cs = qc - 8; cs = cs < 0 ? 0 : (cs > GRIDW - 16 ? GRIDW - 16 : cs);
        unsigned colmask = 0u;
#pragma unroll
        for (int i = 0; i < 16; ++i) { const int kc = cw0 + 8 * h + 16 * (i >> 3) + (i & 7); colmask |= (kc >= cs && kc < cs + 16) ? (1u << i) : 0u; }
        const int dcb = cw0 + 8 * h - qc + 15;
        const float* rpb_h = rpb + (size_t)head * 15 * 31;
        bf16x8 qf[8];
        { const bf16* qp = QK + ((size_t)head * 8 * MT + qrow) * 16 + 8 * h;
#pragma unroll
          for (int s = 0; s < 8; ++s) qf[s] = *(const GAS bf16x8*)(qp + (size_t)s * MT * 16); }
        f32x16 ot[4];
#pragma unroll
        for (int nb = 0; nb < 4; ++nb)
#pragma unroll
            for (int i = 0; i < 16; ++i) ot[nb][i] = 0.f;
        float m = -__builtin_inff(), lsum = 0.f;
        const int qlp = (ql & ~12) | ((ql & 4) << 1) | ((ql & 8) >> 1);
        const unsigned kbase = (unsigned)((((size_t)(16 + head) * 8 * MT + qlp) * 16 + 8 * h) * 2);
        const unsigned vbase = (unsigned)((((size_t)head * (MT / 8) + h) * 128 + ql) * 16);
        const int crow0 = ML + CTXL * b, nt = 8 + (rs1e - rs0);
#define ATT_DESC(t, d) do { const int t__ = (t); const bool ctx__ = t__ < 8; const int kr__ = rs0 + t__ - 8; \
            const int k0__ = ctx__ ? crow0 + 32 * t__ : b * SEQ + kr__ * GRIDW + cw0;                                      \
            d.koff = kbase + (unsigned)k0__ * 32u; d.voff = vbase + (unsigned)(k0__ >> 3) * 2048u; d.lat = !ctx__; \
            d.row_ok = !ctx__ && kr__ >= rs && kr__ < rs + 8; d.boff = d.row_ok ? (kr__ - qr + 7) * 31 + dcb : 15; } while (0)
        AttnBases B;
#pragma unroll
        for (int sx = 0; sx < 8; ++sx) B.kpl[sx] = (const char*)QK + (size_t)sx * (MT * 32);
        B.vt = (const char*)VT; B.rpb = (const char*)rpb_h;
        LAS float* btab = (LAS float*)(F.lds + F.wave * 2304) + 16;
#pragma unroll
        for (int q = 0; q < 8; ++q) { const int idx = lane + 64 * q; if (idx < 465) btab[idx] = rpb_h[idx]; }
        bf16x8 kf[8], vf[4][2]; AttnTileDesc dA, dB;
        asm volatile("s_waitcnt vmcnt(0) lgkmcnt(0)" : "+v"(qf[0]), "+v"(qf[1]), "+v"(qf[2]), "+v"(qf[3]), "+v"(qf[4]), "+v"(qf[5]), "+v"(qf[6]), "+v"(qf[7]) :: "memory");
        ATT_DESC(0, dA); attn_issue_k(B, dA.koff, kf); attn_issue_v(B, dA.voff, vf);
        for (int t = 0; t < nt; ++t) {
            ATT_DESC(t + 1 < nt ? t + 1 : t, dB);
            attn_tile(B, kf, vf, dA, dB, btab, qf, ot, m, lsum, colmask, c1);
            dA = dB;
        }
        AWAIT8(0, kf); AWAITV(0, vf);
#undef ATT_DESC
        const float inv = 1.0f / swap32_sum(lsum);
        bf16* op = O + (size_t)qrow * DM + head * HD + 4 * h;
#pragma unroll
        for (int nb = 0; nb < 4; ++nb)
#pragma unroll
            for (int g4 = 0; g4 < 4; ++g4) { v2u w; w.x = pk2(ot[nb][4 * g4] * inv, ot[nb][4 * g4 + 1] * inv); w.y = pk2(ot[nb][4 * g4 + 2] * inv, ot[nb][4 * g4 + 3] * inv);
                *(GAS v2u*)(op + 32 * nb + 8 * g4) = w; }
    }
}

__device__ __forceinline__ void gm_spatial_phase(Frame& F, const bf16* U, const bf16* VT, bf16* G, const bf16* WS, const float* PST, const float* vg, const float* bs) {
    const int lane = F.lane, ql = lane & 31, h = lane >> 5, w = F.wave;
    LAS float* rsd = (LAS float*)(F.lds);
    constexpr int NUNITS = (MT / GMC) * GMG;
    const int u0 = (int)((long)F.vcu * NUNITS / F.G), u1 = (int)((long)(F.vcu + 1) * NUNITS / F.G);
    int cprev = -1;
    for (int u = u0; u < u1; ++u) {
        const int c = u >> 4, g = u & 15;
        if (c != cprev) { cprev = c;
            __syncthreads();
            if (lane < 16) { const int tok = GMC * c + 16 * w + lane; float s = 0.f;
#pragma unroll 8
                for (int p = 0; p < 32; ++p) s += PST[(size_t)p * MT + tok];
                rsd[16 * w + lane] = 1.0f / sqrtf(s * (1.0f / GMW) + EPS); }
            __syncthreads();
        }
        bf16x8 af[8];
        { const bf16* ap = VT + ((size_t)(8 * g + w) * (MT / 16) + 8 * c) * 512 + ql * 16 + 8 * h;
#pragma unroll
          for (int s = 0; s < 8; ++s) { const v4u raw = *(const GAS v4u*)(ap + 512 * s); const f32x4 r0 = *(const LAS f32x4*)(rsd + 16 * s + 8 * h), r1 = *(const LAS f32x4*)(rsd + 16 * s + 8 * h + 4);
              v4u o; o.x = pk2(bflo(raw.x) * r0.x, bfhi(raw.x) * r0.y); o.y = pk2(bflo(raw.y) * r0.z, bfhi(raw.y) * r0.w);
              o.z = pk2(bflo(raw.z) * r1.x, bfhi(raw.z) * r1.y); o.w = pk2(bflo(raw.w) * r1.z, bfhi(raw.w) * r1.w);
              af[s] = __builtin_bit_cast(bf16x8, o); } }
        f32x16 acc[4];
#pragma unroll
        for (int ib = 0; ib < 4; ++ib)
#pragma unroll
            for (int i = 0; i < 16; ++i) acc[ib][i] = 0.f;
#pragma unroll
        for (int ib = 0; ib < 4; ++ib) { const bf16* bp = WS + ((size_t)(g * 4 + ib) * 8) * 512 + lane * 8;
#pragma unroll
            for (int s = 0; s < 8; ++s) { const bf16x8 bfr = *(const GAS bf16x8*)(bp + 512 * s); acc[ib] = MFMA32(af[s], bfr, acc[ib]); } }
#pragma unroll
        for (int ib = 0; ib < 4; ++ib) { const int i = 32 * ib + ql; const size_t row = (size_t)GMC * c + i; const float bsv = bs[g * GMC + i];
#pragma unroll
            for (int g4 = 0; g4 < 4; ++g4) { const int col = GMGD * g + 32 * w + 8 * g4 + 4 * h; const f32x4 v4 = *(const f32x4*)(vg + col);
                const v2u uu = *(const GAS v2u*)(U + row * GMW + col);
                const float o0 = bflo(uu.x) * (v4.x * acc[ib][4 * g4] + bsv), o1 = bfhi(uu.x) * (v4.y * acc[ib][4 * g4 + 1] + bsv);
                const float o2 = bflo(uu.y) * (v4.z * acc[ib][4 * g4 + 2] + bsv), o3 = bfhi(uu.y) * (v4.w * acc[ib][4 * g4 + 3] + bsv);
                v2u wv; wv.x = pk2(o0, o1); wv.y = pk2(o2, o3); *(GAS v2u*)(G + row * GMW + col) = wv; } }
        LDS_WAIT(); asm volatile("" ::: "memory");
    }
}

__device__ __forceinline__ bool has_prev(int r) { return r < ML ? (r & (SEQ - 1)) != 0 : ((r - ML) & (CTXL - 1)) != 0; }
__device__ __forceinline__ bool has_next(int r) { return r < ML ? (r & (SEQ - 1)) != SEQ - 1 : ((r - ML) & (CTXL - 1)) != CTXL - 1; }

__device__ __forceinline__ void sc_conv_phase(Frame& F, const bf16* BCX, bf16* T, const float* cw  ) {
    const int gt = F.vcu * NWAVES * 64 + F.tid, NT = F.G * NWAVES * 64;
    constexpr int RB = 16, NOC = DM / 8;
    for (int it = gt; it < (MT / RB) * NOC; it += NT) {
        const int rb = it / NOC, oc = it % NOC, c0 = 8 * oc, r0 = rb * RB;
        float w0[8], w1[8], w2[8];
#pragma unroll
        for (int e = 0; e < 8; ++e) { w0[e] = cw[c0 + e]; w1[e] = cw[DM + c0 + e]; w2[e] = cw[2 * DM + c0 + e]; }
        float pv[8], cv[8], nv[8];
        auto ld = [&](int r, float (&o)[8]) { float a[8], b[8]; unpack8(*(const GAS v4u*)(BCX + (size_t)r * 6144 + DM + c0), a); unpack8(*(const GAS v4u*)(BCX + (size_t)r * 6144 + 2 * DM + c0), b);
#pragma unroll
            for (int e = 0; e < 8; ++e) o[e] = a[e] * b[e]; };
        if (has_prev(r0)) ld(r0 - 1, pv); else {
#pragma unroll
            for (int e = 0; e < 8; ++e) pv[e] = 0.f; }
        ld(r0, cv);
        for (int i = 0; i < RB; ++i) { const int r = r0 + i;
            if (has_next(r)) ld(r + 1, nv); else {
#pragma unroll
                for (int e = 0; e < 8; ++e) nv[e] = 0.f; }
            float bg[8]; unpack8(*(const GAS v4u*)(BCX + (size_t)r * 6144 + c0), bg);
            float y[8];
#pragma unroll
            for (int e = 0; e < 8; ++e) y[e] = bg[e] * (pv[e] * w0[e] + cv[e] * w1[e] + nv[e] * w2[e]);
            v4u o; o.x = pk2(y[0], y[1]); o.y = pk2(y[2], y[3]); o.z = pk2(y[4], y[5]); o.w = pk2(y[6], y[7]);
            *(GAS v4u*)(T + (size_t)r * DM + c0) = o;
#pragma unroll
            for (int e = 0; e < 8; ++e) { pv[e] = cv[e]; cv[e] = nv[e]; } }
    }
}

__device__ __forceinline__ void ffn_act_phase(Frame& F, const bf16* Z, bf16* A, const float* cw  , const float* cb  , int nrows) {
    const int gt = F.vcu * NWAVES * 64 + F.tid, NT = F.G * NWAVES * 64;
    constexpr int RB = 16, NOC = FFN / 8;
    for (int it = gt; it < (nrows / RB) * NOC; it += NT) {
        const int rb = it / NOC, oc = it % NOC, f0 = 8 * oc, r0 = rb * RB;
        const int zg = 256 * (f0 >> 7) + (f0 & 127), zu = zg + 128;
        float wg0[8], wg1[8], wg2[8], wu0[8], wu1[8], wu2[8], bg[8], bu[8];
#pragma unroll
        for (int e = 0; e < 8; ++e) { wg0[e] = cw[f0 + e]; wg1[e] = cw[FFN2 + f0 + e]; wg2[e] = cw[2 * FFN2 + f0 + e]; bg[e] = cb[f0 + e];
            wu0[e] = cw[FFN + f0 + e]; wu1[e] = cw[FFN2 + FFN + f0 + e]; wu2[e] = cw[2 * FFN2 + FFN + f0 + e]; bu[e] = cb[FFN + f0 + e]; }
        float pg[8], cg[8], ng[8], pu[8], cu[8], nu[8];
        auto ld = [&](int r, float (&og)[8], float (&ou)[8]) { unpack8(*(const GAS v4u*)(Z + (size_t)r * FFN2 + zg), og); unpack8(*(const GAS v4u*)(Z + (size_t)r * FFN2 + zu), ou); };
        if (has_prev(r0)) ld(r0 - 1, pg, pu); else {
#pragma unroll
            for (int e = 0; e < 8; ++e) { pg[e] = 0.f; pu[e] = 0.f; } }
        ld(r0, cg, cu);
        for (int i = 0; i < RB; ++i) { const int r = r0 + i;
            if (has_next(r)) ld(r + 1, ng, nu); else {
#pragma unroll
                for (int e = 0; e < 8; ++e) { ng[e] = 0.f; nu[e] = 0.f; } }
            float y[8];
#pragma unroll
            for (int e = 0; e < 8; ++e) { const float yg = pg[e] * wg0[e] + cg[e] * wg1[e] + ng[e] * wg2[e] + bg[e]; const float yu = pu[e] * wu0[e] + cu[e] * wu1[e] + nu[e] * wu2[e] + bu[e]; y[e] = pg8::silu_f(yg) * yu; }
            v4u o; o.x = pk2(y[0], y[1]); o.y = pk2(y[2], y[3]); o.z = pk2(y[4], y[5]); o.w = pk2(y[6], y[7]);
            *(GAS v4u*)(A + (size_t)r * FFN + f0) = o;
#pragma unroll
            for (int e = 0; e < 8; ++e) { pg[e] = cg[e]; cg[e] = ng[e]; pu[e] = cu[e]; cu[e] = nu[e]; } }
    }
}

constexpr int PH_PER_LAYER = MK_FFN_HALVES ? 10 : 8;
constexpr bool RES32 = !MK_RES_BF16;
constexpr size_t CTXOFF = (size_t)ML * DM * (RES32 ? 4 : 2);
constexpr int NPHASES = 1 + DEPTH * PH_PER_LAYER;
struct Args { const float* in[N_IN]; float* out; unsigned char* ws; int ph_lo, ph_hi; };

__device__ __forceinline__ unsigned long long tab_ld(int i) {
    extern __shared__ __attribute__((aligned(16))) unsigned char lds_[];
    volatile LAS unsigned* t = (volatile LAS unsigned*)((LAS unsigned char*)lds_ + LDSCTL_OFF) + 2 * i;
    const unsigned lo = __builtin_amdgcn_readfirstlane(t[0]), hi = __builtin_amdgcn_readfirstlane(t[1]);
    return ((unsigned long long)hi << 32) | lo;
}
#define INP(i) ((const float*)(const GAS float*)tab_ld(i))
#define OUTP() ((float*)(GAS float*)tab_ld(N_IN))
#define WSP() ((unsigned char*)(GAS unsigned char*)tab_ld(N_IN + 1))
#define FRAME() Frame F; { extern __shared__ __attribute__((aligned(16))) unsigned char lds_[]; int t_ = wv_ * 64 + (int)__builtin_amdgcn_mbcnt_hi(~0u, __builtin_amdgcn_mbcnt_lo(~0u, 0u)); asm volatile("" : "+v"(t_)); int bx_ = blockIdx.x; asm volatile("" : "+s"(bx_)); \
    F.lds = (LAS unsigned char*)lds_; F.MISC = (volatile LAS unsigned*)(F.lds + MISC_OFF); F.tid = t_; F.lane = t_ & 63; F.wave = __builtin_amdgcn_readfirstlane(t_ >> 6); \
    F.G = gridDim.x; F.vcu = (F.G % 8 == 0) ? (bx_ % 8) * (F.G / 8) + bx_ / 8 : bx_; F.ws = WSP(); F.ctl = (gu32*)(F.ws + WS_CTL); }

template <int Lw> __device__ __forceinline__ void convert_layer(Frame& F, int lo, int hi, int rank, int nranks) {
    unsigned char* ws = F.ws;
    LAS unsigned* scr = (LAS unsigned*)(F.lds + RING_OFF + F.wave * 16384);
    constexpr int I_QKV = 32 * 96, I_O = 32 * 32, I_GIN = 32 * 128, I_GOUT = 64 * 32, I_CIN = 32 * 96, I_COUT = 32 * 32, I_UP = 32 * 172, I_DN = 86 * 32;
    constexpr int mxw = Lw % 3, jxw = Lw / 3;
    constexpr int nA = mxw == 0 ? I_QKV : (mxw == 1 ? I_GIN : I_CIN), nB = mxw == 0 ? I_O : (mxw == 1 ? I_GOUT : I_COUT), T = nA + nB + I_UP + I_DN;
    const int it0 = (int)((long)T * lo / 256), it1 = (int)((long)T * hi / 256);
    for (int it = it0 + rank; it < it1; it += nranks) {
        int r = it;
        if (r < nA) { if (mxw == 0) p0_transpose_item(INP(I_NAQKV) + (size_t)jxw * DM * 6144, DM, 6144, (bf16*)(ws + WS_WQKV) + (size_t)jxw * 6144 * DM, false, scr, r, F.lane);
                      else if (mxw == 1) p0_transpose_item(INP(I_GMWIN), DM, 8192, (bf16*)(ws + WS_WGIN), false, scr, r, F.lane);
                      else p0_transpose_item(INP(I_SCWIN), DM, 6144, (bf16*)(ws + WS_WCIN), false, scr, r, F.lane);
                      continue; } r -= nA;
        if (r < nB) { if (mxw == 0) p0_transpose_item(INP(I_NAWO) + (size_t)jxw * DM * DM, DM, DM, (bf16*)(ws + WS_WO) + (size_t)jxw * DM * DM, false, scr, r, F.lane);
                      else if (mxw == 1) p0_transpose_item(INP(I_GMWOUT), GMW, DM, (bf16*)(ws + WS_WGOUT), false, scr, r, F.lane);
                      else p0_transpose_item(INP(I_SCWOUT), DM, DM, (bf16*)(ws + WS_WCOUT), false, scr, r, F.lane);
                      continue; } r -= nB;
        if (r < I_UP) { p0_transpose_item(INP(I_FUP) + (size_t)Lw * DM * FFN2, DM, FFN2, (bf16*)(ws + WS_WUP) + (size_t)Lw * FFN2 * DM, true, scr, r, F.lane); continue; } r -= I_UP;
        p0_transpose_item(INP(I_FDN) + (size_t)Lw * FFN * DM, FFN, DM, (bf16*)(ws + WS_WDN) + (size_t)Lw * DM * FFN_LD, false, scr, r, F.lane, FFN_LD);
    }
}
__device__ __forceinline__ void idle_rank(int nunits, int G, int c, int& rank, int& nidle) {
    const int rounds = (nunits + G - 1) / G, rem = nunits - (rounds - 1) * G;
    if (rem == G) { rank = c; nidle = G; } else { rank = c >= rem ? c - rem : -1; nidle = G - rem; }
}

__global__ void __launch_bounds__(NWAVES * 64, 2) mk_fwd(Args args) {
    extern __shared__ __attribute__((aligned(16))) unsigned char lds[];
    for (int u = threadIdx.x; u < (LDS_BYTES - LDSCTL_OFF) / 4; u += NWAVES * 64) ((LAS unsigned*)((LAS unsigned char*)lds + LDSCTL_OFF))[u] = 0u;
    __syncthreads();
    if (threadIdx.x == 0) { LAS unsigned long long* t = (LAS unsigned long long*)((LAS unsigned char*)lds + LDSCTL_OFF);
#pragma unroll
        for (int i = 0; i < N_IN; ++i) t[i] = (unsigned long long)args.in[i];
        t[N_IN] = (unsigned long long)args.out; t[N_IN + 1] = (unsigned long long)args.ws; }
    __syncthreads();
    const int lo = args.ph_lo, hi = args.ph_hi;
    const int wv_ = __builtin_amdgcn_readfirstlane((int)threadIdx.x >> 6);
    if (hi - lo > 1) { (void)xcd_barrier_post((unsigned*)(WSP() + WS_CTL) + CW_BAR, (volatile LAS unsigned*)((LAS unsigned char*)lds + MISC_OFF) + 8); }
#define IN(k) (lo <= (k) && (k) < hi)
#if MK_STAMP
#define STAMP(k) do { if (blockIdx.x == 0 && threadIdx.x == 0) ((unsigned long long*)(WSP() + WS_CTL + 4 * CW_STAMP))[k] = __builtin_amdgcn_s_memrealtime(); } while (0)
#else
#define STAMP(k) do { } while (0)
#endif
#define SEAM(k) do { if (IN((k) + 1)) { XcdBarrier bar_; bar_.bar = (unsigned*)(WSP() + WS_CTL) + CW_BAR; bar_.x = xb_xcc_id(); bar_.st = (volatile LAS unsigned*)((LAS unsigned char*)lds + MISC_OFF) + 8; xcd_barrier(bar_); if (MK_DOUBLE_BAR) xcd_barrier(bar_); } } while (0)
#define WSPTRS() unsigned char* ws = F.ws; float* mod = (float*)(ws + WS_MOD); unsigned char* XA = ws + WS_XA; unsigned char* XB = ws + WS_XB; \
    bf16* H = (bf16*)(ws + WS_H); bf16* ACT = (bf16*)(ws + WS_ACT); float* PST = (float*)(ws + WS_PST); unsigned char* BIG = ws + WS_BIG; \
    const float* modL = mod + (size_t)L * 3 * NMOD; const void* xin_lat = L == 0 ? (const void*)INP(I_X) : (const void*)XA; const void* xin_ctx = L == 0 ? (const void*)INP(I_CTX) : (const void*)(XA + CTXOFF); \
    (void)mod; (void)XA; (void)XB; (void)H; (void)ACT; (void)PST; (void)BIG; (void)modL; (void)xin_lat; (void)xin_ctx;

    if (IN(0)) {
        STAMP(0); FRAME();
        _Pragma("unroll") for (int rep_ = 0; rep_ < 1 + ((MK_REPS >> 0) & 1); ++rep_)
        p0_prologue(F, INP(I_C), INP(I_CCTX), INP(I_WADA), INP(I_BADA), INP(I_NAQKV), INP(I_NAWO), INP(I_GMWIN), INP(I_GMWS), INP(I_GMWOUT),
                    INP(I_SCWIN), INP(I_SCWOUT), INP(I_FUP), INP(I_FDN));
        __syncthreads();
        convert_layer<0>(F, 0, 256, F.vcu * NWAVES + F.wave, F.G * NWAVES);
#if !MK_DEFER_CONVERT
        convert_layer<1>(F, 0, 256, F.vcu * NWAVES + F.wave, F.G * NWAVES); convert_layer<2>(F, 0, 256, F.vcu * NWAVES + F.wave, F.G * NWAVES); convert_layer<3>(F, 0, 256, F.vcu * NWAVES + F.wave, F.G * NWAVES);
#endif
        SEAM(0);
    }
    { constexpr int L = 0;
        const int base = 1 + PH_PER_LAYER * L, mx = L % 3, jx = L / 3;
        const bool last = (L == DEPTH - 1);
        constexpr int rows = (L == DEPTH - 1) ? ML : MT;
        if (IN(base + 0)) { STAMP(base + 0); FRAME(); WSPTRS();
            const float* modP = mod + (size_t)(L > 0 ? L - 1 : 0) * 3 * NMOD;
            _Pragma("unroll") for (int rep_ = 0; rep_ < REPN(MK_RB_NORM); ++rep_) norm_mod_phase<(L == 0) || RES32, RES32, RES32>(F, xin_lat, xin_ctx, INP(I_NMG) + (size_t)L * DM, modL + 0 * DM, modL + 1 * DM, H, MT,
                L > 0 ? (const float*)(ws + WS_SLAB) : nullptr, 8, XB + CTXOFF, modP + 5 * DM, XA + CTXOFF);
            SEAM(base + 0); }
        if (IN(base + 1)) { STAMP(base + 1); FRAME(); WSPTRS();
            const bf16* Wa; int Na; bf16* Oa; bool acta; int modea = 0, modeb = 0, ldca;
            const bf16* Wb; int Mb; bf16* Ob; bool actb, statb;
            if (mx == 0) { Wa = (const bf16*)(ws + WS_WQKV) + (size_t)jx * 6144 * DM; Na = 4096; Oa = (bf16*)(BIG + BIG_QK); acta = false; modea = 1; modeb = 2;
                           Wb = Wa + (size_t)4096 * DM; Mb = 2048; Ob = (bf16*)(BIG + BIG_VT); actb = false; statb = false; }
            else if (mx == 1) { Wa = (const bf16*)(ws + WS_WGIN); Na = 4096; Oa = (bf16*)(BIG + BIG_U); acta = true;
                           Wb = Wa + (size_t)4096 * DM; Mb = 4096; Ob = (bf16*)(BIG + BIG_GVT); actb = true; statb = true; modeb = 3; }
            else { Wa = (const bf16*)(ws + WS_WCIN); Na = 6144; Oa = (bf16*)(BIG + BIG_BCX); acta = false; Wb = nullptr; Mb = 0; Ob = nullptr; actb = false; statb = false; }
            ldca = modea == 1 ? MT : Na;
            pg8::Gemm g{H, Wa, MT, Na, DM, 256, Wb, H, 0}; pg8::DualOrder S; S.init(Na, Mb, F.G, (int)blockIdx.x); S.wgm0 = MK_WGM_IN0; S.wgm1 = MK_WGM_IN1;
            if (MK_XSTAG_IN > 0) { const unsigned long long d_ = (unsigned long long)(xb_xcc_id() & 7u) * MK_XSTAG_IN, t0_ = __builtin_amdgcn_s_memrealtime(); while (__builtin_amdgcn_s_memrealtime() - t0_ < d_) __builtin_amdgcn_s_sleep(4); }
            if constexpr (L % 3 == 1) {
                pg8::EpiDual E{ pg8::EpiBf16R{Oa, ldca, nullptr, acta, false, modea, (PG8_LAS float*)(F.lds + HALO_OFF), INP(I_NAQG) + jx * HD, INP(I_NAKG) + jx * HD},
                                pg8::EpiBf16R{Ob, MT, PST, actb, statb, modeb, nullptr, nullptr, nullptr} };
                _Pragma("unroll") for (int rep_ = 0; rep_ < REPN(MK_RB_GIN); ++rep_)
                pg8::gemm_phase<pg8::EpiDual, pg8::DualOrder, true, true>(F.lds + RING_OFF, g, S, E, wv_);
            } else {
                constexpr int kM0 = (L % 3 == 0) ? 1 : 0, kM1 = (L % 3 == 0) ? 2 : 0;
                typedef pg8::EpiDualT<kM0, false, false, kM1, false, false> EpiIn;
                EpiIn E{ pg8::EpiBf16T<kM0, false, false>{Oa, ldca, nullptr, (PG8_LAS float*)(F.lds + HALO_OFF), INP(I_NAQG) + jx * HD, INP(I_NAKG) + jx * HD},
                         pg8::EpiBf16T<kM1, false, false>{Ob, MT, PST, nullptr, nullptr, nullptr} };
                _Pragma("unroll") for (int rep_ = 0; rep_ < REPN(MK_RB_GIN); ++rep_)
                pg8::gemm_phase<EpiIn, pg8::DualOrder, true, true>(F.lds + RING_OFF, g, S, E, wv_);
            }
#if MK_DEFER_CONVERT
            if (L + 1 < DEPTH) { int rk, ni; idle_rank(S.n0 + S.n1 + S.c0 + 2 * S.nM1, F.G, (int)blockIdx.x, rk, ni);
                if (rk >= 0) convert_layer<(L + 1 < DEPTH ? L + 1 : 0)>(F, 0, MK_DS1, rk * NWAVES + F.wave, ni * NWAVES); }
#endif
            SEAM(base + 1);
        }
        if (IN(base + 3)) { STAMP(base + 3); FRAME(); WSPTRS();
            _Pragma("unroll") for (int rep_ = 0; rep_ < REPN(MK_RB_CORE); ++rep_) {
            if (mx == 0) attn_phase(F, (const bf16*)(BIG + BIG_QK), (const bf16*)(BIG + BIG_VT), (bf16*)(BIG + BIG_O), INP(I_NARPB) + (size_t)jx * NH * 15 * 31, !last);
            else if (mx == 1) gm_spatial_phase(F, (const bf16*)(BIG + BIG_U), (const bf16*)(BIG + BIG_GVT), (bf16*)(BIG + BIG_G), (const bf16*)(ws + WS_WGS), PST, INP(I_GMVG), INP(I_GMBS));
            else sc_conv_phase(F, (const bf16*)(BIG + BIG_BCX), (bf16*)(BIG + BIG_T), INP(I_SCCW));
            }
            SEAM(base + 3);
        }
        if (IN(base + 4)) { STAMP(base + 4); FRAME(); WSPTRS();
            const bf16* Ao; const bf16* Wo; int Ko;
            if (mx == 0) { Ao = (const bf16*)(BIG + BIG_O); Wo = (const bf16*)(ws + WS_WO) + (size_t)jx * DM * DM; Ko = DM; }
            else if (mx == 1) { Ao = (const bf16*)(BIG + BIG_G); Wo = (const bf16*)(ws + WS_WGOUT); Ko = GMW; }
            else { Ao = (const bf16*)(BIG + BIG_T); Wo = (const bf16*)(ws + WS_WCOUT); Ko = DM; }
            pg8::Gemm g{Ao, Wo, rows, DM, Ko, 256, nullptr, nullptr, 0}; pg8::SplitOrder S; S.init(DM, Ko, mx == 1 ? 8 : 4, !last, F.G, (int)blockIdx.x); S.lat.wgm = MK_WGM_OUT;
            if (MK_STAGGER_TICKS > 0 && (blockIdx.x & 1)) { const unsigned long long t0_ = __builtin_amdgcn_s_memrealtime(); while (__builtin_amdgcn_s_memrealtime() - t0_ < (unsigned long long)MK_STAGGER_TICKS) __builtin_amdgcn_s_sleep(8); }
            pg8::EpiResT<(L == 0) || RES32, RES32> E{xin_lat, xin_ctx, XB, XB + CTXOFF, modL + 2 * DM, (float*)(ws + WS_SLAB)};
            _Pragma("unroll") for (int rep_ = 0; rep_ < REPN(MK_RB_GOUT); ++rep_)
            pg8::gemm_phase<pg8::EpiResT<(L == 0) || RES32, RES32>, pg8::SplitOrder, true, true>(F.lds + RING_OFF, g, S, E, wv_);
#if MK_DEFER_CONVERT
            if (L + 1 < DEPTH) { int rk, ni; idle_rank(S.nlat + S.nctx, F.G, (int)blockIdx.x, rk, ni);
                if (rk >= 0) convert_layer<(L + 1 < DEPTH ? L + 1 : 0)>(F, MK_DS1, MK_DS2, rk * NWAVES + F.wave, ni * NWAVES); }
#endif
            SEAM(base + 4);
        }
        if (IN(base + 5)) { STAMP(base + 5); FRAME(); WSPTRS();
            _Pragma("unroll") for (int rep_ = 0; rep_ < REPN(MK_RB_NORM); ++rep_) norm_mod_phase<RES32, (L == 0) || RES32, RES32>(F, XB, XB + CTXOFF, INP(I_NFG) + (size_t)L * DM, modL + 3 * DM, modL + 4 * DM, H, rows,
                !last ? (const float*)(ws + WS_SLAB) : nullptr, mx == 1 ? 8 : 4, xin_ctx, modL + 2 * DM, XB + CTXOFF);
            SEAM(base + 5); }
#if MK_FFN_HALVES
        if (IN(base + 6)) { STAMP(base + 6); FRAME(); WSPTRS();
            constexpr int npan = (rows + 253) / 254, pan0 = 0, pan1 = 33;
            pg8::Gemm g{H - DM, (const bf16*)(ws + WS_WUP) + (size_t)L * FFN2 * DM, npan * 256, FFN2, DM, 254, nullptr, nullptr, 0}; pg8::StaticOrder S; S.init((pan1 - pan0) * 256, FFN2, F.G, (int)blockIdx.x); S.wgm = MK_WGM_UP; S.pm0 = pan0;
            pg8::EpiAct E{ACT, INP(I_FCW) + (size_t)L * 3 * FFN2, INP(I_FCB) + (size_t)L * FFN2, rows, (PG8_LAS float*)(F.lds + HALO_OFF), FFN_LD};
            _Pragma("unroll") for (int rep_ = 0; rep_ < REPN(MK_RB_UP); ++rep_)
            pg8::gemm_phase<pg8::EpiAct, pg8::StaticOrder, true, true>(F.lds + RING_OFF, g, S, E, wv_);
#if MK_DEFER_CONVERT
            if (L + 1 < DEPTH) { int rk, ni; idle_rank((pan1 - pan0) * (FFN2 / 256), F.G, (int)blockIdx.x, rk, ni);
                if (rk >= 0) convert_layer<(L + 1 < DEPTH ? L + 1 : 0)>(F, MK_DS2, (MK_DS2 + MK_DS3) / 2, rk * NWAVES + F.wave, ni * NWAVES); }
#endif
            SEAM(base + 6);
        }
        if (IN(base + 7)) { STAMP(base + 7); FRAME(); WSPTRS();
            pg8::Gemm g{ACT, (const bf16*)(ws + WS_WDN) + (size_t)L * DM * FFN_LD, rows, DM, FFN, 256, nullptr, nullptr, FFN_LD}; pg8::SplitOrder S; S.init(DM, FFN, 8, false, F.G, (int)blockIdx.x, 32, 0); S.lat.wgm = MK_WGM_DOWN;
            void* xo_lat = last ? (void*)OUTP() : (void*)XA;
            pg8::EpiResT<RES32, (L == DEPTH - 1) || RES32> E{XB, XB + CTXOFF, xo_lat, XA + CTXOFF, modL + 5 * DM, (float*)(ws + WS_SLAB)};
            _Pragma("unroll") for (int rep_ = 0; rep_ < REPN(MK_RB_DOWN); ++rep_)
            pg8::gemm_phase<pg8::EpiResT<RES32, (L == DEPTH - 1) || RES32>, pg8::SplitOrder, true, true>(F.lds + RING_OFF, g, S, E, wv_);
            SEAM(base + 7);
        }
        if (IN(base + 8)) { STAMP(base + 8); FRAME(); WSPTRS();
            constexpr int npan = (rows + 253) / 254, pan0 = 33, pan1 = npan;
            pg8::Gemm g{H - DM, (const bf16*)(ws + WS_WUP) + (size_t)L * FFN2 * DM, npan * 256, FFN2, DM, 254, nullptr, nullptr, 0}; pg8::StaticOrder S; S.init((pan1 - pan0) * 256, FFN2, F.G, (int)blockIdx.x); S.wgm = MK_WGM_UP; S.pm0 = pan0;
            pg8::EpiAct E{ACT, INP(I_FCW) + (size_t)L * 3 * FFN2, INP(I_FCB) + (size_t)L * FFN2, rows, (PG8_LAS float*)(F.lds + HALO_OFF), FFN_LD};
            _Pragma("unroll") for (int rep_ = 0; rep_ < REPN(MK_RB_UP); ++rep_)
            pg8::gemm_phase<pg8::EpiAct, pg8::StaticOrder, true, true>(F.lds + RING_OFF, g, S, E, wv_);
#if MK_DEFER_CONVERT
            if (L + 1 < DEPTH) { int rk, ni; idle_rank((pan1 - pan0) * (FFN2 / 256), F.G, (int)blockIdx.x, rk, ni);
                if (rk >= 0) convert_layer<(L + 1 < DEPTH ? L + 1 : 0)>(F, (MK_DS2 + MK_DS3) / 2, MK_DS3, rk * NWAVES + F.wave, ni * NWAVES); }
#endif
            SEAM(base + 8);
        }
        if (IN(base + 9)) { STAMP(base + 9); FRAME(); WSPTRS();
            pg8::Gemm g{ACT, (const bf16*)(ws + WS_WDN) + (size_t)L * DM * FFN_LD, rows, DM, FFN, 256, nullptr, nullptr, FFN_LD}; pg8::SplitOrder S; S.init(DM, FFN, 8, !last, F.G, (int)blockIdx.x, 32, 32); S.lat.wgm = MK_WGM_DOWN;
            void* xo_lat = last ? (void*)OUTP() : (void*)XA;
            pg8::EpiResT<RES32, (L == DEPTH - 1) || RES32> E{XB, XB + CTXOFF, xo_lat, XA + CTXOFF, modL + 5 * DM, (float*)(ws + WS_SLAB)};
            _Pragma("unroll") for (int rep_ = 0; rep_ < REPN(MK_RB_DOWN); ++rep_)
            pg8::gemm_phase<pg8::EpiResT<RES32, (L == DEPTH - 1) || RES32>, pg8::SplitOrder, true, true>(F.lds + RING_OFF, g, S, E, wv_);
            SEAM(base + 9);
        }
#else
        if (IN(base + 6)) { STAMP(base + 6); FRAME(); WSPTRS();
            constexpr int npan = (rows + 253) / 254;
            pg8::Gemm g{H - DM, (const bf16*)(ws + WS_WUP) + (size_t)L * FFN2 * DM, npan * 256, FFN2, DM, 254, nullptr, nullptr, 0}; pg8::StaticOrder S; S.init(npan * 256, FFN2, F.G, (int)blockIdx.x); S.wgm = MK_WGM_UP;
            if (MK_XSTAG_UP > 0) { const unsigned long long d_ = (unsigned long long)(xb_xcc_id() & 7u) * MK_XSTAG_UP, t0_ = __builtin_amdgcn_s_memrealtime(); while (__builtin_amdgcn_s_memrealtime() - t0_ < d_) __builtin_amdgcn_s_sleep(4); }
            pg8::EpiAct E{ACT, INP(I_FCW) + (size_t)L * 3 * FFN2, INP(I_FCB) + (size_t)L * FFN2, rows, (PG8_LAS float*)(F.lds + HALO_OFF), FFN_LD};
            _Pragma("unroll") for (int rep_ = 0; rep_ < REPN(MK_RB_UP); ++rep_)
            pg8::gemm_phase<pg8::EpiAct, pg8::StaticOrder, true, true>(F.lds + RING_OFF, g, S, E, wv_);
#if MK_DEFER_CONVERT
            if (L + 1 < DEPTH) { int rk, ni; idle_rank(npan * (FFN2 / 256), F.G, (int)blockIdx.x, rk, ni);
                if (rk >= 0) convert_layer<(L + 1 < DEPTH ? L + 1 : 0)>(F, MK_DS2, MK_DS3, rk * NWAVES + F.wave, ni * NWAVES); }
#endif
            SEAM(base + 6);
        }
        if (IN(base + 7)) { STAMP(base + 7); FRAME(); WSPTRS();
            pg8::Gemm g{ACT, (const bf16*)(ws + WS_WDN) + (size_t)L * DM * FFN_LD, rows, DM, FFN, 256, nullptr, nullptr, FFN_LD}; pg8::SplitOrder S; S.init(DM, FFN, 8, !last, F.G, (int)blockIdx.x); S.rev = MK_DOWN_REV; S.lat.wgm = MK_WGM_DOWN;
            void* xo_lat = last ? (void*)OUTP() : (void*)XA;
            if (MK_STAGGER_TICKS > 0 && (blockIdx.x & 1)) { const unsigned long long t0_ = __builtin_amdgcn_s_memrealtime(); while (__builtin_amdgcn_s_memrealtime() - t0_ < (unsigned long long)MK_STAGGER_TICKS) __builtin_amdgcn_s_sleep(8); }
            pg8::EpiResT<RES32, (L == DEPTH - 1) || RES32> E{XB, XB + CTXOFF, xo_lat, XA + CTXOFF, modL + 5 * DM, (float*)(ws + WS_SLAB)};
            _Pragma("unroll") for (int rep_ = 0; rep_ < REPN(MK_RB_DOWN); ++rep_)
            pg8::gemm_phase<pg8::EpiResT<RES32, (L == DEPTH - 1) || RES32>, pg8::SplitOrder, true, true>(F.lds + RING_OFF, g, S, E, wv_);
#if MK_DEFER_CONVERT
            if (L + 1 < DEPTH) { int rk, ni; idle_rank(S.nlat + S.nctx, F.G, (int)blockIdx.x, rk, ni);
                if (rk >= 0) convert_layer<(L + 1 < DEPTH ? L + 1 : 0)>(F, MK_DS3, 256, rk * NWAVES + F.wave, ni * NWAVES); }
#endif
            SEAM(base + 7);
        }
#endif
    }
    { constexpr int L = 1;
        const int base = 1 + PH_PER_LAYER * L, mx = L % 3, jx = L / 3;
        const bool last = (L == DEPTH - 1);
        constexpr int rows = (L == DEPTH - 1) ? ML : MT;
        if (IN(base + 0)) { STAMP(base + 0); FRAME(); WSPTRS();
            const float* modP = mod + (size_t)(L > 0 ? L - 1 : 0) * 3 * NMOD;
            _Pragma("unroll") for (int rep_ = 0; rep_ < REPN(MK_RB_NORM); ++rep_) norm_mod_phase<(L == 0) || RES32, RES32, RES32>(F, xin_lat, xin_ctx, INP(I_NMG) + (size_t)L * DM, modL + 0 * DM, modL + 1 * DM, H, MT,
                L > 0 ? (const float*)(ws + WS_SLAB) : nullptr, 8, XB + CTXOFF, modP + 5 * DM, XA + CTXOFF);
            SEAM(base + 0); }
        if (IN(base + 1)) { STAMP(base + 1); FRAME(); WSPTRS();
            const bf16* Wa; int Na; bf16* Oa; bool acta; int modea = 0, modeb = 0, ldca;
            const bf16* Wb; int Mb; bf16* Ob; bool actb, statb;
            if (mx == 0) { Wa = (const bf16*)(ws + WS_WQKV) + (size_t)jx * 6144 * DM; Na = 4096; Oa = (bf16*)(BIG + BIG_QK); acta = false; modea = 1; modeb = 2;
                           Wb = Wa + (size_t)4096 * DM; Mb = 2048; Ob = (bf16*)(BIG + BIG_VT); actb = false; statb = false; }
            else if (mx == 1) { Wa = (const bf16*)(ws + WS_WGIN); Na = 4096; Oa = (bf16*)(BIG + BIG_U); acta = true;
                           Wb = Wa + (size_t)4096 * DM; Mb = 4096; Ob = (bf16*)(BIG + BIG_GVT); actb = true; statb = true; modeb = 3; }
            else { Wa = (const bf16*)(ws + WS_WCIN); Na = 6144; Oa = (bf16*)(BIG + BIG_BCX); acta = false; Wb = nullptr; Mb = 0; Ob = nullptr; actb = false; statb = false; }
            ldca = modea == 1 ? MT : Na;
            pg8::Gemm g{H, Wa, MT, Na, DM, 256, Wb, H, 0}; pg8::DualOrder S; S.init(Na, Mb, F.G, (int)blockIdx.x); S.wgm0 = MK_WGM_IN0; S.wgm1 = MK_WGM_IN1;
            if (MK_XSTAG_IN > 0) { const unsigned long long d_ = (unsigned long long)(xb_xcc_id() & 7u) * MK_XSTAG_IN, t0_ = __builtin_amdgcn_s_memrealtime(); while (__builtin_amdgcn_s_memrealtime() - t0_ < d_) __builtin_amdgcn_s_sleep(4); }
            if constexpr (L % 3 == 1) {
                pg8::EpiDual E{ pg8::EpiBf16R{Oa, ldca, nullptr, acta, false, modea, (PG8_LAS float*)(F.lds + HALO_OFF), INP(I_NAQG) + jx * HD, INP(I_NAKG) + jx * HD},
                                pg8::EpiBf16R{Ob, MT, PST, actb, statb, modeb, nullptr, nullptr, nullptr} };
                _Pragma("unroll") for (int rep_ = 0; rep_ < REPN(MK_RB_GIN); ++rep_)
                pg8::gemm_phase<pg8::EpiDual, pg8::DualOrder, true, true>(F.lds + RING_OFF, g, S, E, wv_);
            } else {
                constexpr int kM0 = (L % 3 == 0) ? 1 : 0, kM1 = (L % 3 == 0) ? 2 : 0;
                typedef pg8::EpiDualT<kM0, false, false, kM1, false, false> EpiIn;
                EpiIn E{ pg8::EpiBf16T<kM0, false, false>{Oa, ldca, nullptr, (PG8_LAS float*)(F.lds + HALO_OFF), INP(I_NAQG) + jx * HD, INP(I_NAKG) + jx * HD},
                         pg8::EpiBf16T<kM1, false, false>{Ob, MT, PST, nullptr, nullptr, nullptr} };
                _Pragma("unroll") for (int rep_ = 0; rep_ < REPN(MK_RB_GIN); ++rep_)
                pg8::gemm_phase<EpiIn, pg8::DualOrder, true, true>(F.lds + RING_OFF, g, S, E, wv_);
            }
#if MK_DEFER_CONVERT
            if (L + 1 < DEPTH) { int rk, ni; idle_rank(S.n0 + S.n1 + S.c0 + 2 * S.nM1, F.G, (int)blockIdx.x, rk, ni);
                if (rk >= 0) convert_layer<(L + 1 < DEPTH ? L + 1 : 0)>(F, 0, MK_DS1, rk * NWAVES + F.wave, ni * NWAVES); }
#endif
            SEAM(base + 1);
        }
        if (IN(base + 3)) { STAMP(base + 3); FRAME(); WSPTRS();
            _Pragma("unroll") for (int rep_ = 0; rep_ < REPN(MK_RB_CORE); ++rep_) {
            if (mx == 0) attn_phase(F, (const bf16*)(BIG + BIG_QK), (const bf16*)(BIG + BIG_VT), (bf16*)(BIG + BIG_O), INP(I_NARPB) + (size_t)jx * NH * 15 * 31, !last);
            else if (mx == 1) gm_spatial_phase(F, (const bf16*)(BIG + BIG_U), (const bf16*)(BIG + BIG_GVT), (bf16*)(BIG + BIG_G), (const bf16*)(ws + WS_WGS), PST, INP(I_GMVG), INP(I_GMBS));
            else sc_conv_phase(F, (const bf16*)(BIG + BIG_BCX), (bf16*)(BIG + BIG_T), INP(I_SCCW));
            }
            SEAM(base + 3);
        }
        if (IN(base + 4)) { STAMP(base + 4); FRAME(); WSPTRS();
            const bf16* Ao; const bf16* Wo; int Ko;
            if (mx == 0) { Ao = (const bf16*)(BIG + BIG_O); Wo = (const bf16*)(ws + WS_WO) + (size_t)jx * DM * DM; Ko = DM; }
            else if (mx == 1) { Ao = (const bf16*)(BIG + BIG_G); Wo = (const bf16*)(ws + WS_WGOUT); Ko = GMW; }
            else { Ao = (const bf16*)(BIG + BIG_T); Wo = (const bf16*)(ws + WS_WCOUT); Ko = DM; }
            pg8::Gemm g{Ao, Wo, rows, DM, Ko, 256, nullptr, nullptr, 0}; pg8::SplitOrder S; S.init(DM, Ko, mx == 1 ? 8 : 4, !last, F.G, (int)blockIdx.x); S.lat.wgm = MK_WGM_OUT;
            if (MK_STAGGER_TICKS > 0 && (blockIdx.x & 1)) { const unsigned long long t0_ = __builtin_amdgcn_s_memrealtime(); while (__builtin_amdgcn_s_memrealtime() - t0_ < (unsigned long long)MK_STAGGER_TICKS) __builtin_amdgcn_s_sleep(8); }
            pg8::EpiResT<(L == 0) || RES32, RES32> E{xin_lat, xin_ctx, XB, XB + CTXOFF, modL + 2 * DM, (float*)(ws + WS_SLAB)};
            _Pragma("unroll") for (int rep_ = 0; rep_ < REPN(MK_RB_GOUT); ++rep_)
            pg8::gemm_phase<pg8::EpiResT<(L == 0) || RES32, RES32>, pg8::SplitOrder, true, true>(F.lds + RING_OFF, g, S, E, wv_);
#if MK_DEFER_CONVERT
            if (L + 1 < DEPTH) { int rk, ni; idle_rank(S.nlat + S.nctx, F.G, (int)blockIdx.x, rk, ni);
                if (rk >= 0) convert_layer<(L + 1 < DEPTH ? L + 1 : 0)>(F, MK_DS1, MK_DS2, rk * NWAVES + F.wave, ni * NWAVES); }
#endif
            SEAM(base + 4);
        }
        if (IN(base + 5)) { STAMP(base + 5); FRAME(); WSPTRS();
            _Pragma("unroll") for (int rep_ = 0; rep_ < REPN(MK_RB_NORM); ++rep_) norm_mod_phase<RES32, (L == 0) || RES32, RES32>(F, XB, XB + CTXOFF, INP(I_NFG) + (size_t)L * DM, modL + 3 * DM, modL + 4 * DM, H, rows,
                !last ? (const float*)(ws + WS_SLAB) : nullptr, mx == 1 ? 8 : 4, xin_ctx, modL + 2 * DM, XB + CTXOFF);
            SEAM(base + 5); }
#if MK_FFN_HALVES
        if (IN(base + 6)) { STAMP(base + 6); FRAME(); WSPTRS();
            constexpr int npan = (rows + 253) / 254, pan0 = 0, pan1 = 33;
            pg8::Gemm g{H - DM, (const bf16*)(ws + WS_WUP) + (size_t)L * FFN2 * DM, npan * 256, FFN2, DM, 254, nullptr, nullptr, 0}; pg8::StaticOrder S; S.init((pan1 - pan0) * 256, FFN2, F.G, (int)blockIdx.x); S.wgm = MK_WGM_UP; S.pm0 = pan0;
            pg8::EpiAct E{ACT, INP(I_FCW) + (size_t)L * 3 * FFN2, INP(I_FCB) + (size_t)L * FFN2, rows, (PG8_LAS float*)(F.lds + HALO_OFF), FFN_LD};
            _Pragma("unroll") for (int rep_ = 0; rep_ < REPN(MK_RB_UP); ++rep_)
            pg8::gemm_phase<pg8::EpiAct, pg8::StaticOrder, true, true>(F.lds + RING_OFF, g, S, E, wv_);
#if MK_DEFER_CONVERT
            if (L + 1 < DEPTH) { int rk, ni; idle_rank((pan1 - pan0) * (FFN2 / 256), F.G, (int)blockIdx.x, rk, ni);
                if (rk >= 0) convert_layer<(L + 1 < DEPTH ? L + 1 : 0)>(F, MK_DS2, (MK_DS2 + MK_DS3) / 2, rk * NWAVES + F.wave, ni * NWAVES); }
#endif
            SEAM(base + 6);
        }
        if (IN(base + 7)) { STAMP(base + 7); FRAME(); WSPTRS();
            pg8::Gemm g{ACT, (const bf16*)(ws + WS_WDN) + (size_t)L * DM * FFN_LD, rows, DM, FFN, 256, nullptr, nullptr, FFN_LD}; pg8::SplitOrder S; S.init(DM, FFN, 8, false, F.G, (int)blockIdx.x, 32, 0); S.lat.wgm = MK_WGM_DOWN;
            void* xo_lat = last ? (void*)OUTP() : (void*)XA;
            pg8::EpiResT<RES32, (L == DEPTH - 1) || RES32> E{XB, XB + CTXOFF, xo_lat, XA + CTXOFF, modL + 5 * DM, (float*)(ws + WS_SLAB)};
            _Pragma("unroll") for (int rep_ = 0; rep_ < REPN(MK_RB_DOWN); ++rep_)
            pg8::gemm_phase<pg8::EpiResT<RES32, (L == DEPTH - 1) || RES32>, pg8::SplitOrder, true, true>(F.lds + RING_OFF, g, S, E, wv_);
            SEAM(base + 7);
        }
        if (IN(base + 8)) { STAMP(base + 8); FRAME(); WSPTRS();
            constexpr int npan = (rows + 253) / 254, pan0 = 33, pan1 = npan;
            pg8::Gemm g{H - DM, (const bf16*)(ws + WS_WUP) + (size_t)L * FFN2 * DM, npan * 256, FFN2, DM, 254, nullptr, nullptr, 0}; pg8::StaticOrder S; S.init((pan1 - pan0) * 256, FFN2, F.G, (int)blockIdx.x); S.wgm = MK_WGM_UP; S.pm0 = pan0;
            pg8::EpiAct E{ACT, INP(I_FCW) + (size_t)L * 3 * FFN2, INP(I_FCB) + (size_t)L * FFN2, rows, (PG8_LAS float*)(F.lds + HALO_OFF), FFN_LD};
            _Pragma("unroll") for (int rep_ = 0; rep_ < REPN(MK_RB_UP); ++rep_)
            pg8::gemm_phase<pg8::EpiAct, pg8::StaticOrder, true, true>(F.lds + RING_OFF, g, S, E, wv_);
#if MK_DEFER_CONVERT
            if (L + 1 < DEPTH) { int rk, ni; idle_rank((pan1 - pan0) * (FFN2 / 256), F.G, (int)blockIdx.x, rk, ni);
                if (rk >= 0) convert_layer<(L + 1 < DEPTH ? L + 1 : 0)>(F, (MK_DS2 + MK_DS3) / 2, MK_DS3, rk * NWAVES + F.wave, ni * NWAVES); }
#endif
            SEAM(base + 8);
        }
        if (IN(base + 9)) { STAMP(base + 9); FRAME(); WSPTRS();
            pg8::Gemm g{ACT, (const bf16*)(ws + WS_WDN) + (size_t)L * DM * FFN_LD, rows, DM, FFN, 256, nullptr, nullptr, FFN_LD}; pg8::SplitOrder S; S.init(DM, FFN, 8, !last, F.G, (int)blockIdx.x, 32, 32); S.lat.wgm = MK_WGM_DOWN;
            void* xo_lat = last ? (void*)OUTP() : (void*)XA;
            pg8::EpiResT<RES32, (L == DEPTH - 1) || RES32> E{XB, XB + CTXOFF, xo_lat, XA + CTXOFF, modL + 5 * DM, (float*)(ws + WS_SLAB)};
            _Pragma("unroll") for (int rep_ = 0; rep_ < REPN(MK_RB_DOWN); ++rep_)
            pg8::gemm_phase<pg8::EpiResT<RES32, (L == DEPTH - 1) || RES32>, pg8::SplitOrder, true, true>(F.lds + RING_OFF, g, S, E, wv_);
            SEAM(base + 9);
        }
#else
        if (IN(base + 6)) { STAMP(base + 6); FRAME(); WSPTRS();
            constexpr int npan = (rows + 253) / 254;
            pg8::Gemm g{H - DM, (const bf16*)(ws + WS_WUP) + (size_t)L * FFN2 * DM, npan * 256, FFN2, DM, 254, nullptr, nullptr, 0}; pg8::StaticOrder S; S.init(npan * 256, FFN2, F.G, (int)blockIdx.x); S.wgm = MK_WGM_UP;
            if (MK_XSTAG_UP > 0) { const unsigned long long d_ = (unsigned long long)(xb_xcc_id() & 7u) * MK_XSTAG_UP, t0_ = __builtin_amdgcn_s_memrealtime(); while (__builtin_amdgcn_s_memrealtime() - t0_ < d_) __builtin_amdgcn_s_sleep(4); }
            pg8::EpiAct E{ACT, INP(I_FCW) + (size_t)L * 3 * FFN2, INP(I_FCB) + (size_t)L * FFN2, rows, (PG8_LAS float*)(F.lds + HALO_OFF), FFN_LD};
            _Pragma("unroll") for (int rep_ = 0; rep_ < REPN(MK_RB_UP); ++rep_)
            pg8::gemm_phase<pg8::EpiAct, pg8::StaticOrder, true, true>(F.lds + RING_OFF, g, S, E, wv_);
#if MK_DEFER_CONVERT
            if (L + 1 < DEPTH) { int rk, ni; idle_rank(npan * (FFN2 / 256), F.G, (int)blockIdx.x, rk, ni);
                if (rk >= 0) convert_layer<(L + 1 < DEPTH ? L + 1 : 0)>(F, MK_DS2, MK_DS3, rk * NWAVES + F.wave, ni * NWAVES); }
#endif
            SEAM(base + 6);
        }
        if (IN(base + 7)) { STAMP(base + 7); FRAME(); WSPTRS();
            pg8::Gemm g{ACT, (const bf16*)(ws + WS_WDN) + (size_t)L * DM * FFN_LD, rows, DM, FFN, 256, nullptr, nullptr, FFN_LD}; pg8::SplitOrder S; S.init(DM, FFN, 8, !last, F.G, (int)blockIdx.x); S.rev = MK_DOWN_REV; S.lat.wgm = MK_WGM_DOWN;
            void* xo_lat = last ? (void*)OUTP() : (void*)XA;
            if (MK_STAGGER_TICKS > 0 && (blockIdx.x & 1)) { const unsigned long long t0_ = __builtin_amdgcn_s_memrealtime(); while (__builtin_amdgcn_s_memrealtime() - t0_ < (unsigned long long)MK_STAGGER_TICKS) __builtin_amdgcn_s_sleep(8); }
            pg8::EpiResT<RES32, (L == DEPTH - 1) || RES32> E{XB, XB + CTXOFF, xo_lat, XA + CTXOFF, modL + 5 * DM, (float*)(ws + WS_SLAB)};
            _Pragma("unroll") for (int rep_ = 0; rep_ < REPN(MK_RB_DOWN); ++rep_)
            pg8::gemm_phase<pg8::EpiResT<RES32, (L == DEPTH - 1) || RES32>, pg8::SplitOrder, true, true>(F.lds + RING_OFF, g, S, E, wv_);
#if MK_DEFER_CONVERT
            if (L + 1 < DEPTH) { int rk, ni; idle_rank(S.nlat + S.nctx, F.G, (int)blockIdx.x, rk, ni);
                if (rk >= 0) convert_layer<(L + 1 < DEPTH ? L + 1 : 0)>(F, MK_DS3, 256, rk * NWAVES + F.wave, ni * NWAVES); }
#endif
            SEAM(base + 7);
        }
#endif
    }
    { constexpr int L = 2;
        const int base = 1 + PH_PER_LAYER * L, mx = L % 3, jx = L / 3;
        const bool last = (L == DEPTH - 1);
        constexpr int rows = (L == DEPTH - 1) ? ML : MT;
        if (IN(base + 0)) { STAMP(base + 0); FRAME(); WSPTRS();
            const float* modP = mod + (size_t)(L > 0 ? L - 1 : 0) * 3 * NMOD;
            _Pragma("unroll") for (int rep_ = 0; rep_ < REPN(MK_RB_NORM); ++rep_) norm_mod_phase<(L == 0) || RES32, RES32, RES32>(F, xin_lat, xin_ctx, INP(I_NMG) + (size_t)L * DM, modL + 0 * DM, modL + 1 * DM, H, MT,
                L > 0 ? (const float*)(ws + WS_SLAB) : nullptr, 8, XB + CTXOFF, modP + 5 * DM, XA + CTXOFF);
            SEAM(base + 0); }
        if (IN(base + 1)) { STAMP(base + 1); FRAME(); WSPTRS();
            const bf16* Wa; int Na; bf16* Oa; bool acta; int modea = 0, modeb = 0, ldca;
            const bf16* Wb; int Mb; bf16* Ob; bool actb, statb;
            if (mx == 0) { Wa = (const bf16*)(ws + WS_WQKV) + (size_t)jx * 6144 * DM; Na = 4096; Oa = (bf16*)(BIG + BIG_QK); acta = false; modea = 1; modeb = 2;
                           Wb = Wa + (size_t)4096 * DM; Mb = 2048; Ob = (bf16*)(BIG + BIG_VT); actb = false; statb = false; }
            else if (mx == 1) { Wa = (const bf16*)(ws + WS_WGIN); Na = 4096; Oa = (bf16*)(BIG + BIG_U); acta = true;
                           Wb = Wa + (size_t)4096 * DM; Mb = 4096; Ob = (bf16*)(BIG + BIG_GVT); actb = true; statb = true; modeb = 3; }
            else { Wa = (const bf16*)(ws + WS_WCIN); Na = 6144; Oa = (bf16*)(BIG + BIG_BCX); acta = false; Wb = nullptr; Mb = 0; Ob = nullptr; actb = false; statb = false; }
            ldca = modea == 1 ? MT : Na;
            pg8::Gemm g{H, Wa, MT, Na, DM, 256, Wb, H, 0}; pg8::DualOrder S; S.init(Na, Mb, F.G, (int)blockIdx.x); S.wgm0 = MK_WGM_IN0; S.wgm1 = MK_WGM_IN1;
            if (MK_XSTAG_IN > 0) { const unsigned long long d_ = (unsigned long long)(xb_xcc_id() & 7u) * MK_XSTAG_IN, t0_ = __builtin_amdgcn_s_memrealtime(); while (__builtin_amdgcn_s_memrealtime() - t0_ < d_) __builtin_amdgcn_s_sleep(4); }
            if constexpr (L % 3 == 1) {
                pg8::EpiDual E{ pg8::EpiBf16R{Oa, ldca, nullptr, acta, false, modea, (PG8_LAS float*)(F.lds + HALO_OFF), INP(I_NAQG) + jx * HD, INP(I_NAKG) + jx * HD},
                                pg8::EpiBf16R{Ob, MT, PST, actb, statb, modeb, nullptr, nullptr, nullptr} };
                _Pragma("unroll") for (int rep_ = 0; rep_ < REPN(MK_RB_GIN); ++rep_)
                pg8::gemm_phase<pg8::EpiDual, pg8::DualOrder, true, true>(F.lds + RING_OFF, g, S, E, wv_);
            } else {
                constexpr int kM0 = (L % 3 == 0) ? 1 : 0, kM1 = (L % 3 == 0) ? 2 : 0;
                typedef pg8::EpiDualT<kM0, false, false, kM1, false, false> EpiIn;
                EpiIn E{ pg8::EpiBf16T<kM0, false, false>{Oa, ldca, nullptr, (PG8_LAS float*)(F.lds + HALO_OFF), INP(I_NAQG) + jx * HD, INP(I_NAKG) + jx * HD},
                         pg8::EpiBf16T<kM1, false, false>{Ob, MT, PST, nullptr, nullptr, nullptr} };
                _Pragma("unroll") for (int rep_ = 0; rep_ < REPN(MK_RB_GIN); ++rep_)
                pg8::gemm_phase<EpiIn, pg8::DualOrder, true, true>(F.lds + RING_OFF, g, S, E, wv_);
            }
#if MK_DEFER_CONVERT
            if (L + 1 < DEPTH) { int rk, ni; idle_rank(S.n0 + S.n1 + S.c0 + 2 * S.nM1, F.G, (int)blockIdx.x, rk, ni);
                if (rk >= 0) convert_layer<(L + 1 < DEPTH ? L + 1 : 0)>(F, 0, MK_DS1, rk * NWAVES + F.wave, ni * NWAVES); }
#endif
            SEAM(base + 1);
        }
        if (IN(base + 3)) { STAMP(base + 3); FRAME(); WSPTRS();
            _Pragma("unroll") for (int rep_ = 0; rep_ < REPN(MK_RB_CORE); ++rep_) {
            if (mx == 0) attn_phase(F, (const bf16*)(BIG + BIG_QK), (const bf16*)(BIG + BIG_VT), (bf16*)(BIG + BIG_O), INP(I_NARPB) + (size_t)jx * NH * 15 * 31, !last);
            else if (mx == 1) gm_spatial_phase(F, (const bf16*)(BIG + BIG_U), (const bf16*)(BIG + BIG_GVT), (bf16*)(BIG + BIG_G), (const bf16*)(ws + WS_WGS), PST, INP(I_GMVG), INP(I_GMBS));
            else sc_conv_phase(F, (const bf16*)(BIG + BIG_BCX), (bf16*)(BIG + BIG_T), INP(I_SCCW));
            }
            SEAM(base + 3);
        }
        if (IN(base + 4)) { STAMP(base + 4); FRAME(); WSPTRS();
            const bf16* Ao; const bf16* Wo; int Ko;
            if (mx == 0) { Ao = (const bf16*)(BIG + BIG_O); Wo = (const bf16*)(ws + WS_WO) + (size_t)jx * DM * DM; Ko = DM; }
            else if (mx == 1) { Ao = (const bf16*)(BIG + BIG_G); Wo = (const bf16*)(ws + WS_WGOUT); Ko = GMW; }
            else { Ao = (const bf16*)(BIG + BIG_T); Wo = (const bf16*)(ws + WS_WCOUT); Ko = DM; }
            pg8::Gemm g{Ao, Wo, rows, DM, Ko, 256, nullptr, nullptr, 0}; pg8::SplitOrder S; S.init(DM, Ko, mx == 1 ? 8 : 4, !last, F.G, (int)blockIdx.x); S.lat.wgm = MK_WGM_OUT;
            if (MK_STAGGER_TICKS > 0 && (blockIdx.x & 1)) { const unsigned long long t0_ = __builtin_amdgcn_s_memrealtime(); while (__builtin_amdgcn_s_memrealtime() - t0_ < (unsigned long long)MK_STAGGER_TICKS) __builtin_amdgcn_s_sleep(8); }
            pg8::EpiResT<(L == 0) || RES32, RES32> E{xin_lat, xin_ctx, XB, XB + CTXOFF, modL + 2 * DM, (float*)(ws + WS_SLAB)};
            _Pragma("unroll") for (int rep_ = 0; rep_ < REPN(MK_RB_GOUT); ++rep_)
            pg8::gemm_phase<pg8::EpiResT<(L == 0) || RES32, RES32>, pg8::SplitOrder, true, true>(F.lds + RING_OFF, g, S, E, wv_);
#if MK_DEFER_CONVERT
            if (L + 1 < DEPTH) { int rk, ni; idle_rank(S.nlat + S.nctx, F.G, (int)blockIdx.x, rk, ni);
                if (rk >= 0) convert_layer<(L + 1 < DEPTH ? L + 1 : 0)>(F, MK_DS1, MK_DS2, rk * NWAVES + F.wave, ni * NWAVES); }
#endif
            SEAM(base + 4);
        }
        if (IN(base + 5)) { STAMP(base + 5); FRAME(); WSPTRS();
            _Pragma("unroll") for (int rep_ = 0; rep_ < REPN(MK_RB_NORM); ++rep_) norm_mod_phase<RES32, (L == 0) || RES32, RES32>(F, XB, XB + CTXOFF, INP(I_NFG) + (size_t)L * DM, modL + 3 * DM, modL + 4 * DM, H, rows,
                !last ? (const float*)(ws + WS_SLAB) : nullptr, mx == 1 ? 8 : 4, xin_ctx, modL + 2 * DM, XB + CTXOFF);
            SEAM(base + 5); }
#if MK_FFN_HALVES
        if (IN(base + 6)) { STAMP(base + 6); FRAME(); WSPTRS();
            constexpr int npan = (rows + 253) / 254, pan0 = 0, pan1 = 33;
            pg8::Gemm g{H - DM, (const bf16*)(ws + WS_WUP) + (size_t)L * FFN2 * DM, npan * 256, FFN2, DM, 254, nullptr, nullptr, 0}; pg8::StaticOrder S; S.init((pan1 - pan0) * 256, FFN2, F.G, (int)blockIdx.x); S.wgm = MK_WGM_UP; S.pm0 = pan0;
            pg8::EpiAct E{ACT, INP(I_FCW) + (size_t)L * 3 * FFN2, INP(I_FCB) + (size_t)L * FFN2, rows, (PG8_LAS float*)(F.lds + HALO_OFF), FFN_LD};
            _Pragma("unroll") for (int rep_ = 0; rep_ < REPN(MK_RB_UP); ++rep_)
            pg8::gemm_phase<pg8::EpiAct, pg8::StaticOrder, true, true>(F.lds + RING_OFF, g, S, E, wv_);
#if MK_DEFER_CONVERT
            if (L + 1 < DEPTH) { int rk, ni; idle_rank((pan1 - pan0) * (FFN2 / 256), F.G, (int)blockIdx.x, rk, ni);
                if (rk >= 0) convert_layer<(L + 1 < DEPTH ? L + 1 : 0)>(F, MK_DS2, (MK_DS2 + MK_DS3) / 2, rk * NWAVES + F.wave, ni * NWAVES); }
#endif
            SEAM(base + 6);
        }
        if (IN(base + 7)) { STAMP(base + 7); FRAME(); WSPTRS();
            pg8::Gemm g{ACT, (const bf16*)(ws + WS_WDN) + (size_t)L * DM * FFN_LD, rows, DM, FFN, 256, nullptr, nullptr, FFN_LD}; pg8::SplitOrder S; S.init(DM, FFN, 8, false, F.G, (int)blockIdx.x, 32, 0); S.lat.wgm = MK_WGM_DOWN;
            void* xo_lat = last ? (void*)OUTP() : (void*)XA;
            pg8::EpiResT<RES32, (L == DEPTH - 1) || RES32> E{XB, XB + CTXOFF, xo_lat, XA + CTXOFF, modL + 5 * DM, (float*)(ws + WS_SLAB)};
            _Pragma("unroll") for (int rep_ = 0; rep_ < REPN(MK_RB_DOWN); ++rep_)
            pg8::gemm_phase<pg8::EpiResT<RES32, (L == DEPTH - 1) || RES32>, pg8::SplitOrder, true, true>(F.lds + RING_OFF, g, S, E, wv_);
            SEAM(base + 7);
        }
        if (IN(base + 8)) { STAMP(base + 8); FRAME(); WSPTRS();
            constexpr int npan = (rows + 253) / 254, pan0 = 33, pan1 = npan;
            pg8::Gemm g{H - DM, (const bf16*)(ws + WS_WUP) + (size_t)L * FFN2 * DM, npan * 256, FFN2, DM, 254, nullptr, nullptr, 0}; pg8::StaticOrder S; S.init((pan1 - pan0) * 256, FFN2, F.G, (int)blockIdx.x); S.wgm = MK_WGM_UP; S.pm0 = pan0;
            pg8::EpiAct E{ACT, INP(I_FCW) + (size_t)L * 3 * FFN2, INP(I_FCB) + (size_t)L * FFN2, rows, (PG8_LAS float*)(F.lds + HALO_OFF), FFN_LD};
            _Pragma("unroll") for (int rep_ = 0; rep_ < REPN(MK_RB_UP); ++rep_)
            pg8::gemm_phase<pg8::EpiAct, pg8::StaticOrder, true, true>(F.lds + RING_OFF, g, S, E, wv_);
#if MK_DEFER_CONVERT
            if (L + 1 < DEPTH) { int rk, ni; idle_rank((pan1 - pan0) * (FFN2 / 256), F.G, (int)blockIdx.x, rk, ni);
                if (rk >= 0) convert_layer<(L + 1 < DEPTH ? L + 1 : 0)>(F, (MK_DS2 + MK_DS3) / 2, MK_DS3, rk * NWAVES + F.wave, ni * NWAVES); }
#endif
            SEAM(base + 8);
        }
        if (IN(base + 9)) { STAMP(base + 9); FRAME(); WSPTRS();
            pg8::Gemm g{ACT, (const bf16*)(ws + WS_WDN) + (size_t)L * DM * FFN_LD, rows, DM, FFN, 256, nullptr, nullptr, FFN_LD}; pg8::SplitOrder S; S.init(DM, FFN, 8, !last, F.G, (int)blockIdx.x, 32, 32); S.lat.wgm = MK_WGM_DOWN;
            void* xo_lat = last ? (void*)OUTP() : (void*)XA;
            pg8::EpiResT<RES32, (L == DEPTH - 1) || RES32> E{XB, XB + CTXOFF, xo_lat, XA + CTXOFF, modL + 5 * DM, (float*)(ws + WS_SLAB)};
            _Pragma("unroll") for (int rep_ = 0; rep_ < REPN(MK_RB_DOWN); ++rep_)
            pg8::gemm_phase<pg8::EpiResT<RES32, (L == DEPTH - 1) || RES32>, pg8::SplitOrder, true, true>(F.lds + RING_OFF, g, S, E, wv_);
            SEAM(base + 9);
        }
#else
        if (IN(base + 6)) { STAMP(base + 6); FRAME(); WSPTRS();
            constexpr int npan = (rows + 253) / 254;
            pg8::Gemm g{H - DM, (const bf16*)(ws + WS_WUP) + (size_t)L * FFN2 * DM, npan * 256, FFN2, DM, 254, nullptr, nullptr, 0}; pg8::StaticOrder S; S.init(npan * 256, FFN2, F.G, (int)blockIdx.x); S.wgm = MK_WGM_UP;
            if (MK_XSTAG_UP > 0) { const unsigned long long d_ = (unsigned long long)(xb_xcc_id() & 7u) * MK_XSTAG_UP, t0_ = __builtin_amdgcn_s_memrealtime(); while (__builtin_amdgcn_s_memrealtime() - t0_ < d_) __builtin_amdgcn_s_sleep(4); }
            pg8::EpiAct E{ACT, INP(I_FCW) + (size_t)L * 3 * FFN2, INP(I_FCB) + (size_t)L * FFN2, rows, (PG8_LAS float*)(F.lds + HALO_OFF), FFN_LD};
            _Pragma("unroll") for (int rep_ = 0; rep_ < REPN(MK_RB_UP); ++rep_)
            pg8::gemm_phase<pg8::EpiAct, pg8::StaticOrder, true, true>(F.lds + RING_OFF, g, S, E, wv_);
#if MK_DEFER_CONVERT
            if (L + 1 < DEPTH) { int rk, ni; idle_rank(npan * (FFN2 / 256), F.G, (int)blockIdx.x, rk, ni);
                if (rk >= 0) convert_layer<(L + 1 < DEPTH ? L + 1 : 0)>(F, MK_DS2, MK_DS3, rk * NWAVES + F.wave, ni * NWAVES); }
#endif
            SEAM(base + 6);
        }
        if (IN(base + 7)) { STAMP(base + 7); FRAME(); WSPTRS();
            pg8::Gemm g{ACT, (const bf16*)(ws + WS_WDN) + (size_t)L * DM * FFN_LD, rows, DM, FFN, 256, nullptr, nullptr, FFN_LD}; pg8::SplitOrder S; S.init(DM, FFN, 8, !last, F.G, (int)blockIdx.x); S.rev = MK_DOWN_REV; S.lat.wgm = MK_WGM_DOWN;
            void* xo_lat = last ? (void*)OUTP() : (void*)XA;
            if (MK_STAGGER_TICKS > 0 && (blockIdx.x & 1)) { const unsigned long long t0_ = __builtin_amdgcn_s_memrealtime(); while (__builtin_amdgcn_s_memrealtime() - t0_ < (unsigned long long)MK_STAGGER_TICKS) __builtin_amdgcn_s_sleep(8); }
            pg8::EpiResT<RES32, (L == DEPTH - 1) || RES32> E{XB, XB + CTXOFF, xo_lat, XA + CTXOFF, modL + 5 * DM, (float*)(ws + WS_SLAB)};
            _Pragma("unroll") for (int rep_ = 0; rep_ < REPN(MK_RB_DOWN); ++rep_)
            pg8::gemm_phase<pg8::EpiResT<RES32, (L == DEPTH - 1) || RES32>, pg8::SplitOrder, true, true>(F.lds + RING_OFF, g, S, E, wv_);
#if MK_DEFER_CONVERT
            if (L + 1 < DEPTH) { int rk, ni; idle_rank(S.nlat + S.nctx, F.G, (int)blockIdx.x, rk, ni);
                if (rk >= 0) convert_layer<(L + 1 < DEPTH ? L + 1 : 0)>(F, MK_DS3, 256, rk * NWAVES + F.wave, ni * NWAVES); }
#endif
            SEAM(base + 7);
        }
#endif
    }
    { constexpr int L = 3;
        const int base = 1 + PH_PER_LAYER * L, mx = L % 3, jx = L / 3;
        const bool last = (L == DEPTH - 1);
        constexpr int rows = (L == DEPTH - 1) ? ML : MT;
        if (IN(base + 0)) { STAMP(base + 0); FRAME(); WSPTRS();
            const float* modP = mod + (size_t)(L > 0 ? L - 1 : 0) * 3 * NMOD;
            _Pragma("unroll") for (int rep_ = 0; rep_ < REPN(MK_RB_NORM); ++rep_) norm_mod_phase<(L == 0) || RES32, RES32, RES32>(F, xin_lat, xin_ctx, INP(I_NMG) + (size_t)L * DM, modL + 0 * DM, modL + 1 * DM, H, MT,
                L > 0 ? (const float*)(ws + WS_SLAB) : nullptr, 8, XB + CTXOFF, modP + 5 * DM, XA + CTXOFF);
            SEAM(base + 0); }
        if (IN(base + 1)) { STAMP(base + 1); FRAME(); WSPTRS();
            const bf16* Wa; int Na; bf16* Oa; bool acta; int modea = 0, modeb = 0, ldca;
            const bf16* Wb; int Mb; bf16* Ob; bool actb, statb;
            if (mx == 0) { Wa = (const bf16*)(ws + WS_WQKV) + (size_t)jx * 6144 * DM; Na = 4096; Oa = (bf16*)(BIG + BIG_QK); acta = false; modea = 1; modeb = 2;
                           Wb = Wa + (size_t)4096 * DM; Mb = 2048; Ob = (bf16*)(BIG + BIG_VT); actb = false; statb = false; }
            else if (mx == 1) { Wa = (const bf16*)(ws + WS_WGIN); Na = 4096; Oa = (bf16*)(BIG + BIG_U); acta = true;
                           Wb = Wa + (size_t)4096 * DM; Mb = 4096; Ob = (bf16*)(BIG + BIG_GVT); actb = true; statb = true; modeb = 3; }
            else { Wa = (const bf16*)(ws + WS_WCIN); Na = 6144; Oa = (bf16*)(BIG + BIG_BCX); acta = false; Wb = nullptr; Mb = 0; Ob = nullptr; actb = false; statb = false; }
            ldca = modea == 1 ? MT : Na;
            pg8::Gemm g{H, Wa, MT, Na, DM, 256, Wb, H, 0}; pg8::DualOrder S; S.init(Na, Mb, F.G, (int)blockIdx.x); S.wgm0 = MK_WGM_IN0; S.wgm1 = MK_WGM_IN1;
            if (MK_XSTAG_IN > 0) { const unsigned long long d_ = (unsigned long long)(xb_xcc_id() & 7u) * MK_XSTAG_IN, t0_ = __builtin_amdgcn_s_memrealtime(); while (__builtin_amdgcn_s_memrealtime() - t0_ < d_) __builtin_amdgcn_s_sleep(4); }
            if constexpr (L % 3 == 1) {
                pg8::EpiDual E{ pg8::EpiBf16R{Oa, ldca, nullptr, acta, false, modea, (PG8_LAS float*)(F.lds + HALO_OFF), INP(I_NAQG) + jx * HD, INP(I_NAKG) + jx * HD},
                                pg8::EpiBf16R{Ob, MT, PST, actb, statb, modeb, nullptr, nullptr, nullptr} };
                _Pragma("unroll") for (int rep_ = 0; rep_ < REPN(MK_RB_GIN); ++rep_)
                pg8::gemm_phase<pg8::EpiDual, pg8::DualOrder, true, true>(F.lds + RING_OFF, g, S, E, wv_);
            } else {
                constexpr int kM0 = (L % 3 == 0) ? 1 : 0, kM1 = (L % 3 == 0) ? 2 : 0;
                typedef pg8::EpiDualT<kM0, false, false, kM1, false, false> EpiIn;
                EpiIn E{ pg8::EpiBf16T<kM0, false, false>{Oa, ldca, nullptr, (PG8_LAS float*)(F.lds + HALO_OFF), INP(I_NAQG) + jx * HD, INP(I_NAKG) + jx * HD},
                         pg8::EpiBf16T<kM1, false, false>{Ob, MT, PST, nullptr, nullptr, nullptr} };
                _Pragma("unroll") for (int rep_ = 0; rep_ < REPN(MK_RB_GIN); ++rep_)
                pg8::gemm_phase<EpiIn, pg8::DualOrder, true, true>(F.lds + RING_OFF, g, S, E, wv_);
            }
#if MK_DEFER_CONVERT
            if (L + 1 < DEPTH) { int rk, ni; idle_rank(S.n0 + S.n1 + S.c0 + 2 * S.nM1, F.G, (int)blockIdx.x, rk, ni);
                if (rk >= 0) convert_layer<(L + 1 < DEPTH ? L + 1 : 0)>(F, 0, MK_DS1, rk * NWAVES + F.wave, ni * NWAVES); }
#endif
            SEAM(base + 1);
        }
        if (IN(base + 3)) { STAMP(base + 3); FRAME(); WSPTRS();
            _Pragma("unroll") for (int rep_ = 0; rep_ < REPN(MK_RB_CORE); ++rep_) {
            if (mx == 0) attn_phase(F, (const bf16*)(BIG + BIG_QK), (const bf16*)(BIG + BIG_VT), (bf16*)(BIG + BIG_O), INP(I_NARPB) + (size_t)jx * NH * 15 * 31, !last);
            else if (mx == 1) gm_spatial_phase(F, (const bf16*)(BIG + BIG_U), (const bf16*)(BIG + BIG_GVT), (bf16*)(BIG + BIG_G), (const bf16*)(ws + WS_WGS), PST, INP(I_GMVG), INP(I_GMBS));
            else sc_conv_phase(F, (const bf16*)(BIG + BIG_BCX), (bf16*)(BIG + BIG_T), INP(I_SCCW));
            }
            SEAM(base + 3);
        }
        if (IN(base + 4)) { STAMP(base + 4); FRAME(); WSPTRS();
            const bf16* Ao; const bf16* Wo; int Ko;
            if (mx == 0) { Ao = (const bf16*)(BIG + BIG_O); Wo = (const bf16*)(ws + WS_WO) + (size_t)jx * DM * DM; Ko = DM; }
            else if (mx == 1) { Ao = (const bf16*)(BIG + BIG_G); Wo = (const bf16*)(ws + WS_WGOUT); Ko = GMW; }
            else { Ao = (const bf16*)(BIG + BIG_T); Wo = (const bf16*)(ws + WS_WCOUT); Ko = DM; }
            pg8::Gemm g{Ao, Wo, rows, DM, Ko, 256, nullptr, nullptr, 0}; pg8::SplitOrder S; S.init(DM, Ko, mx == 1 ? 8 : 4, !last, F.G, (int)blockIdx.x); S.lat.wgm = MK_WGM_OUT;
            if (MK_STAGGER_TICKS > 0 && (blockIdx.x & 1)) { const unsigned long long t0_ = __builtin_amdgcn_s_memrealtime(); while (__builtin_amdgcn_s_memrealtime() - t0_ < (unsigned long long)MK_STAGGER_TICKS) __builtin_amdgcn_s_sleep(8); }
            pg8::EpiResT<(L == 0) || RES32, RES32> E{xin_lat, xin_ctx, XB, XB + CTXOFF, modL + 2 * DM, (float*)(ws + WS_SLAB)};
            _Pragma("unroll") for (int rep_ = 0; rep_ < REPN(MK_RB_GOUT); ++rep_)
            pg8::gemm_phase<pg8::EpiResT<(L == 0) || RES32, RES32>, pg8::SplitOrder, true, true>(F.lds + RING_OFF, g, S, E, wv_);
#if MK_DEFER_CONVERT
            if (L + 1 < DEPTH) { int rk, ni; idle_rank(S.nlat + S.nctx, F.G, (int)blockIdx.x, rk, ni);
                if (rk >= 0) convert_layer<(L + 1 < DEPTH ? L + 1 : 0)>(F, MK_DS1, MK_DS2, rk * NWAVES + F.wave, ni * NWAVES); }
#endif
            SEAM(base + 4);
        }
        if (IN(base + 5)) { STAMP(base + 5); FRAME(); WSPTRS();
            _Pragma("unroll") for (int rep_ = 0; rep_ < REPN(MK_RB_NORM); ++rep_) norm_mod_phase<RES32, (L == 0) || RES32, RES32>(F, XB, XB + CTXOFF, INP(I_NFG) + (size_t)L * DM, modL + 3 * DM, modL + 4 * DM, H, rows,
                !last ? (const float*)(ws + WS_SLAB) : nullptr, mx == 1 ? 8 : 4, xin_ctx, modL + 2 * DM, XB + CTXOFF);
            SEAM(base + 5); }
#if MK_FFN_HALVES
        if (IN(base + 6)) { STAMP(base + 6); FRAME(); WSPTRS();
            constexpr int npan = (rows + 253) / 254, pan0 = 0, pan1 = 33;
            pg8::Gemm g{H - DM, (const bf16*)(ws + WS_WUP) + (size_t)L * FFN2 * DM, npan * 256, FFN2, DM, 254, nullptr, nullptr, 0}; pg8::StaticOrder S; S.init((pan1 - pan0) * 256, FFN2, F.G, (int)blockIdx.x); S.wgm = MK_WGM_UP; S.pm0 = pan0;
            pg8::EpiAct E{ACT, INP(I_FCW) + (size_t)L * 3 * FFN2, INP(I_FCB) + (size_t)L * FFN2, rows, (PG8_LAS float*)(F.lds + HALO_OFF), FFN_LD};
            _Pragma("unroll") for (int rep_ = 0; rep_ < REPN(MK_RB_UP); ++rep_)
            pg8::gemm_phase<pg8::EpiAct, pg8::StaticOrder, true, true>(F.lds + RING_OFF, g, S, E, wv_);
#if MK_DEFER_CONVERT
            if (L + 1 < DEPTH) { int rk, ni; idle_rank((pan1 - pan0) * (FFN2 / 256), F.G, (int)blockIdx.x, rk, ni);
                if (rk >= 0) convert_layer<(L + 1 < DEPTH ? L + 1 : 0)>(F, MK_DS2, (MK_DS2 + MK_DS3) / 2, rk * NWAVES + F.wave, ni * NWAVES); }
#endif
            SEAM(base + 6);
        }
        if (IN(base + 7)) { STAMP(base + 7); FRAME(); WSPTRS();
            pg8::Gemm g{ACT, (const bf16*)(ws + WS_WDN) + (size_t)L * DM * FFN_LD, rows, DM, FFN, 256, nullptr, nullptr, FFN_LD}; pg8::SplitOrder S; S.init(DM, FFN, 8, false, F.G, (int)blockIdx.x, 32, 0); S.lat.wgm = MK_WGM_DOWN;
            void* xo_lat = last ? (void*)OUTP() : (void*)XA;
            pg8::EpiResT<RES32, (L == DEPTH - 1) || RES32> E{XB, XB + CTXOFF, xo_lat, XA + CTXOFF, modL + 5 * DM, (float*)(ws + WS_SLAB)};
            _Pragma("unroll") for (int rep_ = 0; rep_ < REPN(MK_RB_DOWN); ++rep_)
            pg8::gemm_phase<pg8::EpiResT<RES32, (L == DEPTH - 1) || RES32>, pg8::SplitOrder, true, true>(F.lds + RING_OFF, g, S, E, wv_);
            SEAM(base + 7);
        }
        if (IN(base + 8)) { STAMP(base + 8); FRAME(); WSPTRS();
            constexpr int npan = (rows + 253) / 254, pan0 = 33, pan1 = npan;
            pg8::Gemm g{H - DM, (const bf16*)(ws + WS_WUP) + (size_t)L * FFN2 * DM, npan * 256, FFN2, DM, 254, nullptr, nullptr, 0}; pg8::StaticOrder S; S.init((pan1 - pan0) * 256, FFN2, F.G, (int)blockIdx.x); S.wgm = MK_WGM_UP; S.pm0 = pan0;
            pg8::EpiAct E{ACT, INP(I_FCW) + (size_t)L * 3 * FFN2, INP(I_FCB) + (size_t)L * FFN2, rows, (PG8_LAS float*)(F.lds + HALO_OFF), FFN_LD};
            _Pragma("unroll") for (int rep_ = 0; rep_ < REPN(MK_RB_UP); ++rep_)
            pg8::gemm_phase<pg8::EpiAct, pg8::StaticOrder, true, true>(F.lds + RING_OFF, g, S, E, wv_);
#if MK_DEFER_CONVERT
            if (L + 1 < DEPTH) { int rk, ni; idle_rank((pan1 - pan0) * (FFN2 / 256), F.G, (int)blockIdx.x, rk, ni);
                if (rk >= 0) convert_layer<(L + 1 < DEPTH ? L + 1 : 0)>(F, (MK_DS2 + MK_DS3) / 2, MK_DS3, rk * NWAVES + F.wave, ni * NWAVES); }
#endif
            SEAM(base + 8);
        }
        if (IN(base + 9)) { STAMP(base + 9); FRAME(); WSPTRS();
            pg8::Gemm g{ACT, (const bf16*)(ws + WS_WDN) + (size_t)L * DM * FFN_LD, rows, DM, FFN, 256, nullptr, nullptr, FFN_LD}; pg8::SplitOrder S; S.init(DM, FFN, 8, !last, F.G, (int)blockIdx.x, 32, 32); S.lat.wgm = MK_WGM_DOWN;
            void* xo_lat = last ? (void*)OUTP() : (void*)XA;
            pg8::EpiResT<RES32, (L == DEPTH - 1) || RES32> E{XB, XB + CTXOFF, xo_lat, XA + CTXOFF, modL + 5 * DM, (float*)(ws + WS_SLAB)};
            _Pragma("unroll") for (int rep_ = 0; rep_ < REPN(MK_RB_DOWN); ++rep_)
            pg8::gemm_phase<pg8::EpiResT<RES32, (L == DEPTH - 1) || RES32>, pg8::SplitOrder, true, true>(F.lds + RING_OFF, g, S, E, wv_);
            SEAM(base + 9);
        }
#else
        if (IN(base + 6)) { STAMP(base + 6); FRAME(); WSPTRS();
            constexpr int npan = (rows + 253) / 254;
            pg8::Gemm g{H - DM, (const bf16*)(ws + WS_WUP) + (size_t)L * FFN2 * DM, npan * 256, FFN2, DM, 254, nullptr, nullptr, 0}; pg8::StaticOrder S; S.init(npan * 256, FFN2, F.G, (int)blockIdx.x); S.wgm = MK_WGM_UP;
            if (MK_XSTAG_UP > 0) { const unsigned long long d_ = (unsigned long long)(xb_xcc_id() & 7u) * MK_XSTAG_UP, t0_ = __builtin_amdgcn_s_memrealtime(); while (__builtin_amdgcn_s_memrealtime() - t0_ < d_) __builtin_amdgcn_s_sleep(4); }
            pg8::EpiAct E{ACT, INP(I_FCW) + (size_t)L * 3 * FFN2, INP(I_FCB) + (size_t)L * FFN2, rows, (PG8_LAS float*)(F.lds + HALO_OFF), FFN_LD};
            _Pragma("unroll") for (int rep_ = 0; rep_ < REPN(MK_RB_UP); ++rep_)
            pg8::gemm_phase<pg8::EpiAct, pg8::StaticOrder, true, true>(F.lds + RING_OFF, g, S, E, wv_);
#if MK_DEFER_CONVERT
            if (L + 1 < DEPTH) { int rk, ni; idle_rank(npan * (FFN2 / 256), F.G, (int)blockIdx.x, rk, ni);
                if (rk >= 0) convert_layer<(L + 1 < DEPTH ? L + 1 : 0)>(F, MK_DS2, MK_DS3, rk * NWAVES + F.wave, ni * NWAVES); }
#endif
            SEAM(base + 6);
        }
        if (IN(base + 7)) { STAMP(base + 7); FRAME(); WSPTRS();
            pg8::Gemm g{ACT, (const bf16*)(ws + WS_WDN) + (size_t)L * DM * FFN_LD, rows, DM, FFN, 256, nullptr, nullptr, FFN_LD}; pg8::SplitOrder S; S.init(DM, FFN, 8, !last, F.G, (int)blockIdx.x); S.rev = MK_DOWN_REV; S.lat.wgm = MK_WGM_DOWN;
            void* xo_lat = last ? (void*)OUTP() : (void*)XA;
            if (MK_STAGGER_TICKS > 0 && (blockIdx.x & 1)) { const unsigned long long t0_ = __builtin_amdgcn_s_memrealtime(); while (__builtin_amdgcn_s_memrealtime() - t0_ < (unsigned long long)MK_STAGGER_TICKS) __builtin_amdgcn_s_sleep(8); }
            pg8::EpiResT<RES32, (L == DEPTH - 1) || RES32> E{XB, XB + CTXOFF, xo_lat, XA + CTXOFF, modL + 5 * DM, (float*)(ws + WS_SLAB)};
            _Pragma("unroll") for (int rep_ = 0; rep_ < REPN(MK_RB_DOWN); ++rep_)
            pg8::gemm_phase<pg8::EpiResT<RES32, (L == DEPTH - 1) || RES32>, pg8::SplitOrder, true, true>(F.lds + RING_OFF, g, S, E, wv_);
#if MK_DEFER_CONVERT
            if (L + 1 < DEPTH) { int rk, ni; idle_rank(S.nlat + S.nctx, F.G, (int)blockIdx.x, rk, ni);
                if (rk >= 0) convert_layer<(L + 1 < DEPTH ? L + 1 : 0)>(F, MK_DS3, 256, rk * NWAVES + F.wave, ni * NWAVES); }
#endif
            SEAM(base + 7);
        }
#endif
    }
#if MK_STAMP
    { XcdBarrier bar_; bar_.bar = (unsigned*)(WSP() + WS_CTL) + CW_BAR; bar_.x = xb_xcc_id(); bar_.st = (volatile LAS unsigned*)((LAS unsigned char*)lds + MISC_OFF) + 8; xcd_barrier(bar_); }
    STAMP(NPHASES);
    if (blockIdx.x == 0 && threadIdx.x == 0) {
        const unsigned long long* st = (const unsigned long long*)(WSP() + WS_CTL + 4 * CW_STAMP); unsigned long long tot = 0;
        for (int k = 0; k < NPHASES; ++k) { const int j = k == 0 ? -1 : (k - 1) % PH_PER_LAYER, L = k == 0 ? -1 : (k - 1) / PH_PER_LAYER; int cat;
            if (k == 0) cat = 0; else if (j == 0 || j == 5) cat = 1; else if (j == 1) cat = 2; else if (j == 2) cat = 3; else if (j == 3) cat = (L % 3 == 0) ? 4 : (L % 3 == 1 ? 5 : 6); else if (j == 4) cat = 7; else if (j == 6) cat = 8; else if (j == 7) cat = 9; else cat = 10;
            if (cat == MK_STAMP_SEL || (MK_STAMP_SEL == 11 && (cat == 2 || cat == 7 || cat == 8 || cat == 10)) || (MK_STAMP_SEL == 12 && (cat == 1 || cat == 3 || cat == 9))) tot += st[k + 1] - st[k]; }
        OUTP()[0] = (float)tot * 10.0f;
    }
#endif
#undef IN
#undef SEAM
}

extern "C" void kernel_launch(void* const* d_in, const int* in_sizes, int n_in, void* d_out, int out_size, void* d_ws, size_t ws_size, hipStream_t stream) {
    static int grid = 0;
    if (grid == 0) {
        if (n_in != N_IN || in_sizes[0] != ML * DM || out_size != ML * DM || ws_size < WS_END) {
            fprintf(stderr, "kernel_launch: unexpected problem: n_in %d in0 %d out %d ws %zu (need %zu); nothing launched\n", n_in, n_in > 0 ? in_sizes[0] : -1, out_size, ws_size, (size_t)WS_END); grid = -1; return; }
        int dev = 0, cus = 0, per_cu = 0;
        if (hipGetDevice(&dev) != hipSuccess || hipDeviceGetAttribute(&cus, hipDeviceAttributeMultiprocessorCount, dev) != hipSuccess) { grid = -1; return; }
        if (hipFuncSetAttribute((const void*)mk_fwd, hipFuncAttributeMaxDynamicSharedMemorySize, LDS_BYTES) != hipSuccess) { fprintf(stderr, "kernel_launch: hipFuncSetAttribute failed\n"); grid = -1; return; }
        if (hipOccupancyMaxActiveBlocksPerMultiprocessor(&per_cu, (const void*)mk_fwd, NWAVES * 64, LDS_BYTES) != hipSuccess || per_cu < 1) { fprintf(stderr, "kernel_launch: occupancy query says %d blocks per CU\n", per_cu); }
        (void)hipGetLastError();
        grid = cus;
    }
    if (grid < 0) return;
    if (hipMemsetAsync((char*)d_ws + WS_CTL, 0, CTL_ZERO_BYTES, stream) != hipSuccess) return;
    Args a{};
    for (int i = 0; i < N_IN; ++i) a.in[i] = (const float*)d_in[i];
    a.out = (float*)d_out; a.ws = (unsigned char*)d_ws;
    a.ph_lo = 0; a.ph_hi = NPHASES;
    hipLaunchKernelGGL(mk_fwd, dim3(grid), dim3(NWAVES * 64), LDS_BYTES, stream, a);
    const hipError_t le = hipPeekAtLastError();
    if (le != hipSuccess) fprintf(stderr, "kernel_launch: launch failed: %s\n", hipGetErrorName(le));
}
```

```cpp
#include <hip/hip_runtime.h>
#include <cstdio>
#include <cstdint>

#ifndef MK_STAMP
#define MK_STAMP 0
#endif
#ifndef MK_STAMP_SEL
#define MK_STAMP_SEL 0
#endif
#ifndef MK_REPS
#define MK_REPS 0
#endif
#ifndef MK_REPL
#define MK_REPL 15
#endif
enum { MK_RB_PRO = 0, MK_RB_NORM = 1, MK_RB_GIN = 2, MK_RB_CORE = 3, MK_RB_GOUT = 4, MK_RB_UP = 5, MK_RB_ACT = 6, MK_RB_DOWN = 7 };
#define REPN(bit) (1 + (((MK_REPS >> (bit)) & 1) & ((MK_REPL >> L) & 1)))
#ifndef MK_STAGGER_TICKS
#define MK_STAGGER_TICKS 0
#endif
#ifndef MK_DOUBLE_BAR
#define MK_DOUBLE_BAR 0
#endif
#ifndef MK_DEFER_CONVERT
#define MK_DEFER_CONVERT 1
#endif
#ifndef MK_DS1
#define MK_DS1 128
#endif
#ifndef MK_DS2
#define MK_DS2 128
#endif
#ifndef MK_DS3
#define MK_DS3 256
#endif
#ifndef MK_DOWN_REV
#define MK_DOWN_REV false
#endif
#ifndef MK_WGM_UP
#define MK_WGM_UP 4
#endif
#ifndef MK_WGM_OUT
#define MK_WGM_OUT 4
#endif
#ifndef MK_WGM_DOWN
#define MK_WGM_DOWN 8
#endif
#ifndef MK_WGM_IN0
#define MK_WGM_IN0 4
#endif
#ifndef MK_WGM_IN1
#define MK_WGM_IN1 4
#endif
#ifndef MK_EPI_PROBE
#define MK_EPI_PROBE 0
#endif
#ifndef MK_RES_BF16
#define MK_RES_BF16 1
#endif
#ifndef MK_NT_B
#define MK_NT_B 0
#endif
#ifndef MK_XSTAG_UP
#define MK_XSTAG_UP 0
#endif
#ifndef MK_XSTAG_IN
#define MK_XSTAG_IN 0
#endif
#ifndef MK_ISTAG_UP
#define MK_ISTAG_UP 0
#endif
#ifndef MK_ISTAG_WAYS
#define MK_ISTAG_WAYS 4
#endif
#ifndef MK_RES_ALLLOADS
#define MK_RES_ALLLOADS 1
#endif
#ifndef MK_FFN_LD
#define MK_FFN_LD 6144
#endif
#ifndef MK_FFN_HALVES
#define MK_FFN_HALVES 0
#endif
namespace pg8 {
#define PG8_LAS __attribute__((address_space(3)))
typedef unsigned short bf16_t;
typedef short bf16x8 __attribute__((ext_vector_type(8)));
typedef float f32x4 __attribute__((ext_vector_type(4)));
typedef unsigned u32x4 __attribute__((ext_vector_type(4)));
constexpr int BM = 256, BK = 64, HALF = 128, HTB = HALF * BK * 2  , STAGE_BYTES = 8 * HTB, NXCD = 8, WGM = 4;

__host__ __device__ __forceinline__ int lds_byte(int r, int c) { const int st = (r >> 4) * 2 + (c >> 5), rr = r & 15, cc = c & 31, ob = rr * 64 + cc * 2; return st * 1024 + (ob ^ (((ob >> 9) & 1) << 5)); }
__host__ __device__ __forceinline__ void stage_rc(int b, int& R, int& C) { const int st = b / 1024, sb = b % 1024, swz = sb ^ (((sb >> 9) & 1) << 5); R = (st >> 1) * 16 + swz / 64; C = (st & 1) * 32 + (swz % 64) / 2; }
__host__ __device__ __forceinline__ int perm32(int rho) { const int n = rho >> 4, i = rho & 15; return 8 * (i >> 2) + 4 * n + (i & 3); }

struct Unit { int pm, pn, kt0, ktn, ks, which; };
struct Gemm { const bf16_t* A; const bf16_t* Bt; int M, N, K; int panel_rows; const bf16_t* A2; const bf16_t* Bt2; int ldk; };

struct StaticOrder {
    int nM, nN, nwg, G, c, wgm, pm0;
    __host__ __device__ void init(int M, int N, int G_, int c_) { nM = M / BM; nN = N / BM; nwg = nM * nN; G = G_; c = c_; wgm = WGM; pm0 = 0; }
    __host__ __device__ __forceinline__ bool next(int i, Unit& u) const {
        const long L = (long)i * G + c; if (L >= nwg) return false;
        int wgid = (int)L; { const int q = nwg / NXCD, r = nwg % NXCD, xcd = wgid % NXCD, off = wgid / NXCD; wgid = (xcd < r ? xcd * (q + 1) : r * (q + 1) + (xcd - r) * q) + off; }
        const int nig = wgm * nN, gid = wgid / nig, fm = gid * wgm, gsz = (nM - fm) < wgm ? (nM - fm) : wgm;
        u.pm = pm0 + fm + ((wgid % nig) % gsz); u.pn = (wgid % nig) / gsz; u.kt0 = 0; u.ktn = 0; u.ks = -1; u.which = 0; return true;
    }
    __device__ __forceinline__ void a_ready(const Unit&) const {}
    __device__ __forceinline__ void done(const Unit&) const {}
};

struct SplitOrder {
    StaticOrder lat; int nN, S, C, G, c, nlat, nctx; bool rev;
    __host__ __device__ void init(int N, int K, int S_, bool has_ctx, int G_, int c_, int nlatp = 64, int pm0_ = 0) { lat.init(nlatp * BM, N, G_, c_); lat.pm0 = pm0_; nN = N / BM; S = S_; C = K / 128; G = G_; c = c_; nlat = nlatp * nN; nctx = has_ctx ? 2 * nN * S : 0; rev = false; }
    __host__ __device__ __forceinline__ bool next(int i, Unit& u) const {
        const long L = (long)i * G + c;
        if (L < nlat) { const bool ok = lat.next(i, u); if (rev) u.pm = 63 - u.pm; return ok; }
        const int r = (int)(L - nlat); if (r >= nctx) return false;
        const int ks = r % S, q = r / S; u.pn = q % nN; u.pm = 64 + q / nN;
        const int c0 = (C * ks) / S, c1 = (C * (ks + 1)) / S; u.kt0 = 2 * c0; u.ktn = 2 * (c1 - c0); u.ks = ks; u.which = 0; return true;
    }
    __device__ __forceinline__ void a_ready(const Unit&) const {}
    __device__ __forceinline__ void done(const Unit&) const {}
};

__host__ __device__ __forceinline__ void static_map(int nM, int nN, int L, int& pm, int& pn, int wgm) {
    const int nwg = nM * nN; int wgid = L; { const int q = nwg / NXCD, r = nwg % NXCD, xcd = wgid % NXCD, off = wgid / NXCD; wgid = (xcd < r ? xcd * (q + 1) : r * (q + 1) + (xcd - r) * q) + off; }
    const int nig = wgm * nN, gid = wgid / nig, fm = gid * wgm, gsz = (nM - fm) < wgm ? (nM - fm) : wgm;
    pm = fm + ((wgid % nig) % gsz); pn = (wgid % nig) / gsz;
}
struct DualOrder {
    int nN0, nM1, G, c, n0, n1, c0, wgm0, wgm1;
    __host__ __device__ __forceinline__ void init(int N0, int M1, int G_, int c_) { nN0 = N0 / BM; nM1 = M1 / BM; G = G_; c = c_; n0 = 64 * nN0; n1 = 64 * nM1; c0 = 2 * nN0; wgm0 = WGM; wgm1 = WGM; }
    __host__ __device__ __forceinline__ bool next(int i, Unit& u) const {
        int L = i * G + c; int pm = 0, pn = 0, wh = 0; bool ok = true;
        if (L < n0) { static_map(64, nN0, L, pm, pn, wgm0); wh = 0; }
        else if (L < n0 + n1) { static_map(nM1, 64, L - n0, pm, pn, wgm1); wh = 1; }
        else if (L < n0 + n1 + c0) { const int r = L - n0 - n1; pm = 64 + r / nN0; pn = r % nN0; wh = 0; }
        else if (L < n0 + n1 + c0 + 2 * nM1) { const int r = L - n0 - n1 - c0; pm = r % nM1; pn = 64 + r / nM1; wh = 1; }
        else ok = false;
        u.pm = pm; u.pn = pn; u.kt0 = 0; u.ktn = 0; u.ks = -1; u.which = wh; return ok;
    }
    __device__ __forceinline__ void a_ready(const Unit&) const {}
    __device__ __forceinline__ void done(const Unit&) const {}
};

typedef __bf16 bf16v2 __attribute__((ext_vector_type(2)));
typedef float f32x2 __attribute__((ext_vector_type(2)));
__device__ __forceinline__ unsigned cvt_pk_bf16(float lo, float hi) { const f32x2 v = {lo, hi}; return __builtin_bit_cast(unsigned, __builtin_convertvector(v, bf16v2)); }

__device__ __forceinline__ float gelu_tanh(float x) {
    const float y2 = x * (1.5957691216f + 0.0713548163f * x * x);
    return x * __builtin_amdgcn_rcpf(1.0f + __builtin_amdgcn_exp2f(-1.4426950409f * y2));
}
template <int CTRL> __device__ __forceinline__ float dpp(float x) { return __builtin_bit_cast(float, __builtin_amdgcn_mov_dpp(__builtin_bit_cast(int, x), CTRL, 0xf, 0xf, true)); }
__device__ __forceinline__ float row16_sum(float s) { s += dpp<0xB1>(s); s += dpp<0x4E>(s); s += dpp<0x141>(s); s += dpp<0x128>(s); return s; }
__device__ __forceinline__ float xrow16_sum(float x) {
    auto s = __builtin_amdgcn_permlane16_swap(__float_as_uint(x), __float_as_uint(x), false, false); x = __uint_as_float(s[0]) + __uint_as_float(s[1]);
    auto t = __builtin_amdgcn_permlane32_swap(__float_as_uint(x), __float_as_uint(x), false, false); return __uint_as_float(t[0]) + __uint_as_float(t[1]);
}
__device__ __forceinline__ float silu_f(float x) { return x * __builtin_amdgcn_rcpf(1.0f + __builtin_amdgcn_exp2f(-1.4426950409f * x)); }

template <int MODE, bool ACT, bool STATS> struct EpiBf16T {
    static constexpr bool PERM = true, AFTER_DRAIN = false, PERM_A = false, PROBE_TWICE = false, NT_B = false;
    bf16_t* O; int ldc; float* P; PG8_LAS float* part; const float* qg; const float* kg;
    __device__ __forceinline__ void operator()(const f32x4 (&acc)[2][2][4][2], const Unit& u, int wr, int wc, int fr, int fq) const {
        const int row0 = u.pm * BM + wr * 64 + fr; const int col0 = u.pn * BM + wc * 32 + 8 * fq;
        float ss[2][2][4];
        if (STATS) {
#pragma unroll
            for (int bj = 0; bj < 2; ++bj)
#pragma unroll
                for (int n = 0; n < 2; ++n)
#pragma unroll
                    for (int e = 0; e < 4; ++e) ss[bj][n][e] = 0.f;
        }
        f32x4 gn0 = {1.f, 1.f, 1.f, 1.f}, gn1 = gn0;
        if (MODE == 1) {
#pragma unroll
            for (int ai = 0; ai < 2; ++ai)
#pragma unroll
                for (int m = 0; m < 4; ++m)
#pragma unroll
                    for (int bj = 0; bj < 2; ++bj) { const f32x4 a = acc[ai][bj][m][0], b = acc[ai][bj][m][1];
                        float sq = (a[0] * a[0] + a[1] * a[1]) + (a[2] * a[2] + a[3] * a[3]) + (b[0] * b[0] + b[1] * b[1]) + (b[2] * b[2] + b[3] * b[3]);
                        sq = xrow16_sum(sq);
                        if (fq == 0) part[(ai * HALF + wr * 64 + m * 16 + fr) * 8 + bj * 4 + wc] = sq; }
            asm volatile("s_waitcnt lgkmcnt(0)" ::: "memory"); __builtin_amdgcn_s_barrier(); asm volatile("" ::: "memory");
            const float* gp = (u.pn < 8 ? qg : kg) + wc * 32 + 8 * fq; gn0 = *(const f32x4*)gp; gn1 = *(const f32x4*)(gp + 4);
        }
#pragma unroll
        for (int ai = 0; ai < 2; ++ai)
#pragma unroll
            for (int m = 0; m < 4; ++m) { const int row = row0 + ai * HALF + m * 16; bf16_t* rowp = O + (size_t)row * ldc + col0;
#pragma unroll
                for (int bj = 0; bj < 2; ++bj) { f32x4 v0 = acc[ai][bj][m][0], v1 = acc[ai][bj][m][1];
                    bf16_t* dst = rowp + bj * HALF;
                    if (MODE == 1) dst = O + ((size_t)((2 * u.pn + bj) * 8 + 2 * wc + (fq >> 1)) * ldc + row) * 16 + 8 * (fq & 1);
                    if (MODE == 3) { const int tok = col0 + bj * HALF; dst = O + ((size_t)((row >> 5) * (ldc >> 4) + (tok >> 4)) * 32 + (row & 31)) * 16 + (tok & 8); }
                    if (MODE == 2) { const int tok = col0 + bj * HALF; dst = O + ((size_t)((row >> 7) * (ldc >> 3) + (tok >> 3)) * 128 + (row & 127)) * 8; }
                    if (ACT == 1) {
#pragma unroll
                        for (int e = 0; e < 4; ++e) { v0[e] = gelu_tanh(v0[e]); v1[e] = gelu_tanh(v1[e]); } }
                    if (STATS) {
#pragma unroll
                        for (int e = 0; e < 4; ++e) { ss[bj][0][e] += v0[e] * v0[e]; ss[bj][1][e] += v1[e] * v1[e]; } }
                    if (MODE == 1) { const f32x4 p4 = *(const PG8_LAS f32x4*)(part + (ai * HALF + wr * 64 + m * 16 + fr) * 8 + bj * 4);
                        const float rsd = __builtin_amdgcn_rsqf(((p4[0] + p4[1]) + (p4[2] + p4[3])) * (1.0f / 128.0f) + 1e-6f); v0 = v0 * rsd * gn0; v1 = v1 * rsd * gn1; }
                    u32x4 w; w.x = cvt_pk_bf16(v0[0], v0[1]); w.y = cvt_pk_bf16(v0[2], v0[3]); w.z = cvt_pk_bf16(v1[0], v1[1]); w.w = cvt_pk_bf16(v1[2], v1[3]);
                    *(u32x4*)dst = w; } }
        if (STATS) {
#pragma unroll
            for (int bj = 0; bj < 2; ++bj)
#pragma unroll
                for (int n = 0; n < 2; ++n)
#pragma unroll
                    for (int e = 0; e < 4; ++e) { ss[bj][n][e] = row16_sum(ss[bj][n][e]); }
            if (fr == 0) {
                float* pp = P + (size_t)(2 * u.pm + wr) * ldc + col0;
#pragma unroll
                for (int bj = 0; bj < 2; ++bj) { *(f32x4*)(pp + bj * HALF) = (f32x4){ss[bj][0][0], ss[bj][0][1], ss[bj][0][2], ss[bj][0][3]};
                                                 *(f32x4*)(pp + bj * HALF + 4) = (f32x4){ss[bj][1][0], ss[bj][1][1], ss[bj][1][2], ss[bj][1][3]}; }
            }
        }
    }
};

struct EpiBf16R {
    static constexpr bool PERM = true, AFTER_DRAIN = false, PERM_A = false, PROBE_TWICE = false, NT_B = false;
    bf16_t* O; int ldc; float* P; bool ACT, STATS; int MODE; PG8_LAS float* part; const float* qg; const float* kg;
    __device__ __forceinline__ void operator()(const f32x4 (&acc)[2][2][4][2], const Unit& u, int wr, int wc, int fr, int fq) const {
        const int row0 = u.pm * BM + wr * 64 + fr; const int col0 = u.pn * BM + wc * 32 + 8 * fq;
        float ss[2][2][4];
        if (STATS) {
#pragma unroll
            for (int bj = 0; bj < 2; ++bj)
#pragma unroll
                for (int n = 0; n < 2; ++n)
#pragma unroll
                    for (int e = 0; e < 4; ++e) ss[bj][n][e] = 0.f;
        }
        f32x4 gn0 = {1.f, 1.f, 1.f, 1.f}, gn1 = gn0;
        if (MODE == 1) {
#pragma unroll
            for (int ai = 0; ai < 2; ++ai)
#pragma unroll
                for (int m = 0; m < 4; ++m)
#pragma unroll
                    for (int bj = 0; bj < 2; ++bj) { const f32x4 a = acc[ai][bj][m][0], b = acc[ai][bj][m][1];
                        float sq = (a[0] * a[0] + a[1] * a[1]) + (a[2] * a[2] + a[3] * a[3]) + (b[0] * b[0] + b[1] * b[1]) + (b[2] * b[2] + b[3] * b[3]);
                        sq = xrow16_sum(sq);
                        if (fq == 0) part[(ai * HALF + wr * 64 + m * 16 + fr) * 8 + bj * 4 + wc] = sq; }
            asm volatile("s_waitcnt lgkmcnt(0)" ::: "memory"); __builtin_amdgcn_s_barrier(); asm volatile("" ::: "memory");
            const float* gp = (u.pn < 8 ? qg : kg) + wc * 32 + 8 * fq; gn0 = *(const f32x4*)gp; gn1 = *(const f32x4*)(gp + 4);
        }
#pragma unroll
        for (int ai = 0; ai < 2; ++ai)
#pragma unroll
            for (int m = 0; m < 4; ++m) { const int row = row0 + ai * HALF + m * 16; bf16_t* rowp = O + (size_t)row * ldc + col0;
#pragma unroll
                for (int bj = 0; bj < 2; ++bj) { f32x4 v0 = acc[ai][bj][m][0], v1 = acc[ai][bj][m][1];
                    bf16_t* dst = rowp + bj * HALF;
                    if (MODE == 1) dst = O + ((size_t)((2 * u.pn + bj) * 8 + 2 * wc + (fq >> 1)) * ldc + row) * 16 + 8 * (fq & 1);
                    if (MODE == 3) { const int tok = col0 + bj * HALF; dst = O + ((size_t)((row >> 5) * (ldc >> 4) + (tok >> 4)) * 32 + (row & 31)) * 16 + (tok & 8); }
                    if (MODE == 2) { const int tok = col0 + bj * HALF; dst = O + ((size_t)((row >> 7) * (ldc >> 3) + (tok >> 3)) * 128 + (row & 127)) * 8; }
                    if (ACT == 1) {
#pragma unroll
                        for (int e = 0; e < 4; ++e) { v0[e] = gelu_tanh(v0[e]); v1[e] = gelu_tanh(v1[e]); } }
                    if (STATS) {
#pragma unroll
                        for (int e = 0; e < 4; ++e) { ss[bj][0][e] += v0[e] * v0[e]; ss[bj][1][e] += v1[e] * v1[e]; } }
                    if (MODE == 1) { const f32x4 p4 = *(const PG8_LAS f32x4*)(part + (ai * HALF + wr * 64 + m * 16 + fr) * 8 + bj * 4);
                        const float rsd = 1.0f / sqrtf(((p4[0] + p4[1]) + (p4[2] + p4[3])) * (1.0f / 128.0f) + 1e-6f); v0 = v0 * rsd * gn0; v1 = v1 * rsd * gn1; }
                    u32x4 w; w.x = cvt_pk_bf16(v0[0], v0[1]); w.y = cvt_pk_bf16(v0[2], v0[3]); w.z = cvt_pk_bf16(v1[0], v1[1]); w.w = cvt_pk_bf16(v1[2], v1[3]);
                    *(u32x4*)dst = w; } }
        if (STATS) {
#pragma unroll
            for (int bj = 0; bj < 2; ++bj)
#pragma unroll
                for (int n = 0; n < 2; ++n)
#pragma unroll
                    for (int e = 0; e < 4; ++e) { ss[bj][n][e] = row16_sum(ss[bj][n][e]); }
            if (fr == 0) {
                float* pp = P + (size_t)(2 * u.pm + wr) * ldc + col0;
#pragma unroll
                for (int bj = 0; bj < 2; ++bj) { *(f32x4*)(pp + bj * HALF) = (f32x4){ss[bj][0][0], ss[bj][0][1], ss[bj][0][2], ss[bj][0][3]};
                                                 *(f32x4*)(pp + bj * HALF + 4) = (f32x4){ss[bj][1][0], ss[bj][1][1], ss[bj][1][2], ss[bj][1][3]}; }
            }
        }
    }
};

__device__ __forceinline__ void bf8_to_f32(const u32x4 r, f32x4& lo, f32x4& hi) {
    lo = (f32x4){__uint_as_float(r.x << 16), __uint_as_float(r.x & 0xffff0000u), __uint_as_float(r.y << 16), __uint_as_float(r.y & 0xffff0000u)};
    hi = (f32x4){__uint_as_float(r.z << 16), __uint_as_float(r.z & 0xffff0000u), __uint_as_float(r.w << 16), __uint_as_float(r.w & 0xffff0000u)};
}
template <bool IN32, bool OUT32> struct EpiResT {
    static constexpr bool PERM = true, AFTER_DRAIN = false, PERM_A = false, PROBE_TWICE = false, NT_B = (MK_NT_B & 2) != 0;
    const void* xin_lat; const void* xin_ctx; void* xout_lat; void* xout_ctx; const float* gate; float* slab;
    __device__ __forceinline__ void operator()(const f32x4 (&acc)[2][2][4][2], const Unit& u, int wr, int wc, int fr, int fq) const {
        const int col0 = u.pn * BM + wc * 32 + 8 * fq;
        if (u.ks >= 0) {
            float* sp = slab + ((size_t)u.ks * 512 + (u.pm - 64) * BM + wr * 64 + fr) * 2048 + col0;
#pragma unroll
            for (int ai = 0; ai < 2; ++ai)
#pragma unroll
                for (int m = 0; m < 4; ++m)
#pragma unroll
                    for (int bj = 0; bj < 2; ++bj)
#pragma unroll
                        for (int n = 0; n < 2; ++n) *(f32x4*)(sp + (size_t)(ai * HALF + m * 16) * 2048 + bj * HALF + 4 * n) = acc[ai][bj][m][n];
            return;
        }
        const int pm = u.pm; const int ci = pm < 32 ? 0 : (pm < 64 ? 1 : 2);
        const size_t pbase = (size_t)(pm < 64 ? pm : pm - 64) * BM * 2048 + (size_t)(wr * 64 + fr) * 2048 + col0;
        const char* xi = (const char*)(pm < 64 ? xin_lat : xin_ctx) + pbase * (IN32 ? 4 : 2);
        char* xo = (char*)(pm < 64 ? xout_lat : xout_ctx) + pbase * (OUT32 ? 4 : 2);
        f32x4 g4[2][2];
#pragma unroll
        for (int bj = 0; bj < 2; ++bj)
#pragma unroll
            for (int n = 0; n < 2; ++n) g4[bj][n] = *(const f32x4*)(gate + (size_t)ci * 12288 + col0 + bj * HALF + 4 * n);
        if constexpr (!IN32 && MK_RES_ALLLOADS) {
            u32x4 xq[2][4][2];
#pragma unroll
            for (int ai = 0; ai < 2; ++ai)
#pragma unroll
                for (int m = 0; m < 4; ++m)
#pragma unroll
                    for (int bj = 0; bj < 2; ++bj) xq[ai][m][bj] = __builtin_nontemporal_load((const u32x4*)(xi + ((size_t)(ai * HALF + m * 16) * 2048 + bj * HALF) * 2));
#pragma unroll
            for (int ai = 0; ai < 2; ++ai)
#pragma unroll
                for (int m = 0; m < 4; ++m) { const size_t off = (size_t)(ai * HALF + m * 16) * 2048;
#pragma unroll
                    for (int bj = 0; bj < 2; ++bj) {
                        f32x4 a0, a1; bf8_to_f32(xq[ai][m][bj], a0, a1);
                        const f32x4 r0 = a0 + g4[bj][0] * acc[ai][bj][m][0], r1 = a1 + g4[bj][1] * acc[ai][bj][m][1];
                        if (OUT32) { *(f32x4*)(xo + (off + bj * HALF) * 4) = r0; *(f32x4*)(xo + (off + bj * HALF + 4) * 4) = r1; }
                        else { u32x4 w; w.x = cvt_pk_bf16(r0[0], r0[1]); w.y = cvt_pk_bf16(r0[2], r0[3]); w.z = cvt_pk_bf16(r1[0], r1[1]); w.w = cvt_pk_bf16(r1[2], r1[3]); *(u32x4*)(xo + (off + bj * HALF) * 2) = w; } } }
            return;
        }
#pragma unroll
        for (int ai = 0; ai < 2; ++ai) {
            f32x4 xv[4][2][2]; u32x4 xr[4][2];
#pragma unroll
            for (int m = 0; m < 4; ++m) { const size_t off = (size_t)(ai * HALF + m * 16) * 2048;
#pragma unroll
                for (int bj = 0; bj < 2; ++bj) {
                    if (IN32) { xv[m][bj][0] = __builtin_nontemporal_load((const f32x4*)(xi + (off + bj * HALF) * 4)); xv[m][bj][1] = __builtin_nontemporal_load((const f32x4*)(xi + (off + bj * HALF + 4) * 4)); }
                    else xr[m][bj] = __builtin_nontemporal_load((const u32x4*)(xi + (off + bj * HALF) * 2)); } }
#pragma unroll
            for (int m = 0; m < 4; ++m) { const size_t off = (size_t)(ai * HALF + m * 16) * 2048;
#pragma unroll
                for (int bj = 0; bj < 2; ++bj) {
                    f32x4 a0, a1; if (IN32) { a0 = xv[m][bj][0]; a1 = xv[m][bj][1]; } else bf8_to_f32(xr[m][bj], a0, a1);
                    const f32x4 r0 = a0 + g4[bj][0] * acc[ai][bj][m][0], r1 = a1 + g4[bj][1] * acc[ai][bj][m][1];
                    if (OUT32) { *(f32x4*)(xo + (off + bj * HALF) * 4) = r0; *(f32x4*)(xo + (off + bj * HALF + 4) * 4) = r1; }
                    else { u32x4 w; w.x = cvt_pk_bf16(r0[0], r0[1]); w.y = cvt_pk_bf16(r0[2], r0[3]); w.z = cvt_pk_bf16(r1[0], r1[1]); w.w = cvt_pk_bf16(r1[2], r1[3]); *(u32x4*)(xo + (off + bj * HALF) * 2) = w; } } }
        }
    }
};

template <int CTRL> __device__ __forceinline__ float dpp_upd(float old, float src) {
    return __builtin_bit_cast(float, __builtin_amdgcn_update_dpp(__builtin_bit_cast(int, old), __builtin_bit_cast(int, src), CTRL, 0xf, 0xf, false)); }
struct EpiAct {
    static constexpr bool PERM = true, AFTER_DRAIN = false, PERM_A = true, PROBE_TWICE = (MK_EPI_PROBE == 1), NT_B = (MK_NT_B & 1) != 0;
    bf16_t* A; const float* cw; const float* cb; int rows; PG8_LAS float* halo; int ld;
    __device__ __forceinline__ void operator()(const f32x4 (&acc)[2][2][4][2], const Unit& u, int wr, int wc, int fr, int fq) const {
        typedef unsigned u32x2 __attribute__((ext_vector_type(2)));
        const int cl = wc * 32 + 8 * fq;
        if (fr == 0) {
#pragma unroll
            for (int ai = 0; ai < 2; ++ai)
#pragma unroll
                for (int bj = 0; bj < 2; ++bj)
#pragma unroll
                    for (int n = 0; n < 2; ++n) *(PG8_LAS f32x4*)(halo + ((2 * ai + wr) * 2 + 0) * 256 + bj * HALF + cl + 4 * n) = acc[ai][bj][0][n];
        }
        if (fr == 15) {
#pragma unroll
            for (int ai = 0; ai < 2; ++ai)
#pragma unroll
                for (int bj = 0; bj < 2; ++bj)
#pragma unroll
                    for (int n = 0; n < 2; ++n) *(PG8_LAS f32x4*)(halo + ((2 * ai + wr) * 2 + 1) * 256 + bj * HALF + cl + 4 * n) = acc[ai][bj][3][n];
        }
        asm volatile("s_waitcnt lgkmcnt(0)" ::: "memory"); __builtin_amdgcn_s_barrier(); asm volatile("" ::: "memory");
        unsigned pmask = 0u, nmask = 0u, omask = 0u;
#pragma unroll
        for (int ai = 0; ai < 2; ++ai)
#pragma unroll
            for (int m = 0; m < 4; ++m) { const int t = ai * HALF + wr * 64 + 4 * fr + m, g = u.pm * 254 - 1 + t; const unsigned bit = 1u << (ai * 4 + m);
                const int pos = g < 16384 ? (g & 8191) : ((g - 16384) & 255); const int last = g < 16384 ? 8191 : 255;
                if (pos != 0) pmask |= bit; if (pos != last) nmask |= bit; if (t >= 1 && t <= 254 && g >= 0 && g < rows) omask |= bit; }
#pragma unroll
        for (int n = 0; n < 2; ++n) {
            const int f = HALF * u.pn + cl + 4 * n;
            const f32x4 wg0 = *(const f32x4*)(cw + f), wg1 = *(const f32x4*)(cw + 11008 + f), wg2 = *(const f32x4*)(cw + 22016 + f), bg = *(const f32x4*)(cb + f);
            const f32x4 wu0 = *(const f32x4*)(cw + 5504 + f), wu1 = *(const f32x4*)(cw + 11008 + 5504 + f), wu2 = *(const f32x4*)(cw + 22016 + 5504 + f), bu = *(const f32x4*)(cb + 5504 + f);
#pragma unroll
            for (int ai = 0; ai < 2; ++ai) {
                const int seg = 2 * ai + wr, sp = seg > 0 ? seg - 1 : 0, sn = seg < 3 ? seg + 1 : 3;
                const f32x4 hpg = *(const PG8_LAS f32x4*)(halo + (sp * 2 + 1) * 256 + cl + 4 * n), hpu = *(const PG8_LAS f32x4*)(halo + (sp * 2 + 1) * 256 + HALF + cl + 4 * n);
                const f32x4 hng = *(const PG8_LAS f32x4*)(halo + (sn * 2 + 0) * 256 + cl + 4 * n), hnu = *(const PG8_LAS f32x4*)(halo + (sn * 2 + 0) * 256 + HALF + cl + 4 * n);
#pragma unroll
                for (int m = 0; m < 4; ++m) {
                    const unsigned bit = 1u << (ai * 4 + m); const bool pok = (pmask & bit) != 0u, nok = (nmask & bit) != 0u;
                    float o[4];
#pragma unroll
                    for (int e = 0; e < 4; ++e) {
                        const float zg = acc[ai][0][m][n][e], zu = acc[ai][1][m][n][e];
                        const float pg = m > 0 ? acc[ai][0][m > 0 ? m - 1 : 0][n][e] : dpp_upd<0x111>(hpg[e], acc[ai][0][3][n][e]);
                        const float pu = m > 0 ? acc[ai][1][m > 0 ? m - 1 : 0][n][e] : dpp_upd<0x111>(hpu[e], acc[ai][1][3][n][e]);
                        const float ng = m < 3 ? acc[ai][0][m < 3 ? m + 1 : 3][n][e] : dpp_upd<0x101>(hng[e], acc[ai][0][0][n][e]);
                        const float nu = m < 3 ? acc[ai][1][m < 3 ? m + 1 : 3][n][e] : dpp_upd<0x101>(hnu[e], acc[ai][1][0][n][e]);
                        float yg = wg1[e] * zg + bg[e], yu = wu1[e] * zu + bu[e];
                        yg += pok ? wg0[e] * pg : 0.f; yu += pok ? wu0[e] * pu : 0.f;
                        yg += nok ? wg2[e] * ng : 0.f; yu += nok ? wu2[e] * nu : 0.f;
                        o[e] = silu_f(yg) * yu;
                    }
                    if (omask & bit) { const int g = u.pm * 254 - 1 + ai * HALF + wr * 64 + 4 * fr + m;
                        *(u32x2*)(A + (size_t)g * ld + f) = (u32x2){cvt_pk_bf16(o[0], o[1]), cvt_pk_bf16(o[2], o[3])}; }
                }
            }
        }
    }
};

template <int M0, bool A0, bool S0, int M1, bool A1, bool S1> struct EpiDualT {
    static constexpr bool PERM = true, AFTER_DRAIN = false, PERM_A = false, PROBE_TWICE = (MK_EPI_PROBE == 3), NT_B = false;
    EpiBf16T<M0, A0, S0> e0; EpiBf16T<M1, A1, S1> e1;
    __device__ __forceinline__ void operator()(const f32x4 (&acc)[2][2][4][2], const Unit& u, int wr, int wc, int fr_, int fq_) const {
        int fr = fr_, fq = fq_; asm volatile("" : "+v"(fr), "+v"(fq));
        if (u.which == 0) e0(acc, u, wr, wc, fr, fq); else e1(acc, u, wr, wc, fr, fq); }
};

struct EpiDual {
    static constexpr bool PERM = true, AFTER_DRAIN = false, PERM_A = false, PROBE_TWICE = (MK_EPI_PROBE == 3), NT_B = false;
    EpiBf16R e0, e1;
    __device__ __forceinline__ void operator()(const f32x4 (&acc)[2][2][4][2], const Unit& u, int wr, int wc, int fr, int fq) const {
        EpiBf16R e;
        const bool w = u.which != 0;
        e.O = w ? e1.O : e0.O; e.ldc = w ? e1.ldc : e0.ldc; e.P = w ? e1.P : e0.P; e.ACT = w ? e1.ACT : e0.ACT; e.STATS = w ? e1.STATS : e0.STATS; e.MODE = w ? e1.MODE : e0.MODE;
        e.part = e0.part; e.qg = e0.qg; e.kg = e0.kg;
        e(acc, u, wr, wc, fr, fq); }
};
template <class Epi, class Sched, bool ALIGN_EPI = false, bool SP2 = false>
__device__ __forceinline__ void gemm_phase(PG8_LAS unsigned char* lds, const Gemm g, const Sched& S, const Epi& E, const int wave_idx) {
    int tid_ = wave_idx * 64 + (int)__builtin_amdgcn_mbcnt_hi(~0u, __builtin_amdgcn_mbcnt_lo(~0u, 0u)); asm volatile("" : "+v"(tid_)); const int tid = tid_, wid = __builtin_amdgcn_readfirstlane(tid >> 6), lane = tid & 63, wr = wid >> 2, wc = wid & 3, fr = lane & 15, fq = lane >> 4;
    const int K = g.K, nt = K / BK, LD = g.ldk ? g.ldk : g.K;
    unsigned voffA[2], voffB[2];
#pragma unroll
    for (int i = 0; i < 2; ++i) { int R, C; stage_rc(tid * 16 + i * 8192, R, C); const int Rb = Epi::PERM ? ((R & ~31) + perm32(R & 31)) : R;
        const int Ra = Epi::PERM_A ? ((R & ~63) + 4 * (R & 15) + ((R & 63) >> 4)) : R;
        voffA[i] = (unsigned)(Ra * LD + C) * 2u; voffB[i] = (unsigned)(Rb * LD + C) * 2u; }
    const size_t kstep = (size_t)(BK * 2);
    const size_t hstep = (size_t)HALF * LD * 2;
    const size_t tstep = 2 * hstep; const size_t tstepA = (size_t)g.panel_rows * LD * 2;
    const unsigned ldsw = (unsigned)wid * 1024u;
    const int aoff = lds_byte(wr * 64 + fr, fq * 8), boff = lds_byte(wc * 32 + fr, fq * 8);
#define PG8_SA(b, h) (((b) * 2 + (h)) * HTB)
#define PG8_SB(b, h) ((4 + (b) * 2 + (h)) * HTB)
#define PG8_STAGE_(bufoff, gbase, voff, aux) do { _Pragma("unroll") for (int _i = 0; _i < 2; ++_i) \
        __builtin_amdgcn_global_load_lds((const unsigned*)((const char*)(gbase) + (voff)[_i]), (PG8_LAS unsigned*)(lds + (bufoff) + ldsw + _i * 8192), 16, 0, aux); } while (0)
#define PG8_STAGE(bufoff, gbase, voff) PG8_STAGE_(bufoff, gbase, voff, 0)
#define PG8_STAGEB(bufoff, gbase, voff) do { if (Epi::NT_B) PG8_STAGE_(bufoff, gbase, voff, 2); else PG8_STAGE_(bufoff, gbase, voff, 0); } while (0)
#define PG8_LDA(dst, b, h) do { _Pragma("unroll") for (int m = 0; m < 4; ++m) _Pragma("unroll") for (int k = 0; k < 2; ++k) dst[m][k] = *(const PG8_LAS bf16x8*)(lds + PG8_SA(b, h) + aoff + m * 2048 + k * 1024); } while (0)
#define PG8_LDB(dst, b, h) do { _Pragma("unroll") for (int n = 0; n < 2; ++n) _Pragma("unroll") for (int k = 0; k < 2; ++k) dst[n][k] = *(const PG8_LAS bf16x8*)(lds + PG8_SB(b, h) + boff + n * 2048 + k * 1024); } while (0)
#define PG8_MMA(ai, bj, At, Bt) do { __builtin_amdgcn_s_setprio(1); _Pragma("unroll") for (int m = 0; m < 4; ++m) _Pragma("unroll") for (int n = 0; n < 2; ++n) _Pragma("unroll") for (int k = 0; k < 2; ++k) \
        acc[ai][bj][m][n] = __builtin_amdgcn_mfma_f32_16x16x32_bf16(Bt[n][k], At[m][k], acc[ai][bj][m][n], 0, 0, 0); __builtin_amdgcn_s_setprio(0); } while (0)
#define PG8_WAIT_V(n) asm volatile("s_waitcnt vmcnt(" #n ")" ::: "memory")
#define PG8_WAIT_L(n) asm volatile("s_waitcnt lgkmcnt(" #n ")" ::: "memory")
#define PG8_BAR __builtin_amdgcn_s_barrier()
#define PG8_SCHED __builtin_amdgcn_sched_barrier(0)
    Unit cur, nxt; int ui = 0;
    if (!S.next(0, cur)) return;
    f32x4 acc[2][2][4][2];
#pragma unroll
    for (int a = 0; a < 2; ++a)
#pragma unroll
        for (int b = 0; b < 2; ++b)
#pragma unroll
            for (int m = 0; m < 4; ++m)
#pragma unroll
                for (int n = 0; n < 2; ++n) acc[a][b][m][n] = (f32x4){0.f, 0.f, 0.f, 0.f};
    bf16x8 At[4][2], B0[2][2], B1[2][2];
    const char* cA = (const char*)(cur.which ? g.A2 : g.A) + (size_t)cur.pm * tstepA + (size_t)cur.kt0 * kstep; const char* cB = (const char*)(cur.which ? g.Bt2 : g.Bt) + (size_t)cur.pn * tstep + (size_t)cur.kt0 * kstep;
    S.a_ready(cur);
    if constexpr (SP2) {
        PG8_STAGEB(PG8_SB(0, 0), cB, voffB); PG8_STAGEB(PG8_SB(0, 1), cB + hstep, voffB); PG8_STAGE(PG8_SA(0, 0), cA, voffA); PG8_STAGE(PG8_SA(0, 1), cA + hstep, voffA);
        if (wr == 1) PG8_BAR;
        PG8_WAIT_V(2); PG8_BAR;
        PG8_STAGEB(PG8_SB(1, 0), cB + kstep, voffB); PG8_STAGE(PG8_SA(1, 0), cA + kstep, voffA); PG8_STAGEB(PG8_SB(1, 1), cB + hstep + kstep, voffB);
        PG8_WAIT_V(6); PG8_BAR;
    } else {
        PG8_STAGEB(PG8_SB(0, 0), cB, voffB); PG8_STAGE(PG8_SA(0, 0), cA, voffA); PG8_STAGEB(PG8_SB(0, 1), cB + hstep, voffB); PG8_STAGE(PG8_SA(0, 1), cA + hstep, voffA);
        if (wr == 1) PG8_BAR;
        PG8_WAIT_V(4); PG8_BAR;
        PG8_STAGEB(PG8_SB(1, 0), cB + kstep, voffB); PG8_STAGE(PG8_SA(1, 0), cA + kstep, voffA); PG8_STAGEB(PG8_SB(1, 1), cB + hstep + kstep, voffB);
        PG8_WAIT_V(6); PG8_BAR;
    }
    for (;;) {
        const bool has_next = S.next(ui + 1, nxt);
        const char* nA = has_next ? (const char*)(nxt.which ? g.A2 : g.A) + (size_t)nxt.pm * tstepA + (size_t)nxt.kt0 * kstep : cA; const char* nB = has_next ? (const char*)(nxt.which ? g.Bt2 : g.Bt) + (size_t)nxt.pn * tstep + (size_t)nxt.kt0 * kstep : cB;
        const int ntc = cur.ktn ? cur.ktn : nt;
        for (int t = 0; t < ntc; t += 2) {
            const bool last = (t == ntc - 2);
            const char* a1 = cA + (size_t)(t + 1) * kstep;
            const char* a2 = last ? nA : cA + (size_t)(t + 2) * kstep; const char* b2 = last ? nB : cB + (size_t)(t + 2) * kstep;
            const char* a3 = a2 + kstep; const char* b3 = b2 + kstep;
            if (last && has_next) S.a_ready(nxt);
            if constexpr (SP2) {
            PG8_LDB(B0, 0, 0); PG8_LDB(B1, 0, 1); PG8_SCHED; PG8_LDA(At, 0, 0); PG8_STAGE(PG8_SA(1, 1), a1 + hstep, voffA);
            PG8_WAIT_V(8); PG8_WAIT_L(0); PG8_BAR; PG8_MMA(0, 0, At, B0); PG8_MMA(0, 1, At, B1); PG8_BAR; PG8_SCHED;
            PG8_LDA(At, 0, 1); PG8_STAGEB(PG8_SB(0, 0), b2, voffB); PG8_STAGEB(PG8_SB(0, 1), b2 + hstep, voffB); PG8_STAGE(PG8_SA(0, 0), a2, voffA);
            PG8_WAIT_V(8); PG8_WAIT_L(0); PG8_BAR; PG8_MMA(1, 0, At, B0); PG8_MMA(1, 1, At, B1); PG8_BAR; PG8_SCHED;
            PG8_LDB(B0, 1, 0); PG8_LDB(B1, 1, 1); PG8_SCHED; PG8_LDA(At, 1, 0); PG8_STAGE(PG8_SA(0, 1), a2 + hstep, voffA);
            PG8_WAIT_V(8); PG8_WAIT_L(0); PG8_BAR; PG8_MMA(0, 0, At, B0); PG8_MMA(0, 1, At, B1); PG8_BAR; PG8_SCHED;
            PG8_LDA(At, 1, 1); PG8_STAGEB(PG8_SB(1, 0), b3, voffB); PG8_STAGEB(PG8_SB(1, 1), b3 + hstep, voffB); PG8_STAGE(PG8_SA(1, 0), a3, voffA);
            PG8_WAIT_V(8); PG8_WAIT_L(0); PG8_BAR; PG8_MMA(1, 0, At, B0); PG8_MMA(1, 1, At, B1); PG8_BAR; PG8_SCHED;
            } else {
            PG8_LDB(B0, 0, 0); PG8_SCHED; PG8_LDA(At, 0, 0); PG8_STAGE(PG8_SA(1, 1), a1 + hstep, voffA);
            PG8_WAIT_L(8); PG8_BAR; PG8_WAIT_L(0); PG8_MMA(0, 0, At, B0); PG8_BAR; PG8_SCHED;
            PG8_LDB(B1, 0, 1); PG8_STAGEB(PG8_SB(0, 0), b2, voffB);
            PG8_BAR; PG8_WAIT_L(0); PG8_MMA(0, 1, At, B1); PG8_BAR;
            PG8_LDA(At, 0, 1); PG8_STAGE(PG8_SA(0, 0), a2, voffA);
            PG8_BAR; PG8_WAIT_L(0); PG8_MMA(1, 0, At, B0); PG8_BAR; PG8_SCHED;
            PG8_STAGEB(PG8_SB(0, 1), b2 + hstep, voffB);
            PG8_WAIT_V(6); PG8_BAR; PG8_MMA(1, 1, At, B1); PG8_BAR;
            PG8_LDB(B0, 1, 0); PG8_SCHED; PG8_LDA(At, 1, 0); PG8_STAGE(PG8_SA(0, 1), a2 + hstep, voffA);
            PG8_WAIT_L(8); PG8_BAR; PG8_WAIT_L(0); PG8_MMA(0, 0, At, B0); PG8_BAR; PG8_SCHED;
            PG8_LDB(B1, 1, 1); PG8_STAGEB(PG8_SB(1, 0), b3, voffB);
            PG8_BAR; PG8_WAIT_L(0); PG8_MMA(0, 1, At, B1); PG8_BAR;
            PG8_LDA(At, 1, 1); PG8_STAGE(PG8_SA(1, 0), a3, voffA);
            PG8_BAR; PG8_WAIT_L(0); PG8_MMA(1, 0, At, B0); PG8_BAR; PG8_SCHED;
            PG8_STAGEB(PG8_SB(1, 1), b3 + hstep, voffB);
            PG8_WAIT_V(6); PG8_BAR; PG8_MMA(1, 1, At, B1); PG8_BAR;
            }
        }
        if constexpr (ALIGN_EPI) { if (wr == 0) PG8_BAR; }
        if constexpr (!Epi::AFTER_DRAIN) { E(acc, cur, wr, wc, fr, fq); if constexpr (Epi::PROBE_TWICE) { asm volatile("" ::: "memory"); E(acc, cur, wr, wc, fr, fq); } S.done(cur); }
        if (!has_next) break;
#pragma unroll
        for (int a = 0; a < 2; ++a)
#pragma unroll
            for (int b = 0; b < 2; ++b)
#pragma unroll
                for (int m = 0; m < 4; ++m)
#pragma unroll
                    for (int n = 0; n < 2; ++n) acc[a][b][m][n] = (f32x4){0.f, 0.f, 0.f, 0.f};
        cur = nxt; cA = nA; cB = nB; ++ui;
        if constexpr (ALIGN_EPI) { if (wr == 1) PG8_BAR; }
    }
    PG8_WAIT_V(0);
    if constexpr (!ALIGN_EPI) { if (wr == 0) PG8_BAR; }
    PG8_BAR;
    if constexpr (Epi::AFTER_DRAIN) { E.fused(acc, cur, wr, wc, fr, fq, lds, wid, lane); S.done(cur); }
#undef PG8_SA
#undef PG8_SB
#undef PG8_STAGE
#undef PG8_STAGE_
#undef PG8_STAGEB
#undef PG8_LDA
#undef PG8_LDB
#undef PG8_MMA
#undef PG8_WAIT_V
#undef PG8_WAIT_L
#undef PG8_BAR
#undef PG8_SCHED
}
}

constexpr int NWAVES = 8;
constexpr int DM = 2048, NB = 2, SEQ = 8192, DEPTH = 4, CTXL = 256;
constexpr int ML = NB * SEQ;
constexpr int MC = NB * CTXL;
constexpr int MT = ML + MC;
constexpr int NH = 16, HD = 128, GRIDW = 64, GROWS = 128;
constexpr int GMW = 4096, GMG = 16, GMGD = 256, GMC = 128;
constexpr int FFN = 5504, FFN2 = 11008;
constexpr int FFN_LD = MK_FFN_LD;
constexpr float EPS = 1e-6f;
constexpr float LOG2E = 1.4426950408889634f;
constexpr int NMOD = 6 * DM;

enum { I_X = 0, I_C, I_CTX, I_CCTX, I_NMG, I_NFG, I_WADA, I_BADA, I_NAQKV, I_NAQG, I_NAKG, I_NARPB, I_NAWO, I_GMWIN, I_GMVG, I_GMWS, I_GMBS, I_GMWOUT,
       I_SCWIN, I_SCCW, I_SCWOUT, I_FUP, I_FCW, I_FCB, I_FDN, N_IN };

constexpr size_t MiB = 1u << 20;
constexpr size_t WS_CTL = 0, CTL_ZERO_BYTES = 1 * MiB;
constexpr size_t WS_MOD = 1 * MiB;
constexpr size_t WS_WQKV = 2 * MiB;
constexpr size_t WS_WO = 50 * MiB;
constexpr size_t WS_WGIN = 66 * MiB;
constexpr size_t WS_WGS = 98 * MiB;
constexpr size_t WS_WGOUT = 99 * MiB;
constexpr size_t WS_WCIN = 115 * MiB;
constexpr size_t WS_WCOUT = 139 * MiB;
constexpr size_t WS_WUP = 147 * MiB;
constexpr size_t WS_XA = 405 * MiB;
constexpr size_t WS_XB = 537 * MiB;
constexpr size_t WS_H = 669 * MiB + 4096;
constexpr size_t WS_ACT = 738 * MiB;
constexpr size_t WS_PST = 936 * MiB;
constexpr size_t WS_BIG = 939 * MiB;
constexpr size_t WS_SLAB = 1339 * MiB;
constexpr size_t WS_WDN = 1371 * MiB;
constexpr size_t WS_END = 1467 * MiB;
constexpr size_t BIG_QK = 0, BIG_VT = 132 * MiB, BIG_O = 198 * MiB;
constexpr size_t BIG_U = 0, BIG_GVT = 132 * MiB, BIG_G = 264 * MiB;
constexpr size_t BIG_BCX = 0, BIG_T = 198 * MiB;
constexpr size_t BIG_Z = 0;
constexpr int CW_TMO = 0, CW_BAR = 4096, CW_DIAG = 16384, CW_STAMP = 20480;

constexpr int RING_OFF = 0, RING_BYTES = 131072;
constexpr int LDSCTL_OFF = RING_BYTES, MISC_OFF = LDSCTL_OFF + 320, HALO_OFF = LDSCTL_OFF + 1024;
constexpr int LDS_BYTES = 147456;

#define GAS __attribute__((address_space(1)))
#define LAS __attribute__((address_space(3)))
typedef unsigned short bf16;
typedef unsigned v4u __attribute__((ext_vector_type(4)));
typedef unsigned v2u __attribute__((ext_vector_type(2)));
typedef float f32x4 __attribute__((ext_vector_type(4)));
typedef float f32x16 __attribute__((ext_vector_type(16)));
typedef short bf16x8 __attribute__((ext_vector_type(8)));
typedef short s16x4 __attribute__((ext_vector_type(4)));
typedef GAS unsigned gu32;
#define RLX_AGENT __ATOMIC_RELAXED, __HIP_MEMORY_SCOPE_AGENT
#define LDS_WAIT() asm volatile("s_waitcnt lgkmcnt(0)" ::: "memory")
__device__ __forceinline__ unsigned pk2(float lo, float hi) { return pg8::cvt_pk_bf16(lo, hi); }
__device__ __forceinline__ float bf2f(bf16 b) { return __uint_as_float(((unsigned)b) << 16); }
__device__ __forceinline__ float bflo(unsigned w) { return __uint_as_float(w << 16); }
__device__ __forceinline__ float bfhi(unsigned w) { return __uint_as_float(w & 0xffff0000u); }
__device__ __forceinline__ float wave_sum(float v) { return pg8::xrow16_sum(pg8::row16_sum(v)); }
__device__ __forceinline__ float swap32_max(float m) { auto rr = __builtin_amdgcn_permlane32_swap(__float_as_uint(m), __float_as_uint(m), false, false); return __builtin_fmaxf(__uint_as_float(rr[0]), __uint_as_float(rr[1])); }
__device__ __forceinline__ float swap32_sum(float m) { auto rr = __builtin_amdgcn_permlane32_swap(__float_as_uint(m), __float_as_uint(m), false, false); return __uint_as_float(rr[0]) + __uint_as_float(rr[1]); }
#define MFMA32(a, b, c) __builtin_amdgcn_mfma_f32_32x32x16_bf16((a), (b), (c), 0, 0, 0)

#define XB_TMO      128
#define XB_XCNT(j)  (256  + 64 * (j))
#define XB_XSUB(j)  (1280 + 64 * (j))
#define XB_XGEN(j)  (2304 + 64 * (j))
#define XB_TOP      3328
#define XB_TOPGEN   3392
#define XCD_BAR_WORDS 3456
#define XB_SPIN_CAP (1u << 18)

__device__ __forceinline__ unsigned xb_ld(unsigned* p)              { return __hip_atomic_load(p, __ATOMIC_RELAXED, __HIP_MEMORY_SCOPE_AGENT); }
__device__ __forceinline__ unsigned xb_add(unsigned* p, unsigned v) { return __hip_atomic_fetch_add(p, v, __ATOMIC_RELAXED, __HIP_MEMORY_SCOPE_AGENT); }
__device__ __forceinline__ unsigned xb_xcc_id() { return (unsigned)__builtin_amdgcn_s_getreg((3 << 11) | 20) & 0xFu; }
#define XB_SPIN(cond, bar) do { unsigned _sp = 0; while (cond) { __builtin_amdgcn_s_sleep(1); \
    if ((++_sp & 255u) == 0u) { if (xb_ld(&(bar)[XB_TMO])) break; if (_sp > XB_SPIN_CAP) { atomicAdd(&(bar)[XB_TMO], 1u); break; } } } } while (0)

struct XcdBarrier {
    unsigned* bar; unsigned x;
    volatile LAS unsigned* st;
};

__device__ __forceinline__ XcdBarrier xcd_barrier_post(unsigned* bar, volatile LAS unsigned* st) {
    XcdBarrier b; b.bar = bar; b.x = xb_xcc_id(); b.st = st;
    if (threadIdx.x == 0) (void)xb_add(&bar[XB_XCNT(b.x)], 1u);
    return b;
}
__device__ __forceinline__ void xcd_barrier_complete(unsigned* bar, unsigned x, unsigned& nloc, unsigned& nx) {
    const unsigned G = gridDim.x * gridDim.y * gridDim.z;
    unsigned sum, cnt, mine, sp = 0u;
    for (;;) {
        sum = 0u; cnt = 0u; mine = 0u;
#pragma unroll
        for (unsigned j = 0; j < 16; ++j) { const unsigned c = xb_ld(&bar[XB_XCNT(j)]); sum += c; cnt += (c > 0u) ? 1u : 0u; mine = (j == x) ? c : mine; }
        if (sum == G) break;
        __builtin_amdgcn_s_sleep(1);
        if ((++sp & 255u) == 0u) { if (xb_ld(&bar[XB_TMO])) break; if (sp > XB_SPIN_CAP) { atomicAdd(&bar[XB_TMO], 1u); break; } }
    }
    nloc = mine > 0u ? mine : 1u; nx = cnt > 0u ? cnt : 1u;
}

__device__ __forceinline__ void xcd_barrier(const XcdBarrier& b) {
    asm volatile("s_waitcnt vmcnt(0)" ::: "memory");
    __syncthreads();
    if (threadIdx.x == 0) {
        unsigned* bar = b.bar;
        __builtin_amdgcn_s_waitcnt(0);
        unsigned nloc = b.st[0], nx = b.st[1];
        if (nloc == 0u) { xcd_barrier_complete(bar, b.x, nloc, nx); b.st[0] = nloc; b.st[1] = nx; }
        const unsigned old = xb_add(&bar[XB_XSUB(b.x)], 1u);
        const unsigned gen = old / nloc;
        if (old + 1u == (gen + 1u) * nloc) {
            __builtin_amdgcn_fence(__ATOMIC_RELEASE, "agent");
            asm volatile("s_waitcnt vmcnt(0)" ::: "memory");
            const unsigned og = xb_add(&bar[XB_TOP], 1u);
            const unsigned tg = og / nx;
            if (og + 1u == (tg + 1u) * nx) xb_add(&bar[XB_TOPGEN], 1u);
            else XB_SPIN(xb_ld(&bar[XB_TOPGEN]) == tg, bar);
            __builtin_amdgcn_fence(__ATOMIC_ACQUIRE, "agent");
            xb_add(&bar[XB_XGEN(b.x)], 1u);
            asm volatile("s_waitcnt vmcnt(0)" ::: "memory");
        } else {
            XB_SPIN(xb_ld(&bar[XB_XGEN(b.x)]) == gen, bar);
            __builtin_amdgcn_fence(__ATOMIC_ACQUIRE, "agent");
            asm volatile("s_waitcnt vmcnt(0)" ::: "memory");
        }
    }
    __syncthreads();
}

struct Frame {
    LAS unsigned char* lds;
    volatile LAS unsigned* MISC;
    gu32* ctl;
    int tid, lane, wave, vcu, G;
    unsigned char* ws;
};
__device__ __forceinline__ int cond_of_row(int r) { return r < SEQ ? 0 : (r < ML ? 1 : 2); }
__device__ __forceinline__ void unpack8(const v4u r, float (&x)[8]) { x[0] = bflo(r.x); x[1] = bfhi(r.x); x[2] = bflo(r.y); x[3] = bfhi(r.y); x[4] = bflo(r.z); x[5] = bfhi(r.z); x[6] = bflo(r.w); x[7] = bfhi(r.w); }

__device__ __forceinline__ int up_perm_row(int n0) {
    return n0 < FFN ? 256 * (n0 / 128) + (n0 % 128) : 256 * ((n0 - FFN) / 128) + 128 + ((n0 - FFN) % 128);
}
__device__ __forceinline__ void p0_transpose_item(const float* W, int K, int N, bf16* WT, bool perm, LAS unsigned* scr, int item, int lane, int ldw = 0) {
    if (ldw == 0) ldw = K;
    const int nblk = N / 64, kb = item / nblk, nb = item % nblk, k0 = 64 * kb, n0 = 64 * nb;
    const int r0 = perm ? up_perm_row(n0) : n0;
    const int rsub = lane >> 4, c4 = lane & 15;
    f32x4 va[8], vb[8];
    const float* src = W + (size_t)(k0 + 2 * rsub) * N + n0 + 4 * c4;
#pragma unroll
    for (int t = 0; t < 8; ++t) { va[t] = __builtin_nontemporal_load((const f32x4*)(src + (size_t)(8 * t) * N)); vb[t] = __builtin_nontemporal_load((const f32x4*)(src + (size_t)(8 * t + 1) * N)); }
#pragma unroll
    for (int t = 0; t < 8; ++t) { const int p = 4 * t + rsub;
#pragma unroll
        for (int e = 0; e < 4; ++e) scr[(4 * c4 + e) * 33 + p] = pk2(va[t][e], vb[t][e]); }
    LDS_WAIT(); asm volatile("" ::: "memory");
    const int r = lane >> 3, c = lane & 7;
#pragma unroll
    for (int j = 0; j < 8; ++j) { const int n = 8 * j + r; const LAS unsigned* sp = scr + n * 33 + 4 * c;
        v4u o; o.x = sp[0]; o.y = sp[1]; o.z = sp[2]; o.w = sp[3];
        *(GAS v4u*)(WT + (size_t)(r0 + n) * ldw + k0 + 8 * c) = o; }
    LDS_WAIT(); asm volatile("" ::: "memory");
}
__device__ __forceinline__ void p0_prologue(Frame& F, const float* c_in, const float* cctx_in, const float* w_ada, const float* b_ada,
                                            const float* na_qkv, const float* na_wo, const float* gm_win, const float* gm_ws, const float* gm_wout,
                                            const float* sc_win, const float* sc_wout, const float* f_up, const float* f_dn) {
    unsigned char* ws = F.ws;
    LAS float* sc = (LAS float*)(F.lds);
    LAS float* red = (LAS float*)(F.lds + 24576);
    __syncthreads();
    for (int i = F.tid; i < 3 * DM; i += NWAVES * 64) { const int ci = i / DM, k = i % DM; const float v = ci < 2 ? c_in[ci * DM + k] : cctx_in[k]; sc[i] = pg8::silu_f(v); }
    __syncthreads();
    float* mod = (float*)(ws + WS_MOD);
    for (int it = F.vcu; it < DEPTH * 192; it += F.G) {
        const int L = it / 192, nb = it % 192, cq = F.tid & 15, ks = F.tid >> 4;
        f32x4 a0 = {0.f, 0.f, 0.f, 0.f}, a1 = a0, a2 = a0;
        const float* wp = w_ada + ((size_t)L * DM + ks * 64) * NMOD + nb * 64 + cq * 4;
#pragma unroll 8
        for (int kk = 0; kk < 64; ++kk) { const f32x4 w = *(const GAS f32x4*)(wp + (size_t)kk * NMOD); const int k = ks * 64 + kk;
            a0 += w * sc[k]; a1 += w * sc[DM + k]; a2 += w * sc[2 * DM + k]; }
        *(LAS f32x4*)(red + (ks * 3 + 0) * 64 + cq * 4) = a0; *(LAS f32x4*)(red + (ks * 3 + 1) * 64 + cq * 4) = a1; *(LAS f32x4*)(red + (ks * 3 + 2) * 64 + cq * 4) = a2;
        __syncthreads();
        if (F.tid < 192) { const int ci = F.tid / 64, col = F.tid % 64; float s = 0.f;
#pragma unroll 8
            for (int q = 0; q < 32; ++q) s += red[(q * 3 + ci) * 64 + col];
            mod[((size_t)L * 3 + ci) * NMOD + nb * 64 + col] = s + b_ada[(size_t)L * NMOD + nb * 64 + col]; }
        __syncthreads();
    }
    { bf16* d = (bf16*)(ws + WS_WGS); const int gt = F.vcu * NWAVES * 64 + F.tid, NT = F.G * NWAVES * 64;
      for (int o = gt; o < GMG * GMC * GMC / 8; o += NT) { const int i = o & 31, h = (o >> 5) & 1, sx = (o >> 6) & 7, ib = (o >> 9) & 3, g = o >> 11;
          const float* src = gm_ws + ((size_t)g * GMC + 32 * ib + i) * GMC + 16 * sx + 8 * h; const f32x4 a = *(const f32x4*)src, b = *(const f32x4*)(src + 4);
          v4u w; w.x = pk2(a.x, a.y); w.y = pk2(a.z, a.w); w.z = pk2(b.x, b.y); w.w = pk2(b.z, b.w); *(GAS v4u*)(d + (size_t)o * 8) = w; } }
}

template <bool X32, bool FX32, bool RES32_>
__device__ __forceinline__ void norm_mod_phase(Frame& F, const void* xlat, const void* xctx, const float* gain, const float* shift0, const float* scale0, bf16* H, int nrows,
                                               const float* slab, int nsl, const void* fx_in, const float* fx_gate, void* fx_out) {
    const int gw = F.vcu * NWAVES + F.wave, NGW = F.G * NWAVES;
    for (int row = gw; row < nrows; row += NGW) {
        const int ci = cond_of_row(row);
        const float* shp = shift0 + (size_t)ci * NMOD; const float* scp = scale0 + (size_t)ci * NMOD;
        if (slab != nullptr && row >= ML) {
            f32x4 v[8]; float s = 0.f;
            const f32x4* g4 = (const f32x4*)(fx_gate + 2 * (size_t)NMOD) + F.lane;
#pragma unroll
            for (int j = 0; j < 8; ++j) { f32x4 a = {0.f, 0.f, 0.f, 0.f};
                for (int q = 0; q < nsl; ++q) a += *((const GAS f32x4*)(slab + ((size_t)q * MC + (row - ML)) * DM) + F.lane + 64 * j);
                f32x4 xin;
                if (FX32) xin = *((const GAS f32x4*)((const float*)fx_in + (size_t)(row - ML) * DM) + F.lane + 64 * j);
                else { const v2u r = *((const GAS v2u*)((const bf16*)fx_in + (size_t)(row - ML) * DM) + F.lane + 64 * j); xin = (f32x4){bflo(r.x), bfhi(r.x), bflo(r.y), bfhi(r.y)}; }
                v[j] = xin + g4[64 * j] * a;
                if (RES32_) *((GAS f32x4*)((float*)fx_out + (size_t)(row - ML) * DM) + F.lane + 64 * j) = v[j];
                else { v2u w; w.x = pk2(v[j].x, v[j].y); w.y = pk2(v[j].z, v[j].w); *((GAS v2u*)((bf16*)fx_out + (size_t)(row - ML) * DM) + F.lane + 64 * j) = w;
                       v[j] = (f32x4){bflo(w.x), bfhi(w.x), bflo(w.y), bfhi(w.y)}; }
                s += (v[j].x * v[j].x + v[j].y * v[j].y) + (v[j].z * v[j].z + v[j].w * v[j].w); }
            const float rstd = 1.0f / sqrtf(wave_sum(s) * (1.0f / DM) + EPS);
            const f32x4* gg = (const f32x4*)gain + F.lane; const f32x4* sh4 = (const f32x4*)shp + F.lane; const f32x4* sc4 = (const f32x4*)scp + F.lane;
            GAS v2u* o8 = (GAS v2u*)(H + (size_t)row * DM) + F.lane;
#pragma unroll
            for (int j = 0; j < 8; ++j) { const f32x4 y = v[j] * rstd * gg[64 * j] * (sc4[64 * j] + 1.0f) + sh4[64 * j]; v2u w; w.x = pk2(y.x, y.y); w.y = pk2(y.z, y.w); o8[64 * j] = w; }
        } else if (X32) {
            const float* src = row < ML ? (const float*)xlat + (size_t)row * DM : (const float*)xctx + (size_t)(row - ML) * DM;
            const GAS f32x4* xr = (const GAS f32x4*)src + F.lane;
            f32x4 v[8]; float s = 0.f;
#pragma unroll
            for (int j = 0; j < 8; ++j) { v[j] = xr[64 * j]; s += (v[j].x * v[j].x + v[j].y * v[j].y) + (v[j].z * v[j].z + v[j].w * v[j].w); }
            const float rstd = 1.0f / sqrtf(wave_sum(s) * (1.0f / DM) + EPS);
            const f32x4* gg = (const f32x4*)gain + F.lane; const f32x4* sh4 = (const f32x4*)shp + F.lane; const f32x4* sc4 = (const f32x4*)scp + F.lane;
            GAS v2u* o8 = (GAS v2u*)(H + (size_t)row * DM) + F.lane;
#pragma unroll
            for (int j = 0; j < 8; ++j) { const f32x4 y = v[j] * rstd * gg[64 * j] * (sc4[64 * j] + 1.0f) + sh4[64 * j]; v2u w; w.x = pk2(y.x, y.y); w.y = pk2(y.z, y.w); o8[64 * j] = w; }
        } else {
            const bf16* src = row < ML ? (const bf16*)xlat + (size_t)row * DM : (const bf16*)xctx + (size_t)(row - ML) * DM;
            const GAS v4u* xr = (const GAS v4u*)src + F.lane;
            v4u raw[4]; float s = 0.f;
#pragma unroll
            for (int j = 0; j < 4; ++j) raw[j] = xr[64 * j];
#pragma unroll
            for (int j = 0; j < 4; ++j) { float x[8]; unpack8(raw[j], x);
#pragma unroll
                for (int e = 0; e < 8; ++e) s += x[e] * x[e]; }
            const float rstd = 1.0f / sqrtf(wave_sum(s) * (1.0f / DM) + EPS);
            GAS v4u* o16 = (GAS v4u*)(H + (size_t)row * DM) + F.lane;
#pragma unroll
            for (int j = 0; j < 4; ++j) { float x[8]; unpack8(raw[j], x); const int c = 8 * F.lane + 512 * j;
                const f32x4 g0 = *(const f32x4*)(gain + c), g1 = *(const f32x4*)(gain + c + 4), s0 = *(const f32x4*)(scp + c), s1 = *(const f32x4*)(scp + c + 4), h0 = *(const f32x4*)(shp + c), h1 = *(const f32x4*)(shp + c + 4);
                v4u w; w.x = pk2(x[0] * rstd * g0.x * (s0.x + 1.0f) + h0.x, x[1] * rstd * g0.y * (s0.y + 1.0f) + h0.y); w.y = pk2(x[2] * rstd * g0.z * (s0.z + 1.0f) + h0.z, x[3] * rstd * g0.w * (s0.w + 1.0f) + h0.w);
                w.z = pk2(x[4] * rstd * g1.x * (s1.x + 1.0f) + h1.x, x[5] * rstd * g1.y * (s1.y + 1.0f) + h1.y); w.w = pk2(x[6] * rstd * g1.z * (s1.z + 1.0f) + h1.z, x[7] * rstd * g1.w * (s1.w + 1.0f) + h1.w);
                o16[64 * j] = w; }
        }
    }
}

struct AttnTileDesc { unsigned koff, voff; int boff; bool lat, row_ok; };
#define ALD16(dst, voff, sbase, imm) asm volatile("global_load_dwordx4 %0, %1, %2 offset:" #imm : "=v"(dst) : "v"(voff), "s"(sbase))
#define ALD4(dst, voff, sbase) asm volatile("global_load_dword %0, %1, %2" : "=v"(dst) : "v"(voff), "s"(sbase))
struct AttnBases { const char* kpl[8]; const char* vt; const char* rpb; };
__device__ __forceinline__ void attn_issue_k(const AttnBases& B, unsigned koff, bf16x8 (&kf)[8]) {
    ALD16(kf[0], koff, B.kpl[0], 0); ALD16(kf[1], koff, B.kpl[1], 0); ALD16(kf[2], koff, B.kpl[2], 0); ALD16(kf[3], koff, B.kpl[3], 0);
    ALD16(kf[4], koff, B.kpl[4], 0); ALD16(kf[5], koff, B.kpl[5], 0); ALD16(kf[6], koff, B.kpl[6], 0); ALD16(kf[7], koff, B.kpl[7], 0);
}
__device__ __forceinline__ void attn_issue_v(const AttnBases& B, unsigned voff, bf16x8 (&vf)[4][2]) {
    const unsigned v1 = voff + 4096u;
    ALD16(vf[0][0], voff, B.vt, 0); ALD16(vf[1][0], voff, B.vt, 512); ALD16(vf[2][0], voff, B.vt, 1024); ALD16(vf[3][0], voff, B.vt, 1536);
    ALD16(vf[0][1], v1, B.vt, 0); ALD16(vf[1][1], v1, B.vt, 512); ALD16(vf[2][1], v1, B.vt, 1024); ALD16(vf[3][1], v1, B.vt, 1536);
}
#define AWAIT8(n, a) asm volatile("s_waitcnt vmcnt(" #n ")" : "+v"(a[0]), "+v"(a[1]), "+v"(a[2]), "+v"(a[3]), "+v"(a[4]), "+v"(a[5]), "+v"(a[6]), "+v"(a[7]))
#define AWAITV(n, a) asm volatile("s_waitcnt vmcnt(" #n ")" : "+v"(a[0][0]), "+v"(a[1][0]), "+v"(a[2][0]), "+v"(a[3][0]), "+v"(a[0][1]), "+v"(a[1][1]), "+v"(a[2][1]), "+v"(a[3][1]))
__device__ __forceinline__ void attn_tile(const AttnBases& B, bf16x8 (&kf)[8], bf16x8 (&vf)[4][2], const AttnTileDesc& d, const AttnTileDesc& dn, const LAS float* btab,
                                          const bf16x8 (&qf)[8], f32x16 (&ot)[4], float& m, float& lsum, const unsigned colmask, const float c1) {
    float bvv[16];
#pragma unroll
    for (int i = 0; i < 16; ++i) bvv[i] = btab[d.boff + 16 * (i >> 3) + (i & 7)];
    f32x16 S;
#pragma unroll
    for (int i = 0; i < 16; ++i) S[i] = 0.f;
    AWAIT8(8, kf);
#pragma unroll
    for (int s = 0; s < 8; ++s) S = MFMA32(kf[s], qf[s], S);
    __builtin_amdgcn_sched_barrier(0);
    attn_issue_k(B, dn.koff, kf);
    __builtin_amdgcn_sched_barrier(0);
    float t[16];
    { const unsigned msk = d.lat ? (d.row_ok ? colmask : 0u) : 0xffffu; const float bsc = d.lat ? LOG2E : 0.f;
#pragma unroll
      for (int i = 0; i < 16; ++i) t[i] = ((msk >> i) & 1u) ? S[i] * c1 + bvv[i] * bsc : -__builtin_inff(); }
    float mx = t[0];
#pragma unroll
    for (int i = 1; i < 16; ++i) mx = __builtin_fmaxf(mx, t[i]);
    mx = swap32_max(mx);
    if (__any(mx > m + 8.0f)) {
        const float mn = __builtin_fmaxf(m, mx);
        const float alpha = __builtin_amdgcn_exp2f(m - mn);
        m = mn; lsum *= alpha;
#pragma unroll
        for (int nb = 0; nb < 4; ++nb)
#pragma unroll
            for (int i = 0; i < 16; ++i) ot[nb][i] *= alpha;
    }
    float ps = 0.f; float p[16];
#pragma unroll
    for (int i = 0; i < 16; ++i) { p[i] = __builtin_amdgcn_exp2f(t[i] - m); ps += p[i]; }
    lsum += ps;
    v4u w0, w1; w0.x = pk2(p[0], p[1]); w0.y = pk2(p[2], p[3]); w0.z = pk2(p[4], p[5]); w0.w = pk2(p[6], p[7]);
    w1.x = pk2(p[8], p[9]); w1.y = pk2(p[10], p[11]); w1.z = pk2(p[12], p[13]); w1.w = pk2(p[14], p[15]);
    const bf16x8 pf0 = __builtin_bit_cast(bf16x8, w0), pf1 = __builtin_bit_cast(bf16x8, w1);
    AWAITV(8, vf);
#pragma unroll
    for (int nb = 0; nb < 4; ++nb) { ot[nb] = MFMA32(vf[nb][0], pf0, ot[nb]); ot[nb] = MFMA32(vf[nb][1], pf1, ot[nb]); }
    __builtin_amdgcn_sched_barrier(0);
    attn_issue_v(B, dn.voff, vf);
    __builtin_amdgcn_sched_barrier(0);
}
__device__ __forceinline__ void attn_phase(Frame& F, const bf16* QK, const bf16* VT, bf16* O, const float* rpb, const bool ctx_out) {
    const int lane = F.lane, ql = lane & 31, h = lane >> 5;
    const int gw = F.vcu * NWAVES + F.wave, NGW = F.G * NWAVES;
    const int NU = 8192 + (ctx_out ? 256 : 0);
    const float c1 = 0.08838834764831845f * LOG2E;
    for (int u = gw; u < NU; u += NGW) {
        int b, head, qrow, qr = 0, qc = 0, cw0 = 0, rs0 = 0, rs1e = 0;
        if (u < 8192) { const int g = u & 3, rp = (u >> 2) & 63; head = (u >> 8) & 15; b = u >> 12;
            qr = 2 * rp + (ql >> 4); qc = 16 * g + (ql & 15); qrow = b * SEQ + qr * GRIDW + qc; cw0 = g == 0 ? 0 : (g == 1 ? 8 : (g == 2 ? 24 : 32));
            int a0 = 2 * rp - 4; a0 = a0 < 0 ? 0 : (a0 > GROWS - 8 ? GROWS - 8 : a0); int a1 = 2 * rp - 3; a1 = a1 < 0 ? 0 : (a1 > GROWS - 8 ? GROWS - 8 : a1); rs0 = a0; rs1e = a1 + 8; }
        else { const int u2 = u - 8192, qt = u2 & 7; head = (u2 >> 3) & 15; b = u2 >> 7; qrow = ML + CTXL * b + 32 * qt + ql; }
        int rs = qr - 4; rs = rs < 0 ? 0 : (rs > GROWS - 8 ? GROWS - 8 : rs);
        int cs = qc - 8; cs = cs < 0 ? 0 : (cs > GRIDW - 16 ? GRIDW - 16 : cs);
        unsigned colmask = 0u;
#pragma unroll
        for (int i = 0; i < 16; ++i) { const int kc = cw0 + 8 * h + 16 * (i >> 3) + (i & 7); colmask |= (kc >= cs && kc < cs + 16) ? (1u << i) : 0u; }
        const int dcb = cw0 + 8 * h - qc + 15;
        const float* rpb_h = rpb + (size_t)head * 15 * 31;
        bf16x8 qf[8];
        { const bf16* qp = QK + ((size_t)head * 8 * MT + qrow) * 16 + 8 * h;
#pragma unroll
          for (int s = 0; s < 8; ++s) qf[s] = *(const GAS bf16x8*)(qp + (size_t)s * MT * 16); }
        f32x16 ot[4];
#pragma unroll
        for (int nb = 0; nb < 4; ++nb)
#pragma unroll
            for (int i = 0; i < 16; ++i) ot[nb][i] = 0.f;
        float m = -__builtin_inff(), lsum = 0.f;
        const int qlp = (ql & ~12) | ((ql & 4) << 1) | ((ql & 8) >> 1);
        const unsigned kbase = (unsigned)((((size_t)(16 + head) * 8 * MT + qlp) * 16 + 8 * h) * 2);
        const unsigned vbase = (unsigned)((((size_t)head * (MT / 8) + h) * 128 + ql) * 16);
        const int crow0 = ML + CTXL * b, nt = 8 + (rs1e - rs0);
#define ATT_DESC(t, d) do { const int t__ = (t); const bool ctx__ = t__ < 8; const int kr__ = rs0 + t__ - 8; \
            const int k0__ = ctx__ ? crow0 + 32 * t__ : b * SEQ + kr__ * GRIDW + cw0;                                      \
            d.koff = kbase + (unsigned)k0__ * 32u; d.voff = vbase + (unsigned)(k0__ >> 3) * 2048u; d.lat = !ctx__; \
            d.row_ok = !ctx__ && kr__ >= rs && kr__ < rs + 8; d.boff = d.row_ok ? (kr__ - qr + 7) * 31 + dcb : 15; } while (0)
        AttnBases B;
#pragma unroll
        for (int sx = 0; sx < 8; ++sx) B.kpl[sx] = (const char*)QK + (size_t)sx * (MT * 32);
        B.vt = (const char*)VT; B.rpb = (const char*)rpb_h;
        LAS float* btab = (LAS float*)(F.lds + F.wave * 2304) + 16;
#pragma unroll
        for (int q = 0; q < 8; ++q) { const int idx = lane + 64 * q; if (idx < 465) btab[idx] = rpb_h[idx]; }
        bf16x8 kf[8], vf[4][2]; AttnTileDesc dA, dB;
        asm volatile("s_waitcnt vmcnt(0) lgkmcnt(0)" : "+v"(qf[0]), "+v"(qf[1]), "+v"(qf[2]), "+v"(qf[3]), "+v"(qf[4]), "+v"(qf[5]), "+v"(qf[6]), "+v"(qf[7]) :: "memory");
        ATT_DESC(0, dA); attn_issue_k(B, dA.koff, kf); attn_issue_v(B, dA.voff, vf);
        for (int t = 0; t < nt; ++t) {
            ATT_DESC(t + 1 < nt ? t + 1 : t, dB);
            attn_tile(B, kf, vf, dA, dB, btab, qf, ot, m, lsum, colmask, c1);
            dA = dB;
        }
        AWAIT8(0, kf); AWAITV(0, vf);
#undef ATT_DESC
        const float inv = 1.0f / swap32_sum(lsum);
        bf16* op = O + (size_t)qrow * DM + head * HD + 4 * h;
#pragma unroll
        for (int nb = 0; nb < 4; ++nb)
#pragma unroll
            for (int g4 = 0; g4 < 4; ++g4) { v2u w; w.x = pk2(ot[nb][4 * g4] * inv, ot[nb][4 * g4 + 1] * inv); w.y = pk2(ot[nb][4 * g4 + 2] * inv, ot[nb][4 * g4 + 3] * inv);
                *(GAS v2u*)(op + 32 * nb + 8 * g4) = w; }
    }
}

__device__ __forceinline__ void gm_spatial_phase(Frame& F, const bf16* U, const bf16* VT, bf16* G, const bf16* WS, const float* PST, const float* vg, const float* bs) {
    const int lane = F.lane, ql = lane & 31, h = lane >> 5, w = F.wave;
    LAS float* rsd = (LAS float*)(F.lds);
    constexpr int NUNITS = (MT / GMC) * GMG;
    const int u0 = (int)((long)F.vcu * NUNITS / F.G), u1 = (int)((long)(F.vcu + 1) * NUNITS / F.G);
    int cprev = -1;
    for (int u = u0; u < u1; ++u) {
        const int c = u >> 4, g = u & 15;
        if (c != cprev) { cprev = c;
            __syncthreads();
            if (lane < 16) { const int tok = GMC * c + 16 * w + lane; float s = 0.f;
#pragma unroll 8
                for (int p = 0; p < 32; ++p) s += PST[(size_t)p * MT + tok];
                rsd[16 * w + lane] = 1.0f / sqrtf(s * (1.0f / GMW) + EPS); }
            __syncthreads();
        }
        bf16x8 af[8];
        { const bf16* ap = VT + ((size_t)(8 * g + w) * (MT / 16) + 8 * c) * 512 + ql * 16 + 8 * h;
#pragma unroll
          for (int s = 0; s < 8; ++s) { const v4u raw = *(const GAS v4u*)(ap + 512 * s); const f32x4 r0 = *(const LAS f32x4*)(rsd + 16 * s + 8 * h), r1 = *(const LAS f32x4*)(rsd + 16 * s + 8 * h + 4);
              v4u o; o.x = pk2(bflo(raw.x) * r0.x, bfhi(raw.x) * r0.y); o.y = pk2(bflo(raw.y) * r0.z, bfhi(raw.y) * r0.w);
              o.z = pk2(bflo(raw.z) * r1.x, bfhi(raw.z) * r1.y); o.w = pk2(bflo(raw.w) * r1.z, bfhi(raw.w) * r1.w);
              af[s] = __builtin_bit_cast(bf16x8, o); } }
        f32x16 acc[4];
#pragma unroll
        for (int ib = 0; ib < 4; ++ib)
#pragma unroll
            for (int i = 0; i < 16; ++i) acc[ib][i] = 0.f;
#pragma unroll
        for (int ib = 0; ib < 4; ++ib) { const bf16* bp = WS + ((size_t)(g * 4 + ib) * 8) * 512 + lane * 8;
#pragma unroll
            for (int s = 0; s < 8; ++s) { const bf16x8 bfr = *(const GAS bf16x8*)(bp + 512 * s); acc[ib] = MFMA32(af[s], bfr, acc[ib]); } }
#pragma unroll
        for (int ib = 0; ib < 4; ++ib) { const int i = 32 * ib + ql; const size_t row = (size_t)GMC * c + i; const float bsv = bs[g * GMC + i];
#pragma unroll
            for (int g4 = 0; g4 < 4; ++g4) { const int col = GMGD * g + 32 * w + 8 * g4 + 4 * h; const f32x4 v4 = *(const f32x4*)(vg + col);
                const v2u uu = *(const GAS v2u*)(U + row * GMW + col);
                const float o0 = bflo(uu.x) * (v4.x * acc[ib][4 * g4] + bsv), o1 = bfhi(uu.x) * (v4.y * acc[ib][4 * g4 + 1] + bsv);
                const float o2 = bflo(uu.y) * (v4.z * acc[ib][4 * g4 + 2] + bsv), o3 = bfhi(uu.y) * (v4.w * acc[ib][4 * g4 + 3] + bsv);
                v2u wv; wv.x = pk2(o0, o1); wv.y = pk2(o2, o3); *(GAS v2u*)(G + row * GMW + col) = wv; } }
        LDS_WAIT(); asm volatile("" ::: "memory");
    }
}

__device__ __forceinline__ bool has_prev(int r) { return r < ML ? (r & (SEQ - 1)) != 0 : ((r - ML) & (CTXL - 1)) != 0; }
__device__ __forceinline__ bool has_next(int r) { return r < ML ? (r & (SEQ - 1)) != SEQ - 1 : ((r - ML) & (CTXL - 1)) != CTXL - 1; }

__device__ __forceinline__ void sc_conv_phase(Frame& F, const bf16* BCX, bf16* T, const float* cw  ) {
    const int gt = F.vcu * NWAVES * 64 + F.tid, NT = F.G * NWAVES * 64;
    constexpr int RB = 16, NOC = DM / 8;
    for (int it = gt; it < (MT / RB) * NOC; it += NT) {
        const int rb = it / NOC, oc = it % NOC, c0 = 8 * oc, r0 = rb * RB;
        float w0[8], w1[8], w2[8];
#pragma unroll
        for (int e = 0; e < 8; ++e) { w0[e] = cw[c0 + e]; w1[e] = cw[DM + c0 + e]; w2[e] = cw[2 * DM + c0 + e]; }
        float pv[8], cv[8], nv[8];
        auto ld = [&](int r, float (&o)[8]) { float a[8], b[8]; unpack8(*(const GAS v4u*)(BCX + (size_t)r * 6144 + DM + c0), a); unpack8(*(const GAS v4u*)(BCX + (size_t)r * 6144 + 2 * DM + c0), b);
#pragma unroll
            for (int e = 0; e < 8; ++e) o[e] = a[e] * b[e]; };
        if (has_prev(r0)) ld(r0 - 1, pv); else {
#pragma unroll
            for (int e = 0; e < 8; ++e) pv[e] = 0.f; }
        ld(r0, cv);
        for (int i = 0; i < RB; ++i) { const int r = r0 + i;
            if (has_next(r)) ld(r + 1, nv); else {
#pragma unroll
                for (int e = 0; e < 8; ++e) nv[e] = 0.f; }
            float bg[8]; unpack8(*(const GAS v4u*)(BCX + (size_t)r * 6144 + c0), bg);
            float y[8];
#pragma unroll
            for (int e = 0; e < 8; ++e) y[e] = bg[e] * (pv[e] * w0[e] + cv[e] * w1[e] + nv[e] * w2[e]);
            v4u o; o.x = pk2(y[0], y[1]); o.y = pk2(y[2], y[3]); o.z = pk2(y[4], y[5]); o.w = pk2(y[6], y[7]);
            *(GAS v4u*)(T + (size_t)r * DM + c0) = o;
#pragma unroll
            for (int e = 0; e < 8; ++e) { pv[e] = cv[e]; cv[e] = nv[e]; } }
    }
}

__device__ __forceinline__ void ffn_act_phase(Frame& F, const bf16* Z, bf16* A, const float* cw  , const float* cb  , int nrows) {
    const int gt = F.vcu * NWAVES * 64 + F.tid, NT = F.G * NWAVES * 64;
    constexpr int RB = 16, NOC = FFN / 8;
    for (int it = gt; it < (nrows / RB) * NOC; it += NT) {
        const int rb = it / NOC, oc = it % NOC, f0 = 8 * oc, r0 = rb * RB;
        const int zg = 256 * (f0 >> 7) + (f0 & 127), zu = zg + 128;
        float wg0[8], wg1[8], wg2[8], wu0[8], wu1[8], wu2[8], bg[8], bu[8];
#pragma unroll
        for (int e = 0; e < 8; ++e) { wg0[e] = cw[f0 + e]; wg1[e] = cw[FFN2 + f0 + e]; wg2[e] = cw[2 * FFN2 + f0 + e]; bg[e] = cb[f0 + e];
            wu0[e] = cw[FFN + f0 + e]; wu1[e] = cw[FFN2 + FFN + f0 + e]; wu2[e] = cw[2 * FFN2 + FFN + f0 + e]; bu[e] = cb[FFN + f0 + e]; }
        float pg[8], cg[8], ng[8], pu[8], cu[8], nu[8];
        auto ld = [&](int r, float (&og)[8], float (&ou)[8]) { unpack8(*(const GAS v4u*)(Z + (size_t)r * FFN2 + zg), og); unpack8(*(const GAS v4u*)(Z + (size_t)r * FFN2 + zu), ou); };
        if (has_prev(r0)) ld(r0 - 1, pg, pu); else {
#pragma unroll
            for (int e = 0; e < 8; ++e) { pg[e] = 0.f; pu[e] = 0.f; } }
        ld(r0, cg, cu);
        for (int i = 0; i < RB; ++i) { const int r = r0 + i;
            if (has_next(r)) ld(r + 1, ng, nu); else {
#pragma unroll
                for (int e = 0; e < 8; ++e) { ng[e] = 0.f; nu[e] = 0.f; } }
            float y[8];
#pragma unroll
            for (int e = 0; e < 8; ++e) { const float yg = pg[e] * wg0[e] + cg[e] * wg1[e] + ng[e] * wg2[e] + bg[e]; const float yu = pu[e] * wu0[e] + cu[e] * wu1[e] + nu[e] * wu2[e] + bu[e]; y[e] = pg8::silu_f(yg) * yu; }
            v4u o; o.x = pk2(y[0], y[1]); o.y = pk2(y[2], y[3]); o.z = pk2(y[4], y[5]); o.w = pk2(y[6], y[7]);
            *(GAS v4u*)(A + (size_t)r * FFN + f0) = o;
#pragma unroll
            for (int e = 0; e < 8; ++e) { pg[e] = cg[e]; cg[e] = ng[e]; pu[e] = cu[e]; cu[e] = nu[e]; } }
    }
}

constexpr int PH_PER_LAYER = MK_FFN_HALVES ? 10 : 8;
constexpr bool RES32 = !MK_RES_BF16;
constexpr size_t CTXOFF = (size_t)ML * DM * (RES32 ? 4 : 2);
constexpr int NPHASES = 1 + DEPTH * PH_PER_LAYER;
struct Args { const float* in[N_IN]; float* out; unsigned char* ws; int ph_lo, ph_hi; };

__device__ __forceinline__ unsigned long long tab_ld(int i) {
    extern __shared__ __attribute__((aligned(16))) unsigned char lds_[];
    volatile LAS unsigned* t = (volatile LAS unsigned*)((LAS unsigned char*)lds_ + LDSCTL_OFF) + 2 * i;
    const unsigned lo = __builtin_amdgcn_readfirstlane(t[0]), hi = __builtin_amdgcn_readfirstlane(t[1]);
    return ((unsigned long long)hi << 32) | lo;
}
#define INP(i) ((const float*)(const GAS float*)tab_ld(i))
#define OUTP() ((float*)(GAS float*)tab_ld(N_IN))
#define WSP() ((unsigned char*)(GAS unsigned char*)tab_ld(N_IN + 1))
#define FRAME() Frame F; { extern __shared__ __attribute__((aligned(16))) unsigned char lds_[]; int t_ = wv_ * 64 + (int)__builtin_amdgcn_mbcnt_hi(~0u, __builtin_amdgcn_mbcnt_lo(~0u, 0u)); asm volatile("" : "+v"(t_)); int bx_ = blockIdx.x; asm volatile("" : "+s"(bx_)); \
    F.lds = (LAS unsigned char*)lds_; F.MISC = (volatile LAS unsigned*)(F.lds + MISC_OFF); F.tid = t_; F.lane = t_ & 63; F.wave = __builtin_amdgcn_readfirstlane(t_ >> 6); \
    F.G = gridDim.x; F.vcu = (F.G % 8 == 0) ? (bx_ % 8) * (F.G / 8) + bx_ / 8 : bx_; F.ws = WSP(); F.ctl = (gu32*)(F.ws + WS_CTL); }

template <int Lw> __device__ __forceinline__ void convert_layer(Frame& F, int lo, int hi, int rank, int nranks) {
    unsigned char* ws = F.ws;
    LAS unsigned* scr = (LAS unsigned*)(F.lds + RING_OFF + F.wave * 16384);
    constexpr int I_QKV = 32 * 96, I_O = 32 * 32, I_GIN = 32 * 128, I_GOUT = 64 * 32, I_CIN = 32 * 96, I_COUT = 32 * 32, I_UP = 32 * 172, I_DN = 86 * 32;
    constexpr int mxw = Lw % 3, jxw = Lw / 3;
    constexpr int nA = mxw == 0 ? I_QKV : (mxw == 1 ? I_GIN : I_CIN), nB = mxw == 0 ? I_O : (mxw == 1 ? I_GOUT : I_COUT), T = nA + nB + I_UP + I_DN;
    const int it0 = (int)((long)T * lo / 256), it1 = (int)((long)T * hi / 256);
    for (int it = it0 + rank; it < it1; it += nranks) {
        int r = it;
        if (r < nA) { if (mxw == 0) p0_transpose_item(INP(I_NAQKV) + (size_t)jxw * DM * 6144, DM, 6144, (bf16*)(ws + WS_WQKV) + (size_t)jxw * 6144 * DM, false, scr, r, F.lane);
                      else if (mxw == 1) p0_transpose_item(INP(I_GMWIN), DM, 8192, (bf16*)(ws + WS_WGIN), false, scr, r, F.lane);
                      else p0_transpose_item(INP(I_SCWIN), DM, 6144, (bf16*)(ws + WS_WCIN), false, scr, r, F.lane);
                      continue; } r -= nA;
        if (r < nB) { if (mxw == 0) p0_transpose_item(INP(I_NAWO) + (size_t)jxw * DM * DM, DM, DM, (bf16*)(ws + WS_WO) + (size_t)jxw * DM * DM, false, scr, r, F.lane);
                      else if (mxw == 1) p0_transpose_item(INP(I_GMWOUT), GMW, DM, (bf16*)(ws + WS_WGOUT), false, scr, r, F.lane);
                      else p0_transpose_item(INP(I_SCWOUT), DM, DM, (bf16*)(ws + WS_WCOUT), false, scr, r, F.lane);
                      continue; } r -= nB;
        if (r < I_UP) { p0_transpose_item(INP(I_FUP) + (size_t)Lw * DM * FFN2, DM, FFN2, (bf16*)(ws + WS_WUP) + (size_t)Lw * FFN2 * DM, true, scr, r, F.lane); continue; } r -= I_UP;
        p0_transpose_item(INP(I_FDN) + (size_t)Lw * FFN * DM, FFN, DM, (bf16*)(ws + WS_WDN) + (size_t)Lw * DM * FFN_LD, false, scr, r, F.lane, FFN_LD);
    }
}
__device__ __forceinline__ void idle_rank(int nunits, int G, int c, int& rank, int& nidle) {
    const int rounds = (nunits + G - 1) / G, rem = nunits - (rounds - 1) * G;
    if (rem == G) { rank = c; nidle = G; } else { rank = c >= rem ? c - rem : -1; nidle = G - rem; }
}

__global__ void __launch_bounds__(NWAVES * 64, 2) mk_fwd(Args args) {
    extern __shared__ __attribute__((aligned(16))) unsigned char lds[];
    for (int u = threadIdx.x; u < (LDS_BYTES - LDSCTL_OFF) / 4; u += NWAVES * 64) ((LAS unsigned*)((LAS unsigned char*)lds + LDSCTL_OFF))[u] = 0u;
    __syncthreads();
    if (threadIdx.x == 0) { LAS unsigned long long* t = (LAS unsigned long long*)((LAS unsigned char*)lds + LDSCTL_OFF);
#pragma unroll
        for (int i = 0; i < N_IN; ++i) t[i] = (unsigned long long)args.in[i];
        t[N_IN] = (unsigned long long)args.out; t[N_IN + 1] = (unsigned long long)args.ws; }
    __syncthreads();
    const int lo = args.ph_lo, hi = args.ph_hi;
    const int wv_ = __builtin_amdgcn_readfirstlane((int)threadIdx.x >> 6);
    if (hi - lo > 1) { (void)xcd_barrier_post((unsigned*)(WSP() + WS_CTL) + CW_BAR, (volatile LAS unsigned*)((LAS unsigned char*)lds + MISC_OFF) + 8); }
#define IN(k) (lo <= (k) && (k) < hi)
#if MK_STAMP
#define STAMP(k) do { if (blockIdx.x == 0 && threadIdx.x == 0) ((unsigned long long*)(WSP() + WS_CTL + 4 * CW_STAMP))[k] = __builtin_amdgcn_s_memrealtime(); } while (0)
#else
#define STAMP(k) do { } while (0)
#endif
#define SEAM(k) do { if (IN((k) + 1)) { XcdBarrier bar_; bar_.bar = (unsigned*)(WSP() + WS_CTL) + CW_BAR; bar_.x = xb_xcc_id(); bar_.st = (volatile LAS unsigned*)((LAS unsigned char*)lds + MISC_OFF) + 8; xcd_barrier(bar_); if (MK_DOUBLE_BAR) xcd_barrier(bar_); } } while (0)
#define WSPTRS() unsigned char* ws = F.ws; float* mod = (float*)(ws + WS_MOD); unsigned char* XA = ws + WS_XA; unsigned char* XB = ws + WS_XB; \
    bf16* H = (bf16*)(ws + WS_H); bf16* ACT = (bf16*)(ws + WS_ACT); float* PST = (float*)(ws + WS_PST); unsigned char* BIG = ws + WS_BIG; \
    const float* modL = mod + (size_t)L * 3 * NMOD; const void* xin_lat = L == 0 ? (const void*)INP(I_X) : (const void*)XA; const void* xin_ctx = L == 0 ? (const void*)INP(I_CTX) : (const void*)(XA + CTXOFF); \
    (void)mod; (void)XA; (void)XB; (void)H; (void)ACT; (void)PST; (void)BIG; (void)modL; (void)xin_lat; (void)xin_ctx;

    if (IN(0)) {
        STAMP(0); FRAME();
        _Pragma("unroll") for (int rep_ = 0; rep_ < 1 + ((MK_REPS >> 0) & 1); ++rep_)
        p0_prologue(F, INP(I_C), INP(I_CCTX), INP(I_WADA), INP(I_BADA), INP(I_NAQKV), INP(I_NAWO), INP(I_GMWIN), INP(I_GMWS), INP(I_GMWOUT),
                    INP(I_SCWIN), INP(I_SCWOUT), INP(I_FUP), INP(I_FDN));
        __syncthreads();
        convert_layer<0>(F, 0, 256, F.vcu * NWAVES + F.wave, F.G * NWAVES);
#if !MK_DEFER_CONVERT
        convert_layer<1>(F, 0, 256, F.vcu * NWAVES + F.wave, F.G * NWAVES); convert_layer<2>(F, 0, 256, F.vcu * NWAVES + F.wave, F.G * NWAVES); convert_layer<3>(F, 0, 256, F.vcu * NWAVES + F.wave, F.G * NWAVES);
#endif
        SEAM(0);
    }
    { constexpr int L = 0;
        const int base = 1 + PH_PER_LAYER * L, mx = L % 3, jx = L / 3;
        const bool last = (L == DEPTH - 1);
        constexpr int rows = (L == DEPTH - 1) ? ML : MT;
        if (IN(base + 0)) { STAMP(base + 0); FRAME(); WSPTRS();
            const float* modP = mod + (size_t)(L > 0 ? L - 1 : 0) * 3 * NMOD;
            _Pragma("unroll") for (int rep_ = 0; rep_ < REPN(MK_RB_NORM); ++rep_) norm_mod_phase<(L == 0) || RES32, RES32, RES32>(F, xin_lat, xin_ctx, INP(I_NMG) + (size_t)L * DM, modL + 0 * DM, modL + 1 * DM, H, MT,
                L > 0 ? (const float*)(ws + WS_SLAB) : nullptr, 8, XB + CTXOFF, modP + 5 * DM, XA + CTXOFF);
            SEAM(base + 0); }
        if (IN(base + 1)) { STAMP(base + 1); FRAME(); WSPTRS();
            const bf16* Wa; int Na; bf16* Oa; bool acta; int modea = 0, modeb = 0, ldca;
            const bf16* Wb; int Mb; bf16* Ob; bool actb, statb;
            if (mx == 0) { Wa = (const bf16*)(ws + WS_WQKV) + (size_t)jx * 6144 * DM; Na = 4096; Oa = (bf16*)(BIG + BIG_QK); acta = false; modea = 1; modeb = 2;
                           Wb = Wa + (size_t)4096 * DM; Mb = 2048; Ob = (bf16*)(BIG + BIG_VT); actb = false; statb = false; }
            else if (mx == 1) { Wa = (const bf16*)(ws + WS_WGIN); Na = 4096; Oa = (bf16*)(BIG + BIG_U); acta = true;
                           Wb = Wa + (size_t)4096 * DM; Mb = 4096; Ob = (bf16*)(BIG + BIG_GVT); actb = true; statb = true; modeb = 3; }
            else { Wa = (const bf16*)(ws + WS_WCIN); Na = 6144; Oa = (bf16*)(BIG + BIG_BCX); acta = false; Wb = nullptr; Mb = 0; Ob = nullptr; actb = false; statb = false; }
            ldca = modea == 1 ? MT : Na;
            pg8::Gemm g{H, Wa, MT, Na, DM, 256, Wb, H, 0}; pg8::DualOrder S; S.init(Na, Mb, F.G, (int)blockIdx.x); S.wgm0 = MK_WGM_IN0; S.wgm1 = MK_WGM_IN1;
            if (MK_XSTAG_IN > 0) { const unsigned long long d_ = (unsigned long long)(xb_xcc_id() & 7u) * MK_XSTAG_IN, t0_ = __builtin_amdgcn_s_memrealtime(); while (__builtin_amdgcn_s_memrealtime() - t0_ < d_) __builtin_amdgcn_s_sleep(4); }
            if constexpr (L % 3 == 1) {
                pg8::EpiDual E{ pg8::EpiBf16R{Oa, ldca, nullptr, acta, false, modea, (PG8_LAS float*)(F.lds + HALO_OFF), INP(I_NAQG) + jx * HD, INP(I_NAKG) + jx * HD},
                                pg8::EpiBf16R{Ob, MT, PST, actb, statb, modeb, nullptr, nullptr, nullptr} };
                _Pragma("unroll") for (int rep_ = 0; rep_ < REPN(MK_RB_GIN); ++rep_)
                pg8::gemm_phase<pg8::EpiDual, pg8::DualOrder, true, true>(F.lds + RING_OFF, g, S, E, wv_);
            } else {
                constexpr int kM0 = (L % 3 == 0) ? 1 : 0, kM1 = (L % 3 == 0) ? 2 : 0;
                typedef pg8::EpiDualT<kM0, false, false, kM1, false, false> EpiIn;
                EpiIn E{ pg8::EpiBf16T<kM0, false, false>{Oa, ldca, nullptr, (PG8_LAS float*)(F.lds + HALO_OFF), INP(I_NAQG) + jx * HD, INP(I_NAKG) + jx * HD},
                         pg8::EpiBf16T<kM1, false, false>{Ob, MT, PST, nullptr, nullptr, nullptr} };
                _Pragma("unroll") for (int rep_ = 0; rep_ < REPN(MK_RB_GIN); ++rep_)
                pg8::gemm_phase<EpiIn, pg8::DualOrder, true, true>(F.lds + RING_OFF, g, S, E, wv_);
            }
#if MK_DEFER_CONVERT
            if (L + 1 < DEPTH) { int rk, ni; idle_rank(S.n0 + S.n1 + S.c0 + 2 * S.nM1, F.G, (int)blockIdx.x, rk, ni);
                if (rk >= 0) convert_layer<(L + 1 < DEPTH ? L + 1 : 0)>(F, 0, MK_DS1, rk * NWAVES + F.wave, ni * NWAVES); }
#endif
            SEAM(base + 1);
        }
        if (IN(base + 3)) { STAMP(base + 3); FRAME(); WSPTRS();
            _Pragma("unroll") for (int rep_ = 0; rep_ < REPN(MK_RB_CORE); ++rep_) {
            if (mx == 0) attn_phase(F, (const bf16*)(BIG + BIG_QK), (const bf16*)(BIG + BIG_VT), (bf16*)(BIG + BIG_O), INP(I_NARPB) + (size_t)jx * NH * 15 * 31, !last);
            else if (mx == 1) gm_spatial_phase(F, (const bf16*)(BIG + BIG_U), (const bf16*)(BIG + BIG_GVT), (bf16*)(BIG + BIG_G), (const bf16*)(ws + WS_WGS), PST, INP(I_GMVG), INP(I_GMBS));
            else sc_conv_phase(F, (const bf16*)(BIG + BIG_BCX), (bf16*)(BIG + BIG_T), INP(I_SCCW));
            }
            SEAM(base + 3);
        }
        if (IN(base + 4)) { STAMP(base + 4); FRAME(); WSPTRS();
            const bf16* Ao; const bf16* Wo; int Ko;
            if (mx == 0) { Ao = (const bf16*)(BIG + BIG_O); Wo = (const bf16*)(ws + WS_WO) + (size_t)jx * DM * DM; Ko = DM; }
            else if (mx == 1) { Ao = (const bf16*)(BIG + BIG_G); Wo = (const bf16*)(ws + WS_WGOUT); Ko = GMW; }
            else { Ao = (const bf16*)(BIG + BIG_T); Wo = (const bf16*)(ws + WS_WCOUT); Ko = DM; }
            pg8::Gemm g{Ao, Wo, rows, DM, Ko, 256, nullptr, nullptr, 0}; pg8::SplitOrder S; S.init(DM, Ko, mx == 1 ? 8 : 4, !last, F.G, (int)blockIdx.x); S.lat.wgm = MK_WGM_OUT;
            if (MK_STAGGER_TICKS > 0 && (blockIdx.x & 1)) { const unsigned long long t0_ = __builtin_amdgcn_s_memrealtime(); while (__builtin_amdgcn_s_memrealtime() - t0_ < (unsigned long long)MK_STAGGER_TICKS) __builtin_amdgcn_s_sleep(8); }
            pg8::EpiResT<(L == 0) || RES32, RES32> E{xin_lat, xin_ctx, XB, XB + CTXOFF, modL + 2 * DM, (float*)(ws + WS_SLAB)};
            _Pragma("unroll") for (int rep_ = 0; rep_ < REPN(MK_RB_GOUT); ++rep_)
            pg8::gemm_phase<pg8::EpiResT<(L == 0) || RES32, RES32>, pg8::SplitOrder, true, true>(F.lds + RING_OFF, g, S, E, wv_);
#if MK_DEFER_CONVERT
            if (L + 1 < DEPTH) { int rk, ni; idle_rank(S.nlat + S.nctx, F.G, (int)blockIdx.x, rk, ni);
                if (rk >= 0) convert_layer<(L + 1 < DEPTH ? L + 1 : 0)>(F, MK_DS1, MK_DS2, rk * NWAVES + F.wave, ni * NWAVES); }
#endif
            SEAM(base + 4);
        }
        if (IN(base + 5)) { STAMP(base + 5); FRAME(); WSPTRS();
            _Pragma("unroll") for (int rep_ = 0; rep_ < REPN(MK_RB_NORM); ++rep_) norm_mod_phase<RES32, (L == 0) || RES32, RES32>(F, XB, XB + CTXOFF, INP(I_NFG) + (size_t)L * DM, modL + 3 * DM, modL + 4 * DM, H, rows,
                !last ? (const float*)(ws + WS_SLAB) : nullptr, mx == 1 ? 8 : 4, xin_ctx, modL + 2 * DM, XB + CTXOFF);
            SEAM(base + 5); }
#if MK_FFN_HALVES
        if (IN(base + 6)) { STAMP(base + 6); FRAME(); WSPTRS();
            constexpr int npan = (rows + 253) / 254, pan0 = 0, pan1 = 33;
            pg8::Gemm g{H - DM, (const bf16*)(ws + WS_WUP) + (size_t)L * FFN2 * DM, npan * 256, FFN2, DM, 254, nullptr, nullptr, 0}; pg8::StaticOrder S; S.init((pan1 - pan0) * 256, FFN2, F.G, (int)blockIdx.x); S.wgm = MK_WGM_UP; S.pm0 = pan0;
            pg8::EpiAct E{ACT, INP(I_FCW) + (size_t)L * 3 * FFN2, INP(I_FCB) + (size_t)L * FFN2, rows, (PG8_LAS float*)(F.lds + HALO_OFF), FFN_LD};
            _Pragma("unroll") for (int rep_ = 0; rep_ < REPN(MK_RB_UP); ++rep_)
            pg8::gemm_phase<pg8::EpiAct, pg8::StaticOrder, true, true>(F.lds + RING_OFF, g, S, E, wv_);
#if MK_DEFER_CONVERT
            if (L + 1 < DEPTH) { int rk, ni; idle_rank((pan1 - pan0) * (FFN2 / 256), F.G, (int)blockIdx.x, rk, ni);
                if (rk >= 0) convert_layer<(L + 1 < DEPTH ? L + 1 : 0)>(F, MK_DS2, (MK_DS2 + MK_DS3) / 2, rk * NWAVES + F.wave, ni * NWAVES); }
#endif
            SEAM(base + 6);
        }
        if (IN(base + 7)) { STAMP(base + 7); FRAME(); WSPTRS();
            pg8::Gemm g{ACT, (const bf16*)(ws + WS_WDN) + (size_t)L * DM * FFN_LD, rows, DM, FFN, 256, nullptr, nullptr, FFN_LD}; pg8::SplitOrder S; S.init(DM, FFN, 8, false, F.G, (int)blockIdx.x, 32, 0); S.lat.wgm = MK_WGM_DOWN;
            void* xo_lat = last ? (void*)OUTP() : (void*)XA;
            pg8::EpiResT<RES32, (L == DEPTH - 1) || RES32> E{XB, XB + CTXOFF, xo_lat, XA + CTXOFF, modL + 5 * DM, (float*)(ws + WS_SLAB)};
            _Pragma("unroll") for (int rep_ = 0; rep_ < REPN(MK_RB_DOWN); ++rep_)
            pg8::gemm_phase<pg8::EpiResT<RES32, (L == DEPTH - 1) || RES32>, pg8::SplitOrder, true, true>(F.lds + RING_OFF, g, S, E, wv_);
            SEAM(base + 7);
        }
        if (IN(base + 8)) { STAMP(base + 8); FRAME(); WSPTRS();
            constexpr int npan = (rows + 253) / 254, pan0 = 33, pan1 = npan;
            pg8::Gemm g{H - DM, (const bf16*)(ws + WS_WUP) + (size_t)L * FFN2 * DM, npan * 256, FFN2, DM, 254, nullptr, nullptr, 0}; pg8::StaticOrder S; S.init((pan1 - pan0) * 256, FFN2, F.G, (int)blockIdx.x); S.wgm = MK_WGM_UP; S.pm0 = pan0;
            pg8::EpiAct E{ACT, INP(I_FCW) + (size_t)L * 3 * FFN2, INP(I_FCB) + (size_t)L * FFN2, rows, (PG8_LAS float*)(F.lds + HALO_OFF), FFN_LD};
            _Pragma("unroll") for (int rep_ = 0; rep_ < REPN(MK_RB_UP); ++rep_)
            pg8::gemm_phase<pg8::EpiAct, pg8::StaticOrder, true, true>(F.lds + RING_OFF, g, S, E, wv_);
#if MK_DEFER_CONVERT
            if (L + 1 < DEPTH) { int rk, ni; idle_rank((pan1 - pan0) * (FFN2 / 256), F.G, (int)blockIdx.x, rk, ni);
                if (rk >= 0) convert_layer<(L + 1 < DEPTH ? L + 1 : 0)>(F, (MK_DS2 + MK_DS3) / 2, MK_DS3, rk * NWAVES + F.wave, ni * NWAVES); }
#endif
            SEAM(base + 8);
        }
        if (IN(base + 9)) { STAMP(base + 9); FRAME(); WSPTRS();
            pg8::Gemm g{ACT, (const bf16*)(ws + WS_WDN) + (size_t)L * DM * FFN_LD, rows, DM, FFN, 256, nullptr, nullptr, FFN_LD}; pg8::SplitOrder S; S.init(DM, FFN, 8, !last, F.G, (int)blockIdx.x, 32, 32); S.lat.wgm = MK_WGM_DOWN;
            void* xo_lat = last ? (void*)OUTP() : (void*)XA;
            pg8::EpiResT<RES32, (L == DEPTH - 1) || RES32> E{XB, XB + CTXOFF, xo_lat, XA + CTXOFF, modL + 5 * DM, (float*)(ws + WS_SLAB)};
            _Pragma("unroll") for (int rep_ = 0; rep_ < REPN(MK_RB_DOWN); ++rep_)
            pg8::gemm_phase<pg8::EpiResT<RES32, (L == DEPTH - 1) || RES32>, pg8::SplitOrder, true, true>(F.lds + RING_OFF, g, S, E, wv_);
            SEAM(base + 9);
        }
#else
        if (IN(base + 6)) { STAMP(base + 6); FRAME(); WSPTRS();
            constexpr int npan = (rows + 253) / 254;
            pg8::Gemm g{H - DM, (const bf16*)(ws + WS_WUP) + (size_t)L * FFN2 * DM, npan * 256, FFN2, DM, 254, nullptr, nullptr, 0}; pg8::StaticOrder S; S.init(npan * 256, FFN2, F.G, (int)blockIdx.x); S.wgm = MK_WGM_UP;
            if (MK_ISTAG_UP > 0) { const unsigned long long d_ = (unsigned long long)(((unsigned)blockIdx.x >> 3) & (MK_ISTAG_WAYS - 1)) * MK_ISTAG_UP, t0_ = __builtin_amdgcn_s_memrealtime(); while (__builtin_amdgcn_s_memrealtime() - t0_ < d_) __builtin_amdgcn_s_sleep(4); }
            if (MK_XSTAG_UP > 0) { const unsigned long long d_ = (unsigned long long)(xb_xcc_id() & 7u) * MK_XSTAG_UP, t0_ = __builtin_amdgcn_s_memrealtime(); while (__builtin_amdgcn_s_memrealtime() - t0_ < d_) __builtin_amdgcn_s_sleep(4); }
            pg8::EpiAct E{ACT, INP(I_FCW) + (size_t)L * 3 * FFN2, INP(I_FCB) + (size_t)L * FFN2, rows, (PG8_LAS float*)(F.lds + HALO_OFF), FFN_LD};
            _Pragma("unroll") for (int rep_ = 0; rep_ < REPN(MK_RB_UP); ++rep_)
            pg8::gemm_phase<pg8::EpiAct, pg8::StaticOrder, true, true>(F.lds + RING_OFF, g, S, E, wv_);
#if MK_DEFER_CONVERT
            if (L + 1 < DEPTH) { int rk, ni; idle_rank(npan * (FFN2 / 256), F.G, (int)blockIdx.x, rk, ni);
                if (rk >= 0) convert_layer<(L + 1 < DEPTH ? L + 1 : 0)>(F, MK_DS2, MK_DS3, rk * NWAVES + F.wave, ni * NWAVES); }
#endif
            SEAM(base + 6);
        }
        if (IN(base + 7)) { STAMP(base + 7); FRAME(); WSPTRS();
            pg8::Gemm g{ACT, (const bf16*)(ws + WS_WDN) + (size_t)L * DM * FFN_LD, rows, DM, FFN, 256, nullptr, nullptr, FFN_LD}; pg8::SplitOrder S; S.init(DM, FFN, 8, !last, F.G, (int)blockIdx.x); S.rev = MK_DOWN_REV; S.lat.wgm = MK_WGM_DOWN;
            void* xo_lat = last ? (void*)OUTP() : (void*)XA;
            if (MK_STAGGER_TICKS > 0 && (blockIdx.x & 1)) { const unsigned long long t0_ = __builtin_amdgcn_s_memrealtime(); while (__builtin_amdgcn_s_memrealtime() - t0_ < (unsigned long long)MK_STAGGER_TICKS) __builtin_amdgcn_s_sleep(8); }
            pg8::EpiResT<RES32, (L == DEPTH - 1) || RES32> E{XB, XB + CTXOFF, xo_lat, XA + CTXOFF, modL + 5 * DM, (float*)(ws + WS_SLAB)};
            _Pragma("unroll") for (int rep_ = 0; rep_ < REPN(MK_RB_DOWN); ++rep_)
            pg8::gemm_phase<pg8::EpiResT<RES32, (L == DEPTH - 1) || RES32>, pg8::SplitOrder, true, true>(F.lds + RING_OFF, g, S, E, wv_);
#if MK_DEFER_CONVERT
            if (L + 1 < DEPTH) { int rk, ni; idle_rank(S.nlat + S.nctx, F.G, (int)blockIdx.x, rk, ni);
                if (rk >= 0) convert_layer<(L + 1 < DEPTH ? L + 1 : 0)>(F, MK_DS3, 256, rk * NWAVES + F.wave, ni * NWAVES); }
#endif
            SEAM(base + 7);
        }
#endif
    }
    { constexpr int L = 1;
        const int base = 1 + PH_PER_LAYER * L, mx = L % 3, jx = L / 3;
        const bool last = (L == DEPTH - 1);
        constexpr int rows = (L == DEPTH - 1) ? ML : MT;
        if (IN(base + 0)) { STAMP(base + 0); FRAME(); WSPTRS();
            const float* modP = mod + (size_t)(L > 0 ? L - 1 : 0) * 3 * NMOD;
            _Pragma("unroll") for (int rep_ = 0; rep_ < REPN(MK_RB_NORM); ++rep_) norm_mod_phase<(L == 0) || RES32, RES32, RES32>(F, xin_lat, xin_ctx, INP(I_NMG) + (size_t)L * DM, modL + 0 * DM, modL + 1 * DM, H, MT,
                L > 0 ? (const float*)(ws + WS_SLAB) : nullptr, 8, XB + CTXOFF, modP + 5 * DM, XA + CTXOFF);
            SEAM(base + 0); }
        if (IN(base + 1)) { STAMP(base + 1); FRAME(); WSPTRS();
            const bf16* Wa; int Na; bf16* Oa; bool acta; int modea = 0, modeb = 0, ldca;
            const bf16* Wb; int Mb; bf16* Ob; bool actb, statb;
            if (mx == 0) { Wa = (const bf16*)(ws + WS_WQKV) + (size_t)jx * 6144 * DM; Na = 4096; Oa = (bf16*)(BIG + BIG_QK); acta = false; modea = 1; modeb = 2;
                           Wb = Wa + (size_t)4096 * DM; Mb = 2048; Ob = (bf16*)(BIG + BIG_VT); actb = false; statb = false; }
            else if (mx == 1) { Wa = (const bf16*)(ws + WS_WGIN); Na = 4096; Oa = (bf16*)(BIG + BIG_U); acta = true;
                           Wb = Wa + (size_t)4096 * DM; Mb = 4096; Ob = (bf16*)(BIG + BIG_GVT); actb = true; statb = true; modeb = 3; }
            else { Wa = (const bf16*)(ws + WS_WCIN); Na = 6144; Oa = (bf16*)(BIG + BIG_BCX); acta = false; Wb = nullptr; Mb = 0; Ob = nullptr; actb = false; statb = false; }
            ldca = modea == 1 ? MT : Na;
            pg8::Gemm g{H, Wa, MT, Na, DM, 256, Wb, H, 0}; pg8::DualOrder S; S.init(Na, Mb, F.G, (int)blockIdx.x); S.wgm0 = MK_WGM_IN0; S.wgm1 = MK_WGM_IN1;
            if (MK_XSTAG_IN > 0) { const unsigned long long d_ = (unsigned long long)(xb_xcc_id() & 7u) * MK_XSTAG_IN, t0_ = __builtin_amdgcn_s_memrealtime(); while (__builtin_amdgcn_s_memrealtime() - t0_ < d_) __builtin_amdgcn_s_sleep(4); }
            if constexpr (L % 3 == 1) {
                pg8::EpiDual E{ pg8::EpiBf16R{Oa, ldca, nullptr, acta, false, modea, (PG8_LAS float*)(F.lds + HALO_OFF), INP(I_NAQG) + jx * HD, INP(I_NAKG) + jx * HD},
                                pg8::EpiBf16R{Ob, MT, PST, actb, statb, modeb, nullptr, nullptr, nullptr} };
                _Pragma("unroll") for (int rep_ = 0; rep_ < REPN(MK_RB_GIN); ++rep_)
                pg8::gemm_phase<pg8::EpiDual, pg8::DualOrder, true, true>(F.lds + RING_OFF, g, S, E, wv_);
            } else {
                constexpr int kM0 = (L % 3 == 0) ? 1 : 0, kM1 = (L % 3 == 0) ? 2 : 0;
                typedef pg8::EpiDualT<kM0, false, false, kM1, false, false> EpiIn;
                EpiIn E{ pg8::EpiBf16T<kM0, false, false>{Oa, ldca, nullptr, (PG8_LAS float*)(F.lds + HALO_OFF), INP(I_NAQG) + jx * HD, INP(I_NAKG) + jx * HD},
                         pg8::EpiBf16T<kM1, false, false>{Ob, MT, PST, nullptr, nullptr, nullptr} };
                _Pragma("unroll") for (int rep_ = 0; rep_ < REPN(MK_RB_GIN); ++rep_)
                pg8::gemm_phase<EpiIn, pg8::DualOrder, true, true>(F.lds + RING_OFF, g, S, E, wv_);
            }
#if MK_DEFER_CONVERT
            if (L + 1 < DEPTH) { int rk, ni; idle_rank(S.n0 + S.n1 + S.c0 + 2 * S.nM1, F.G, (int)blockIdx.x, rk, ni);
                if (rk >= 0) convert_layer<(L + 1 < DEPTH ? L + 1 : 0)>(F, 0, MK_DS1, rk * NWAVES + F.wave, ni * NWAVES); }
#endif
            SEAM(base + 1);
        }
        if (IN(base + 3)) { STAMP(base + 3); FRAME(); WSPTRS();
            _Pragma("unroll") for (int rep_ = 0; rep_ < REPN(MK_RB_CORE); ++rep_) {
            if (mx == 0) attn_phase(F, (const bf16*)(BIG + BIG_QK), (const bf16*)(BIG + BIG_VT), (bf16*)(BIG + BIG_O), INP(I_NARPB) + (size_t)jx * NH * 15 * 31, !last);
            else if (mx == 1) gm_spatial_phase(F, (const bf16*)(BIG + BIG_U), (const bf16*)(BIG + BIG_GVT), (bf16*)(BIG + BIG_G), (const bf16*)(ws + WS_WGS), PST, INP(I_GMVG), INP(I_GMBS));
            else sc_conv_phase(F, (const bf16*)(BIG + BIG_BCX), (bf16*)(BIG + BIG_T), INP(I_SCCW));
            }
            SEAM(base + 3);
        }
        if (IN(base + 4)) { STAMP(base + 4); FRAME(); WSPTRS();
            const bf16* Ao; const bf16* Wo; int Ko;
            if (mx == 0) { Ao = (const bf16*)(BIG + BIG_O); Wo = (const bf16*)(ws + WS_WO) + (size_t)jx * DM * DM; Ko = DM; }
            else if (mx == 1) { Ao = (const bf16*)(BIG + BIG_G); Wo = (const bf16*)(ws + WS_WGOUT); Ko = GMW; }
            else { Ao = (const bf16*)(BIG + BIG_T); Wo = (const bf16*)(ws + WS_WCOUT); Ko = DM; }
            pg8::Gemm g{Ao, Wo, rows, DM, Ko, 256, nullptr, nullptr, 0}; pg8::SplitOrder S; S.init(DM, Ko, mx == 1 ? 8 : 4, !last, F.G, (int)blockIdx.x); S.lat.wgm = MK_WGM_OUT;
            if (MK_STAGGER_TICKS > 0 && (blockIdx.x & 1)) { const unsigned long long t0_ = __builtin_amdgcn_s_memrealtime(); while (__builtin_amdgcn_s_memrealtime() - t0_ < (unsigned long long)MK_STAGGER_TICKS) __builtin_amdgcn_s_sleep(8); }
            pg8::EpiResT<(L == 0) || RES32, RES32> E{xin_lat, xin_ctx, XB, XB + CTXOFF, modL + 2 * DM, (float*)(ws + WS_SLAB)};
            _Pragma("unroll") for (int rep_ = 0; rep_ < REPN(MK_RB_GOUT); ++rep_)
            pg8::gemm_phase<pg8::EpiResT<(L == 0) || RES32, RES32>, pg8::SplitOrder, true, true>(F.lds + RING_OFF, g, S, E, wv_);
#if MK_DEFER_CONVERT
            if (L + 1 < DEPTH) { int rk, ni; idle_rank(S.nlat + S.nctx, F.G, (int)blockIdx.x, rk, ni);
                if (rk >= 0) convert_layer<(L + 1 < DEPTH ? L + 1 : 0)>(F, MK_DS1, MK_DS2, rk * NWAVES + F.wave, ni * NWAVES); }
#endif
            SEAM(base + 4);
        }
        if (IN(base + 5)) { STAMP(base + 5); FRAME(); WSPTRS();
            _Pragma("unroll") for (int rep_ = 0; rep_ < REPN(MK_RB_NORM); ++rep_) norm_mod_phase<RES32, (L == 0) || RES32, RES32>(F, XB, XB + CTXOFF, INP(I_NFG) + (size_t)L * DM, modL + 3 * DM, modL + 4 * DM, H, rows,
                !last ? (const float*)(ws + WS_SLAB) : nullptr, mx == 1 ? 8 : 4, xin_ctx, modL + 2 * DM, XB + CTXOFF);
            SEAM(base + 5); }
#if MK_FFN_HALVES
        if (IN(base + 6)) { STAMP(base + 6); FRAME(); WSPTRS();
            constexpr int npan = (rows + 253) / 254, pan0 = 0, pan1 = 33;
            pg8::Gemm g{H - DM, (const bf16*)(ws + WS_WUP) + (size_t)L * FFN2 * DM, npan * 256, FFN2, DM, 254, nullptr, nullptr, 0}; pg8::StaticOrder S; S.init((pan1 - pan0) * 256, FFN2, F.G, (int)blockIdx.x); S.wgm = MK_WGM_UP; S.pm0 = pan0;
            pg8::EpiAct E{ACT, INP(I_FCW) + (size_t)L * 3 * FFN2, INP(I_FCB) + (size_t)L * FFN2, rows, (PG8_LAS float*)(F.lds + HALO_OFF), FFN_LD};
            _Pragma("unroll") for (int rep_ = 0; rep_ < REPN(MK_RB_UP); ++rep_)
            pg8::gemm_phase<pg8::EpiAct, pg8::StaticOrder, true, true>(F.lds + RING_OFF, g, S, E, wv_);
#if MK_DEFER_CONVERT
            if (L + 1 < DEPTH) { int rk, ni; idle_rank((pan1 - pan0) * (FFN2 / 256), F.G, (int)blockIdx.x, rk, ni);
                if (rk >= 0) convert_layer<(L + 1 < DEPTH ? L + 1 : 0)>(F, MK_DS2, (MK_DS2 + MK_DS3) / 2, rk * NWAVES + F.wave, ni * NWAVES); }
#endif
            SEAM(base + 6);
        }
        if (IN(base + 7)) { STAMP(base + 7); FRAME(); WSPTRS();
            pg8::Gemm g{ACT, (const bf16*)(ws + WS_WDN) + (size_t)L * DM * FFN_LD, rows, DM, FFN, 256, nullptr, nullptr, FFN_LD}; pg8::SplitOrder S; S.init(DM, FFN, 8, false, F.G, (int)blockIdx.x, 32, 0); S.lat.wgm = MK_WGM_DOWN;
            void* xo_lat = last ? (void*)OUTP() : (void*)XA;
            pg8::EpiResT<RES32, (L == DEPTH - 1) || RES32> E{XB, XB + CTXOFF, xo_lat, XA + CTXOFF, modL + 5 * DM, (float*)(ws + WS_SLAB)};
            _Pragma("unroll") for (int rep_ = 0; rep_ < REPN(MK_RB_DOWN); ++rep_)
            pg8::gemm_phase<pg8::EpiResT<RES32, (L == DEPTH - 1) || RES32>, pg8::SplitOrder, true, true>(F.lds + RING_OFF, g, S, E, wv_);
            SEAM(base + 7);
        }
        if (IN(base + 8)) { STAMP(base + 8); FRAME(); WSPTRS();
            constexpr int npan = (rows + 253) / 254, pan0 = 33, pan1 = npan;
            pg8::Gemm g{H - DM, (const bf16*)(ws + WS_WUP) + (size_t)L * FFN2 * DM, npan * 256, FFN2, DM, 254, nullptr, nullptr, 0}; pg8::StaticOrder S; S.init((pan1 - pan0) * 256, FFN2, F.G, (int)blockIdx.x); S.wgm = MK_WGM_UP; S.pm0 = pan0;
            pg8::EpiAct E{ACT, INP(I_FCW) + (size_t)L * 3 * FFN2, INP(I_FCB) + (size_t)L * FFN2, rows, (PG8_LAS float*)(F.lds + HALO_OFF), FFN_LD};
            _Pragma("unroll") for (int rep_ = 0; rep_ < REPN(MK_RB_UP); ++rep_)
            pg8::gemm_phase<pg8::EpiAct, pg8::StaticOrder, true, true>(F.lds + RING_OFF, g, S, E, wv_);
#if MK_DEFER_CONVERT
            if (L + 1 < DEPTH) { int rk, ni; idle_rank((pan1 - pan0) * (FFN2 / 256), F.G, (int)blockIdx.x, rk, ni);
                if (rk >= 0) convert_layer<(L + 1 < DEPTH ? L + 1 : 0)>(F, (MK_DS2 + MK_DS3) / 2, MK_DS3, rk * NWAVES + F.wave, ni * NWAVES); }
#endif
            SEAM(base + 8);
        }
        if (IN(base + 9)) { STAMP(base + 9); FRAME(); WSPTRS();
            pg8::Gemm g{ACT, (const bf16*)(ws + WS_WDN) + (size_t)L * DM * FFN_LD, rows, DM, FFN, 256, nullptr, nullptr, FFN_LD}; pg8::SplitOrder S; S.init(DM, FFN, 8, !last, F.G, (int)blockIdx.x, 32, 32); S.lat.wgm = MK_WGM_DOWN;
            void* xo_lat = last ? (void*)OUTP() : (void*)XA;
            pg8::EpiResT<RES32, (L == DEPTH - 1) || RES32> E{XB, XB + CTXOFF, xo_lat, XA + CTXOFF, modL + 5 * DM, (float*)(ws + WS_SLAB)};
            _Pragma("unroll") for (int rep_ = 0; rep_ < REPN(MK_RB_DOWN); ++rep_)
            pg8::gemm_phase<pg8::EpiResT<RES32, (L == DEPTH - 1) || RES32>, pg8::SplitOrder, true, true>(F.lds + RING_OFF, g, S, E, wv_);
            SEAM(base + 9);
        }
#else
        if (IN(base + 6)) { STAMP(base + 6); FRAME(); WSPTRS();
            constexpr int npan = (rows + 253) / 254;
            pg8::Gemm g{H - DM, (const bf16*)(ws + WS_WUP) + (size_t)L * FFN2 * DM, npan * 256, FFN2, DM, 254, nullptr, nullptr, 0}; pg8::StaticOrder S; S.init(npan * 256, FFN2, F.G, (int)blockIdx.x); S.wgm = MK_WGM_UP;
            if (MK_ISTAG_UP > 0) { const unsigned long long d_ = (unsigned long long)(((unsigned)blockIdx.x >> 3) & (MK_ISTAG_WAYS - 1)) * MK_ISTAG_UP, t0_ = __builtin_amdgcn_s_memrealtime(); while (__builtin_amdgcn_s_memrealtime() - t0_ < d_) __builtin_amdgcn_s_sleep(4); }
            if (MK_XSTAG_UP > 0) { const unsigned long long d_ = (unsigned long long)(xb_xcc_id() & 7u) * MK_XSTAG_UP, t0_ = __builtin_amdgcn_s_memrealtime(); while (__builtin_amdgcn_s_memrealtime() - t0_ < d_) __builtin_amdgcn_s_sleep(4); }
            pg8::EpiAct E{ACT, INP(I_FCW) + (size_t)L * 3 * FFN2, INP(I_FCB) + (size_t)L * FFN2, rows, (PG8_LAS float*)(F.lds + HALO_OFF), FFN_LD};
            _Pragma("unroll") for (int rep_ = 0; rep_ < REPN(MK_RB_UP); ++rep_)
            pg8::gemm_phase<pg8::EpiAct, pg8::StaticOrder, true, true>(F.lds + RING_OFF, g, S, E, wv_);
#if MK_DEFER_CONVERT
            if (L + 1 < DEPTH) { int rk, ni; idle_rank(npan * (FFN2 / 256), F.G, (int)blockIdx.x, rk, ni);
                if (rk >= 0) convert_layer<(L + 1 < DEPTH ? L + 1 : 0)>(F, MK_DS2, MK_DS3, rk * NWAVES + F.wave, ni * NWAVES); }
#endif
            SEAM(base + 6);
        }
        if (IN(base + 7)) { STAMP(base + 7); FRAME(); WSPTRS();
            pg8::Gemm g{ACT, (const bf16*)(ws + WS_WDN) + (size_t)L * DM * FFN_LD, rows, DM, FFN, 256, nullptr, nullptr, FFN_LD}; pg8::SplitOrder S; S.init(DM, FFN, 8, !last, F.G, (int)blockIdx.x); S.rev = MK_DOWN_REV; S.lat.wgm = MK_WGM_DOWN;
            void* xo_lat = last ? (void*)OUTP() : (void*)XA;
            if (MK_STAGGER_TICKS > 0 && (blockIdx.x & 1)) { const unsigned long long t0_ = __builtin_amdgcn_s_memrealtime(); while (__builtin_amdgcn_s_memrealtime() - t0_ < (unsigned long long)MK_STAGGER_TICKS) __builtin_amdgcn_s_sleep(8); }
            pg8::EpiResT<RES32, (L == DEPTH - 1) || RES32> E{XB, XB + CTXOFF, xo_lat, XA + CTXOFF, modL + 5 * DM, (float*)(ws + WS_SLAB)};
            _Pragma("unroll") for (int rep_ = 0; rep_ < REPN(MK_RB_DOWN); ++rep_)
            pg8::gemm_phase<pg8::EpiResT<RES32, (L == DEPTH - 1) || RES32>, pg8::SplitOrder, true, true>(F.lds + RING_OFF, g, S, E, wv_);
#if MK_DEFER_CONVERT
            if (L + 1 < DEPTH) { int rk, ni; idle_rank(S.nlat + S.nctx, F.G, (int)blockIdx.x, rk, ni);
                if (rk >= 0) convert_layer<(L + 1 < DEPTH ? L + 1 : 0)>(F, MK_DS3, 256, rk * NWAVES + F.wave, ni * NWAVES); }
#endif
            SEAM(base + 7);
        }
#endif
    }
    { constexpr int L = 2;
        const int base = 1 + PH_PER_LAYER * L, mx = L % 3, jx = L / 3;
        const bool last = (L == DEPTH - 1);
        constexpr int rows = (L == DEPTH - 1) ? ML : MT;
        if (IN(base + 0)) { STAMP(base + 0); FRAME(); WSPTRS();
            const float* modP = mod + (size_t)(L > 0 ? L - 1 : 0) * 3 * NMOD;
            _Pragma("unroll") for (int rep_ = 0; rep_ < REPN(MK_RB_NORM); ++rep_) norm_mod_phase<(L == 0) || RES32, RES32, RES32>(F, xin_lat, xin_ctx, INP(I_NMG) + (size_t)L * DM, modL + 0 * DM, modL + 1 * DM, H, MT,
                L > 0 ? (const float*)(ws + WS_SLAB) : nullptr, 8, XB + CTXOFF, modP + 5 * DM, XA + CTXOFF);
            SEAM(base + 0); }
        if (IN(base + 1)) { STAMP(base + 1); FRAME(); WSPTRS();
            const bf16* Wa; int Na; bf16* Oa; bool acta; int modea = 0, modeb = 0, ldca;
            const bf16* Wb; int Mb; bf16* Ob; bool actb, statb;
            if (mx == 0) { Wa = (const bf16*)(ws + WS_WQKV) + (size_t)jx * 6144 * DM; Na = 4096; Oa = (bf16*)(BIG + BIG_QK); acta = false; modea = 1; modeb = 2;
                           Wb = Wa + (size_t)4096 * DM; Mb = 2048; Ob = (bf16*)(BIG + BIG_VT); actb = false; statb = false; }
            else if (mx == 1) { Wa = (const bf16*)(ws + WS_WGIN); Na = 4096; Oa = (bf16*)(BIG + BIG_U); acta = true;
                           Wb = Wa + (size_t)4096 * DM; Mb = 4096; Ob = (bf16*)(BIG + BIG_GVT); actb = true; statb = true; modeb = 3; }
            else { Wa = (const bf16*)(ws + WS_WCIN); Na = 6144; Oa = (bf16*)(BIG + BIG_BCX); acta = false; Wb = nullptr; Mb = 0; Ob = nullptr; actb = false; statb = false; }
            ldca = modea == 1 ? MT : Na;
            pg8::Gemm g{H, Wa, MT, Na, DM, 256, Wb, H, 0}; pg8::DualOrder S; S.init(Na, Mb, F.G, (int)blockIdx.x); S.wgm0 = MK_WGM_IN0; S.wgm1 = MK_WGM_IN1;
            if (MK_XSTAG_IN > 0) { const unsigned long long d_ = (unsigned long long)(xb_xcc_id() & 7u) * MK_XSTAG_IN, t0_ = __builtin_amdgcn_s_memrealtime(); while (__builtin_amdgcn_s_memrealtime() - t0_ < d_) __builtin_amdgcn_s_sleep(4); }
            if constexpr (L % 3 == 1) {
                pg8::EpiDual E{ pg8::EpiBf16R{Oa, ldca, nullptr, acta, false, modea, (PG8_LAS float*)(F.lds + HALO_OFF), INP(I_NAQG) + jx * HD, INP(I_NAKG) + jx * HD},
                                pg8::EpiBf16R{Ob, MT, PST, actb, statb, modeb, nullptr, nullptr, nullptr} };
                _Pragma("unroll") for (int rep_ = 0; rep_ < REPN(MK_RB_GIN); ++rep_)
                pg8::gemm_phase<pg8::EpiDual, pg8::DualOrder, true, true>(F.lds + RING_OFF, g, S, E, wv_);
            } else {
                constexpr int kM0 = (L % 3 == 0) ? 1 : 0, kM1 = (L % 3 == 0) ? 2 : 0;
                typedef pg8::EpiDualT<kM0, false, false, kM1, false, false> EpiIn;
                EpiIn E{ pg8::EpiBf16T<kM0, false, false>{Oa, ldca, nullptr, (PG8_LAS float*)(F.lds + HALO_OFF), INP(I_NAQG) + jx * HD, INP(I_NAKG) + jx * HD},
                         pg8::EpiBf16T<kM1, false, false>{Ob, MT, PST, nullptr, nullptr, nullptr} };
                _Pragma("unroll") for (int rep_ = 0; rep_ < REPN(MK_RB_GIN); ++rep_)
                pg8::gemm_phase<EpiIn, pg8::DualOrder, true, true>(F.lds + RING_OFF, g, S, E, wv_);
            }
#if MK_DEFER_CONVERT
            if (L + 1 < DEPTH) { int rk, ni; idle_rank(S.n0 + S.n1 + S.c0 + 2 * S.nM1, F.G, (int)blockIdx.x, rk, ni);
                if (rk >= 0) convert_layer<(L + 1 < DEPTH ? L + 1 : 0)>(F, 0, MK_DS1, rk * NWAVES + F.wave, ni * NWAVES); }
#endif
            SEAM(base + 1);
        }
        if (IN(base + 3)) { STAMP(base + 3); FRAME(); WSPTRS();
            _Pragma("unroll") for (int rep_ = 0; rep_ < REPN(MK_RB_CORE); ++rep_) {
            if (mx == 0) attn_phase(F, (const bf16*)(BIG + BIG_QK), (const bf16*)(BIG + BIG_VT), (bf16*)(BIG + BIG_O), INP(I_NARPB) + (size_t)jx * NH * 15 * 31, !last);
            else if (mx == 1) gm_spatial_phase(F, (const bf16*)(BIG + BIG_U), (const bf16*)(BIG + BIG_GVT), (bf16*)(BIG + BIG_G), (const bf16*)(ws + WS_WGS), PST, INP(I_GMVG), INP(I_GMBS));
            else sc_conv_phase(F, (const bf16*)(BIG + BIG_BCX), (bf16*)(BIG + BIG_T), INP(I_SCCW));
            }
            SEAM(base + 3);
        }
        if (IN(base + 4)) { STAMP(base + 4); FRAME(); WSPTRS();
            const bf16* Ao; const bf16* Wo; int Ko;
            if (mx == 0) { Ao = (const bf16*)(BIG + BIG_O); Wo = (const bf16*)(ws + WS_WO) + (size_t)jx * DM * DM; Ko = DM; }
            else if (mx == 1) { Ao = (const bf16*)(BIG + BIG_G); Wo = (const bf16*)(ws + WS_WGOUT); Ko = GMW; }
            else { Ao = (const bf16*)(BIG + BIG_T); Wo = (const bf16*)(ws + WS_WCOUT); Ko = DM; }
            pg8::Gemm g{Ao, Wo, rows, DM, Ko, 256, nullptr, nullptr, 0}; pg8::SplitOrder S; S.init(DM, Ko, mx == 1 ? 8 : 4, !last, F.G, (int)blockIdx.x); S.lat.wgm = MK_WGM_OUT;
            if (MK_STAGGER_TICKS > 0 && (blockIdx.x & 1)) { const unsigned long long t0_ = __builtin_amdgcn_s_memrealtime(); while (__builtin_amdgcn_s_memrealtime() - t0_ < (unsigned long long)MK_STAGGER_TICKS) __builtin_amdgcn_s_sleep(8); }
            pg8::EpiResT<(L == 0) || RES32, RES32> E{xin_lat, xin_ctx, XB, XB + CTXOFF, modL + 2 * DM, (float*)(ws + WS_SLAB)};
            _Pragma("unroll") for (int rep_ = 0; rep_ < REPN(MK_RB_GOUT); ++rep_)
            pg8::gemm_phase<pg8::EpiResT<(L == 0) || RES32, RES32>, pg8::SplitOrder, true, true>(F.lds + RING_OFF, g, S, E, wv_);
#if MK_DEFER_CONVERT
            if (L + 1 < DEPTH) { int rk, ni; idle_rank(S.nlat + S.nctx, F.G, (int)blockIdx.x, rk, ni);
                if (rk >= 0) convert_layer<(L + 1 < DEPTH ? L + 1 : 0)>(F, MK_DS1, MK_DS2, rk * NWAVES + F.wave, ni * NWAVES); }
#endif
            SEAM(base + 4);
        }
        if (IN(base + 5)) { STAMP(base + 5); FRAME(); WSPTRS();
            _Pragma("unroll") for (int rep_ = 0; rep_ < REPN(MK_RB_NORM); ++rep_) norm_mod_phase<RES32, (L == 0) || RES32, RES32>(F, XB, XB + CTXOFF, INP(I_NFG) + (size_t)L * DM, modL + 3 * DM, modL + 4 * DM, H, rows,
                !last ? (const float*)(ws + WS_SLAB) : nullptr, mx == 1 ? 8 : 4, xin_ctx, modL + 2 * DM, XB + CTXOFF);
            SEAM(base + 5); }
#if MK_FFN_HALVES
        if (IN(base + 6)) { STAMP(base + 6); FRAME(); WSPTRS();
            constexpr int npan = (rows + 253) / 254, pan0 = 0, pan1 = 33;
            pg8::Gemm g{H - DM, (const bf16*)(ws + WS_WUP) + (size_t)L * FFN2 * DM, npan * 256, FFN2, DM, 254, nullptr, nullptr, 0}; pg8::StaticOrder S; S.init((pan1 - pan0) * 256, FFN2, F.G, (int)blockIdx.x); S.wgm = MK_WGM_UP; S.pm0 = pan0;
            pg8::EpiAct E{ACT, INP(I_FCW) + (size_t)L * 3 * FFN2, INP(I_FCB) + (size_t)L * FFN2, rows, (PG8_LAS float*)(F.lds + HALO_OFF), FFN_LD};
            _Pragma("unroll") for (int rep_ = 0; rep_ < REPN(MK_RB_UP); ++rep_)
            pg8::gemm_phase<pg8::EpiAct, pg8::StaticOrder, true, true>(F.lds + RING_OFF, g, S, E, wv_);
#if MK_DEFER_CONVERT
            if (L + 1 < DEPTH) { int rk, ni; idle_rank((pan1 - pan0) * (FFN2 / 256), F.G, (int)blockIdx.x, rk, ni);
                if (rk >= 0) convert_layer<(L + 1 < DEPTH ? L + 1 : 0)>(F, MK_DS2, (MK_DS2 + MK_DS3) / 2, rk * NWAVES + F.wave, ni * NWAVES); }
#endif
            SEAM(base + 6);
        }
        if (IN(base + 7)) { STAMP(base + 7); FRAME(); WSPTRS();
            pg8::Gemm g{ACT, (const bf16*)(ws + WS_WDN) + (size_t)L * DM * FFN_LD, rows, DM, FFN, 256, nullptr, nullptr, FFN_LD}; pg8::SplitOrder S; S.init(DM, FFN, 8, false, F.G, (int)blockIdx.x, 32, 0); S.lat.wgm = MK_WGM_DOWN;
            void* xo_lat = last ? (void*)OUTP() : (void*)XA;
            pg8::EpiResT<RES32, (L == DEPTH - 1) || RES32> E{XB, XB + CTXOFF, xo_lat, XA + CTXOFF, modL + 5 * DM, (float*)(ws + WS_SLAB)};
            _Pragma("unroll") for (int rep_ = 0; rep_ < REPN(MK_RB_DOWN); ++rep_)
            pg8::gemm_phase<pg8::EpiResT<RES32, (L == DEPTH - 1) || RES32>, pg8::SplitOrder, true, true>(F.lds + RING_OFF, g, S, E, wv_);
            SEAM(base + 7);
        }
        if (IN(base + 8)) { STAMP(base + 8); FRAME(); WSPTRS();
            constexpr int npan = (rows + 253) / 254, pan0 = 33, pan1 = npan;
            pg8::Gemm g{H - DM, (const bf16*)(ws + WS_WUP) + (size_t)L * FFN2 * DM, npan * 256, FFN2, DM, 254, nullptr, nullptr, 0}; pg8::StaticOrder S; S.init((pan1 - pan0) * 256, FFN2, F.G, (int)blockIdx.x); S.wgm = MK_WGM_UP; S.pm0 = pan0;
            pg8::EpiAct E{ACT, INP(I_FCW) + (size_t)L * 3 * FFN2, INP(I_FCB) + (size_t)L * FFN2, rows, (PG8_LAS float*)(F.lds + HALO_OFF), FFN_LD};
            _Pragma("unroll") for (int rep_ = 0; rep_ < REPN(MK_RB_UP); ++rep_)
            pg8::gemm_phase<pg8::EpiAct, pg8::StaticOrder, true, true>(F.lds + RING_OFF, g, S, E, wv_);
#if MK_DEFER_CONVERT
            if (L + 1 < DEPTH) { int rk, ni; idle_rank((pan1 - pan0) * (FFN2 / 256), F.G, (int)blockIdx.x, rk, ni);
                if (rk >= 0) convert_layer<(L + 1 < DEPTH ? L + 1 : 0)>(F, (MK_DS2 + MK_DS3) / 2, MK_DS3, rk * NWAVES + F.wave, ni * NWAVES); }
#endif
            SEAM(base + 8);
        }
        if (IN(base + 9)) { STAMP(base + 9); FRAME(); WSPTRS();
            pg8::Gemm g{ACT, (const bf16*)(ws + WS_WDN) + (size_t)L * DM * FFN_LD, rows, DM, FFN, 256, nullptr, nullptr, FFN_LD}; pg8::SplitOrder S; S.init(DM, FFN, 8, !last, F.G, (int)blockIdx.x, 32, 32); S.lat.wgm = MK_WGM_DOWN;
            void* xo_lat = last ? (void*)OUTP() : (void*)XA;
            pg8::EpiResT<RES32, (L == DEPTH - 1) || RES32> E{XB, XB + CTXOFF, xo_lat, XA + CTXOFF, modL + 5 * DM, (float*)(ws + WS_SLAB)};
            _Pragma("unroll") for (int rep_ = 0; rep_ < REPN(MK_RB_DOWN); ++rep_)
            pg8::gemm_phase<pg8::EpiResT<RES32, (L == DEPTH - 1) || RES32>, pg8::SplitOrder, true, true>(F.lds + RING_OFF, g, S, E, wv_);
            SEAM(base + 9);
        }
#else
        if (IN(base + 6)) { STAMP(base + 6); FRAME(); WSPTRS();
            constexpr int npan = (rows + 253) / 254;
            pg8::Gemm g{H - DM, (const bf16*)(ws + WS_WUP) + (size_t)L * FFN2 * DM, npan * 256, FFN2, DM, 254, nullptr, nullptr, 0}; pg8::StaticOrder S; S.init(npan * 256, FFN2, F.G, (int)blockIdx.x); S.wgm = MK_WGM_UP;
            if (MK_ISTAG_UP > 0) { const unsigned long long d_ = (unsigned long long)(((unsigned)blockIdx.x >> 3) & (MK_ISTAG_WAYS - 1)) * MK_ISTAG_UP, t0_ = __builtin_amdgcn_s_memrealtime(); while (__builtin_amdgcn_s_memrealtime() - t0_ < d_) __builtin_amdgcn_s_sleep(4); }
            if (MK_XSTAG_UP > 0) { const unsigned long long d_ = (unsigned long long)(xb_xcc_id() & 7u) * MK_XSTAG_UP, t0_ = __builtin_amdgcn_s_memrealtime(); while (__builtin_amdgcn_s_memrealtime() - t0_ < d_) __builtin_amdgcn_s_sleep(4); }
            pg8::EpiAct E{ACT, INP(I_FCW) + (size_t)L * 3 * FFN2, INP(I_FCB) + (size_t)L * FFN2, rows, (PG8_LAS float*)(F.lds + HALO_OFF), FFN_LD};
            _Pragma("unroll") for (int rep_ = 0; rep_ < REPN(MK_RB_UP); ++rep_)
            pg8::gemm_phase<pg8::EpiAct, pg8::StaticOrder, true, true>(F.lds + RING_OFF, g, S, E, wv_);
#if MK_DEFER_CONVERT
            if (L + 1 < DEPTH) { int rk, ni; idle_rank(npan * (FFN2 / 256), F.G, (int)blockIdx.x, rk, ni);
                if (rk >= 0) convert_layer<(L + 1 < DEPTH ? L + 1 : 0)>(F, MK_DS2, MK_DS3, rk * NWAVES + F.wave, ni * NWAVES); }
#endif
            SEAM(base + 6);
        }
        if (IN(base + 7)) { STAMP(base + 7); FRAME(); WSPTRS();
            pg8::Gemm g{ACT, (const bf16*)(ws + WS_WDN) + (size_t)L * DM * FFN_LD, rows, DM, FFN, 256, nullptr, nullptr, FFN_LD}; pg8::SplitOrder S; S.init(DM, FFN, 8, !last, F.G, (int)blockIdx.x); S.rev = MK_DOWN_REV; S.lat.wgm = MK_WGM_DOWN;
            void* xo_lat = last ? (void*)OUTP() : (void*)XA;
            if (MK_STAGGER_TICKS > 0 && (blockIdx.x & 1)) { const unsigned long long t0_ = __builtin_amdgcn_s_memrealtime(); while (__builtin_amdgcn_s_memrealtime() - t0_ < (unsigned long long)MK_STAGGER_TICKS) __builtin_amdgcn_s_sleep(8); }
            pg8::EpiResT<RES32, (L == DEPTH - 1) || RES32> E{XB, XB + CTXOFF, xo_lat, XA + CTXOFF, modL + 5 * DM, (float*)(ws + WS_SLAB)};
            _Pragma("unroll") for (int rep_ = 0; rep_ < REPN(MK_RB_DOWN); ++rep_)
            pg8::gemm_phase<pg8::EpiResT<RES32, (L == DEPTH - 1) || RES32>, pg8::SplitOrder, true, true>(F.lds + RING_OFF, g, S, E, wv_);
#if MK_DEFER_CONVERT
            if (L + 1 < DEPTH) { int rk, ni; idle_rank(S.nlat + S.nctx, F.G, (int)blockIdx.x, rk, ni);
                if (rk >= 0) convert_layer<(L + 1 < DEPTH ? L + 1 : 0)>(F, MK_DS3, 256, rk * NWAVES + F.wave, ni * NWAVES); }
#endif
            SEAM(base + 7);
        }
#endif
    }
    { constexpr int L = 3;
        const int base = 1 + PH_PER_LAYER * L, mx = L % 3, jx = L / 3;
        const bool last = (L == DEPTH - 1);
        constexpr int rows = (L == DEPTH - 1) ? ML : MT;
        if (IN(base + 0)) { STAMP(base + 0); FRAME(); WSPTRS();
            const float* modP = mod + (size_t)(L > 0 ? L - 1 : 0) * 3 * NMOD;
            _Pragma("unroll") for (int rep_ = 0; rep_ < REPN(MK_RB_NORM); ++rep_) norm_mod_phase<(L == 0) || RES32, RES32, RES32>(F, xin_lat, xin_ctx, INP(I_NMG) + (size_t)L * DM, modL + 0 * DM, modL + 1 * DM, H, MT,
                L > 0 ? (const float*)(ws + WS_SLAB) : nullptr, 8, XB + CTXOFF, modP + 5 * DM, XA + CTXOFF);
            SEAM(base + 0); }
        if (IN(base + 1)) { STAMP(base + 1); FRAME(); WSPTRS();
            const bf16* Wa; int Na; bf16* Oa; bool acta; int modea = 0, modeb = 0, ldca;
            const bf16* Wb; int Mb; bf16* Ob; bool actb, statb;
            if (mx == 0) { Wa = (const bf16*)(ws + WS_WQKV) + (size_t)jx * 6144 * DM; Na = 4096; Oa = (bf16*)(BIG + BIG_QK); acta = false; modea = 1; modeb = 2;
                           Wb = Wa + (size_t)4096 * DM; Mb = 2048; Ob = (bf16*)(BIG + BIG_VT); actb = false; statb = false; }
            else if (mx == 1) { Wa = (const bf16*)(ws + WS_WGIN); Na = 4096; Oa = (bf16*)(BIG + BIG_U); acta = true;
                           Wb = Wa + (size_t)4096 * DM; Mb = 4096; Ob = (bf16*)(BIG + BIG_GVT); actb = true; statb = true; modeb = 3; }
            else { Wa = (const bf16*)(ws + WS_WCIN); Na = 6144; Oa = (bf16*)(BIG + BIG_BCX); acta = false; Wb = nullptr; Mb = 0; Ob = nullptr; actb = false; statb = false; }
            ldca = modea == 1 ? MT : Na;
            pg8::Gemm g{H, Wa, MT, Na, DM, 256, Wb, H, 0}; pg8::DualOrder S; S.init(Na, Mb, F.G, (int)blockIdx.x); S.wgm0 = MK_WGM_IN0; S.wgm1 = MK_WGM_IN1;
            if (MK_XSTAG_IN > 0) { const unsigned long long d_ = (unsigned long long)(xb_xcc_id() & 7u) * MK_XSTAG_IN, t0_ = __builtin_amdgcn_s_memrealtime(); while (__builtin_amdgcn_s_memrealtime() - t0_ < d_) __builtin_amdgcn_s_sleep(4); }
            if constexpr (L % 3 == 1) {
                pg8::EpiDual E{ pg8::EpiBf16R{Oa, ldca, nullptr, acta, false, modea, (PG8_LAS float*)(F.lds + HALO_OFF), INP(I_NAQG) + jx * HD, INP(I_NAKG) + jx * HD},
                                pg8::EpiBf16R{Ob, MT, PST, actb, statb, modeb, nullptr, nullptr, nullptr} };
                _Pragma("unroll") for (int rep_ = 0; rep_ < REPN(MK_RB_GIN); ++rep_)
                pg8::gemm_phase<pg8::EpiDual, pg8::DualOrder, true, true>(F.lds + RING_OFF, g, S, E, wv_);
            } else {
                constexpr int kM0 = (L % 3 == 0) ? 1 : 0, kM1 = (L % 3 == 0) ? 2 : 0;
                typedef pg8::EpiDualT<kM0, false, false, kM1, false, false> EpiIn;
                EpiIn E{ pg8::EpiBf16T<kM0, false, false>{Oa, ldca, nullptr, (PG8_LAS float*)(F.lds + HALO_OFF), INP(I_NAQG) + jx * HD, INP(I_NAKG) + jx * HD},
                         pg8::EpiBf16T<kM1, false, false>{Ob, MT, PST, nullptr, nullptr, nullptr} };
                _Pragma("unroll") for (int rep_ = 0; rep_ < REPN(MK_RB_GIN); ++rep_)
                pg8::gemm_phase<EpiIn, pg8::DualOrder, true, true>(F.lds + RING_OFF, g, S, E, wv_);
            }
#if MK_DEFER_CONVERT
            if (L + 1 < DEPTH) { int rk, ni; idle_rank(S.n0 + S.n1 + S.c0 + 2 * S.nM1, F.G, (int)blockIdx.x, rk, ni);
                if (rk >= 0) convert_layer<(L + 1 < DEPTH ? L + 1 : 0)>(F, 0, MK_DS1, rk * NWAVES + F.wave, ni * NWAVES); }
#endif
            SEAM(base + 1);
        }
        if (IN(base + 3)) { STAMP(base + 3); FRAME(); WSPTRS();
            _Pragma("unroll") for (int rep_ = 0; rep_ < REPN(MK_RB_CORE); ++rep_) {
            if (mx == 0) attn_phase(F, (const bf16*)(BIG + BIG_QK), (const bf16*)(BIG + BIG_VT), (bf16*)(BIG + BIG_O), INP(I_NARPB) + (size_t)jx * NH * 15 * 31, !last);
            else if (mx == 1) gm_spatial_phase(F, (const bf16*)(BIG + BIG_U), (const bf16*)(BIG + BIG_GVT), (bf16*)(BIG + BIG_G), (const bf16*)(ws + WS_WGS), PST, INP(I_GMVG), INP(I_GMBS));
            else sc_conv_phase(F, (const bf16*)(BIG + BIG_BCX), (bf16*)(BIG + BIG_T), INP(I_SCCW));
            }
            SEAM(base + 3);
        }
        if (IN(base + 4)) { STAMP(base + 4); FRAME(); WSPTRS();
            const bf16* Ao; const bf16* Wo; int Ko;
            if (mx == 0) { Ao = (const bf16*)(BIG + BIG_O); Wo = (const bf16*)(ws + WS_WO) + (size_t)jx * DM * DM; Ko = DM; }
            else if (mx == 1) { Ao = (const bf16*)(BIG + BIG_G); Wo = (const bf16*)(ws + WS_WGOUT); Ko = GMW; }
            else { Ao = (const bf16*)(BIG + BIG_T); Wo = (const bf16*)(ws + WS_WCOUT); Ko = DM; }
            pg8::Gemm g{Ao, Wo, rows, DM, Ko, 256, nullptr, nullptr, 0}; pg8::SplitOrder S; S.init(DM, Ko, mx == 1 ? 8 : 4, !last, F.G, (int)blockIdx.x); S.lat.wgm = MK_WGM_OUT;
            if (MK_STAGGER_TICKS > 0 && (blockIdx.x & 1)) { const unsigned long long t0_ = __builtin_amdgcn_s_memrealtime(); while (__builtin_amdgcn_s_memrealtime() - t0_ < (unsigned long long)MK_STAGGER_TICKS) __builtin_amdgcn_s_sleep(8); }
            pg8::EpiResT<(L == 0) || RES32, RES32> E{xin_lat, xin_ctx, XB, XB + CTXOFF, modL + 2 * DM, (float*)(ws + WS_SLAB)};
            _Pragma("unroll") for (int rep_ = 0; rep_ < REPN(MK_RB_GOUT); ++rep_)
            pg8::gemm_phase<pg8::EpiResT<(L == 0) || RES32, RES32>, pg8::SplitOrder, true, true>(F.lds + RING_OFF, g, S, E, wv_);
#if MK_DEFER_CONVERT
            if (L + 1 < DEPTH) { int rk, ni; idle_rank(S.nlat + S.nctx, F.G, (int)blockIdx.x, rk, ni);
                if (rk >= 0) convert_layer<(L + 1 < DEPTH ? L + 1 : 0)>(F, MK_DS1, MK_DS2, rk * NWAVES + F.wave, ni * NWAVES); }
#endif
            SEAM(base + 4);
        }
        if (IN(base + 5)) { STAMP(base + 5); FRAME(); WSPTRS();
            _Pragma("unroll") for (int rep_ = 0; rep_ < REPN(MK_RB_NORM); ++rep_) norm_mod_phase<RES32, (L == 0) || RES32, RES32>(F, XB, XB + CTXOFF, INP(I_NFG) + (size_t)L * DM, modL + 3 * DM, modL + 4 * DM, H, rows,
                !last ? (const float*)(ws + WS_SLAB) : nullptr, mx == 1 ? 8 : 4, xin_ctx, modL + 2 * DM, XB + CTXOFF);
            SEAM(base + 5); }
#if MK_FFN_HALVES
        if (IN(base + 6)) { STAMP(base + 6); FRAME(); WSPTRS();
            constexpr int npan = (rows + 253) / 254, pan0 = 0, pan1 = 33;
            pg8::Gemm g{H - DM, (const bf16*)(ws + WS_WUP) + (size_t)L * FFN2 * DM, npan * 256, FFN2, DM, 254, nullptr, nullptr, 0}; pg8::StaticOrder S; S.init((pan1 - pan0) * 256, FFN2, F.G, (int)blockIdx.x); S.wgm = MK_WGM_UP; S.pm0 = pan0;
            pg8::EpiAct E{ACT, INP(I_FCW) + (size_t)L * 3 * FFN2, INP(I_FCB) + (size_t)L * FFN2, rows, (PG8_LAS float*)(F.lds + HALO_OFF), FFN_LD};
            _Pragma("unroll") for (int rep_ = 0; rep_ < REPN(MK_RB_UP); ++rep_)
            pg8::gemm_phase<pg8::EpiAct, pg8::StaticOrder, true, true>(F.lds + RING_OFF, g, S, E, wv_);
#if MK_DEFER_CONVERT
            if (L + 1 < DEPTH) { int rk, ni; idle_rank((pan1 - pan0) * (FFN2 / 256), F.G, (int)blockIdx.x, rk, ni);
                if (rk >= 0) convert_layer<(L + 1 < DEPTH ? L + 1 : 0)>(F, MK_DS2, (MK_DS2 + MK_DS3) / 2, rk * NWAVES + F.wave, ni * NWAVES); }
#endif
            SEAM(base + 6);
        }
        if (IN(base + 7)) { STAMP(base + 7); FRAME(); WSPTRS();
            pg8::Gemm g{ACT, (const bf16*)(ws + WS_WDN) + (size_t)L * DM * FFN_LD, rows, DM, FFN, 256, nullptr, nullptr, FFN_LD}; pg8::SplitOrder S; S.init(DM, FFN, 8, false, F.G, (int)blockIdx.x, 32, 0); S.lat.wgm = MK_WGM_DOWN;
            void* xo_lat = last ? (void*)OUTP() : (void*)XA;
            pg8::EpiResT<RES32, (L == DEPTH - 1) || RES32> E{XB, XB + CTXOFF, xo_lat, XA + CTXOFF, modL + 5 * DM, (float*)(ws + WS_SLAB)};
            _Pragma("unroll") for (int rep_ = 0; rep_ < REPN(MK_RB_DOWN); ++rep_)
            pg8::gemm_phase<pg8::EpiResT<RES32, (L == DEPTH - 1) || RES32>, pg8::SplitOrder, true, true>(F.lds + RING_OFF, g, S, E, wv_);
            SEAM(base + 7);
        }
        if (IN(base + 8)) { STAMP(base + 8); FRAME(); WSPTRS();
            constexpr int npan = (rows + 253) / 254, pan0 = 33, pan1 = npan;
            pg8::Gemm g{H - DM, (const bf16*)(ws + WS_WUP) + (size_t)L * FFN2 * DM, npan * 256, FFN2, DM, 254, nullptr, nullptr, 0}; pg8::StaticOrder S; S.init((pan1 - pan0) * 256, FFN2, F.G, (int)blockIdx.x); S.wgm = MK_WGM_UP; S.pm0 = pan0;
            pg8::EpiAct E{ACT, INP(I_FCW) + (size_t)L * 3 * FFN2, INP(I_FCB) + (size_t)L * FFN2, rows, (PG8_LAS float*)(F.lds + HALO_OFF), FFN_LD};
            _Pragma("unroll") for (int rep_ = 0; rep_ < REPN(MK_RB_UP); ++rep_)
            pg8::gemm_phase<pg8::EpiAct, pg8::StaticOrder, true, true>(F.lds + RING_OFF, g, S, E, wv_);
#if MK_DEFER_CONVERT
            if (L + 1 < DEPTH) { int rk, ni; idle_rank((pan1 - pan0) * (FFN2 / 256), F.G, (int)blockIdx.x, rk, ni);
                if (rk >= 0) convert_layer<(L + 1 < DEPTH ? L + 1 : 0)>(F, (MK_DS2 + MK_DS3) / 2, MK_DS3, rk * NWAVES + F.wave, ni * NWAVES); }
#endif
            SEAM(base + 8);
        }
        if (IN(base + 9)) { STAMP(base + 9); FRAME(); WSPTRS();
            pg8::Gemm g{ACT, (const bf16*)(ws + WS_WDN) + (size_t)L * DM * FFN_LD, rows, DM, FFN, 256, nullptr, nullptr, FFN_LD}; pg8::SplitOrder S; S.init(DM, FFN, 8, !last, F.G, (int)blockIdx.x, 32, 32); S.lat.wgm = MK_WGM_DOWN;
            void* xo_lat = last ? (void*)OUTP() : (void*)XA;
            pg8::EpiResT<RES32, (L == DEPTH - 1) || RES32> E{XB, XB + CTXOFF, xo_lat, XA + CTXOFF, modL + 5 * DM, (float*)(ws + WS_SLAB)};
            _Pragma("unroll") for (int rep_ = 0; rep_ < REPN(MK_RB_DOWN); ++rep_)
            pg8::gemm_phase<pg8::EpiResT<RES32, (L == DEPTH - 1) || RES32>, pg8::SplitOrder, true, true>(F.lds + RING_OFF, g, S, E, wv_);
            SEAM(base + 9);
        }
#else
        if (IN(base + 6)) { STAMP(base + 6); FRAME(); WSPTRS();
            constexpr int npan = (rows + 253) / 254;
            pg8::Gemm g{H - DM, (const bf16*)(ws + WS_WUP) + (size_t)L * FFN2 * DM, npan * 256, FFN2, DM, 254, nullptr, nullptr, 0}; pg8::StaticOrder S; S.init(npan * 256, FFN2, F.G, (int)blockIdx.x); S.wgm = MK_WGM_UP;
            if (MK_ISTAG_UP > 0) { const unsigned long long d_ = (unsigned long long)(((unsigned)blockIdx.x >> 3) & (MK_ISTAG_WAYS - 1)) * MK_ISTAG_UP, t0_ = __builtin_amdgcn_s_memrealtime(); while (__builtin_amdgcn_s_memrealtime() - t0_ < d_) __builtin_amdgcn_s_sleep(4); }
            if (MK_XSTAG_UP > 0) { const unsigned long long d_ = (unsigned long long)(xb_xcc_id() & 7u) * MK_XSTAG_UP, t0_ = __builtin_amdgcn_s_memrealtime(); while (__builtin_amdgcn_s_memrealtime() - t0_ < d_) __builtin_amdgcn_s_sleep(4); }
            pg8::EpiAct E{ACT, INP(I_FCW) + (size_t)L * 3 * FFN2, INP(I_FCB) + (size_t)L * FFN2, rows, (PG8_LAS float*)(F.lds + HALO_OFF), FFN_LD};
            _Pragma("unroll") for (int rep_ = 0; rep_ < REPN(MK_RB_UP); ++rep_)
            pg8::gemm_phase<pg8::EpiAct, pg8::StaticOrder, true, true>(F.lds + RING_OFF, g, S, E, wv_);
#if MK_DEFER_CONVERT
            if (L + 1 < DEPTH) { int rk, ni; idle_rank(npan * (FFN2 / 256), F.G, (int)blockIdx.x, rk, ni);
                if (rk >= 0) convert_layer<(L + 1 < DEPTH ? L + 1 : 0)>(F, MK_DS2, MK_DS3, rk * NWAVES + F.wave, ni * NWAVES); }
#endif
            SEAM(base + 6);
        }
        if (IN(base + 7)) { STAMP(base + 7); FRAME(); WSPTRS();
            pg8::Gemm g{ACT, (const bf16*)(ws + WS_WDN) + (size_t)L * DM * FFN_LD, rows, DM, FFN, 256, nullptr, nullptr, FFN_LD}; pg8::SplitOrder S; S.init(DM, FFN, 8, !last, F.G, (int)blockIdx.x); S.rev = MK_DOWN_REV; S.lat.wgm = MK_WGM_DOWN;
            void* xo_lat = last ? (void*)OUTP() : (void*)XA;
            if (MK_STAGGER_TICKS > 0 && (blockIdx.x & 1)) { const unsigned long long t0_ = __builtin_amdgcn_s_memrealtime(); while (__builtin_amdgcn_s_memrealtime() - t0_ < (unsigned long long)MK_STAGGER_TICKS) __builtin_amdgcn_s_sleep(8); }
            pg8::EpiResT<RES32, (L == DEPTH - 1) || RES32> E{XB, XB + CTXOFF, xo_lat, XA + CTXOFF, modL + 5 * DM, (float*)(ws + WS_SLAB)};
            _Pragma("unroll") for (int rep_ = 0; rep_ < REPN(MK_RB_DOWN); ++rep_)
            pg8::gemm_phase<pg8::EpiResT<RES32, (L == DEPTH - 1) || RES32>, pg8::SplitOrder, true, true>(F.lds + RING_OFF, g, S, E, wv_);
#if MK_DEFER_CONVERT
            if (L + 1 < DEPTH) { int rk, ni; idle_rank(S.nlat + S.nctx, F.G, (int)blockIdx.x, rk, ni);
                if (rk >= 0) convert_layer<(L + 1 < DEPTH ? L + 1 : 0)>(F, MK_DS3, 256, rk * NWAVES + F.wave, ni * NWAVES); }
#endif
            SEAM(base + 7);
        }
#endif
    }
#if MK_STAMP
    { XcdBarrier bar_; bar_.bar = (unsigned*)(WSP() + WS_CTL) + CW_BAR; bar_.x = xb_xcc_id(); bar_.st = (volatile LAS unsigned*)((LAS unsigned char*)lds + MISC_OFF) + 8; xcd_barrier(bar_); }
    STAMP(NPHASES);
    if (blockIdx.x == 0 && threadIdx.x == 0) {
        const unsigned long long* st = (const unsigned long long*)(WSP() + WS_CTL + 4 * CW_STAMP); unsigned long long tot = 0;
        for (int k = 0; k < NPHASES; ++k) { const int j = k == 0 ? -1 : (k - 1) % PH_PER_LAYER, L = k == 0 ? -1 : (k - 1) / PH_PER_LAYER; int cat;
            if (k == 0) cat = 0; else if (j == 0 || j == 5) cat = 1; else if (j == 1) cat = 2; else if (j == 2) cat = 3; else if (j == 3) cat = (L % 3 == 0) ? 4 : (L % 3 == 1 ? 5 : 6); else if (j == 4) cat = 7; else if (j == 6) cat = 8; else if (j == 7) cat = 9; else cat = 10;
            if (cat == MK_STAMP_SEL || (MK_STAMP_SEL == 11 && (cat == 2 || cat == 7 || cat == 8 || cat == 10)) || (MK_STAMP_SEL == 12 && (cat == 1 || cat == 3 || cat == 9))) tot += st[k + 1] - st[k]; }
        OUTP()[0] = (float)tot * 10.0f;
    }
#endif
#undef IN
#undef SEAM
}

extern "C" void kernel_launch(void* const* d_in, const int* in_sizes, int n_in, void* d_out, int out_size, void* d_ws, size_t ws_size, hipStream_t stream) {
    static int grid = 0;
    if (grid == 0) {
        if (n_in != N_IN || in_sizes[0] != ML * DM || out_size != ML * DM || ws_size < WS_END) {
            fprintf(stderr, "kernel_launch: unexpected problem: n_in %d in0 %d out %d ws %zu (need %zu); nothing launched\n", n_in, n_in > 0 ? in_sizes[0] : -1, out_size, ws_size, (size_t)WS_END); grid = -1; return; }
        int dev = 0, cus = 0, per_cu = 0;
        if (hipGetDevice(&dev) != hipSuccess || hipDeviceGetAttribute(&cus, hipDeviceAttributeMultiprocessorCount, dev) != hipSuccess) { grid = -1; return; }
        if (hipFuncSetAttribute((const void*)mk_fwd, hipFuncAttributeMaxDynamicSharedMemorySize, LDS_BYTES) != hipSuccess) { fprintf(stderr, "kernel_launch: hipFuncSetAttribute failed\n"); grid = -1; return; }
        if (hipOccupancyMaxActiveBlocksPerMultiprocessor(&per_cu, (const void*)mk_fwd, NWAVES * 64, LDS_BYTES) != hipSuccess || per_cu < 1) { fprintf(stderr, "kernel_launch: occupancy query says %d blocks per CU\n", per_cu); }
        (void)hipGetLastError();
        grid = cus;
    }
    if (grid < 0) return;
    if (hipMemsetAsync((char*)d_ws + WS_CTL, 0, CTL_ZERO_BYTES, stream) != hipSuccess) return;
    Args a{};
    for (int i = 0; i < N_IN; ++i) a.in[i] = (const float*)d_in[i];
    a.out = (float*)d_out; a.ws = (unsigned char*)d_ws;
    a.ph_lo = 0; a.ph_hi = NPHASES;
    hipLaunchKernelGGL(mk_fwd, dim3(grid), dim3(NWAVES * 64), LDS_BYTES, stream, a);
    const hipError_t le = hipPeekAtLastError();
    if (le != hipSuccess) fprintf(stderr, "kernel_launch: launch failed: %s\n", hipGetErrorName(le));
}
```

```cpp
#include <hip/hip_runtime.h>
#include <cstdio>
#include <cstdint>

#ifndef MK_STAMP
#define MK_STAMP 0
#endif
#ifndef MK_STAMP_MUL
#define MK_STAMP_MUL 4
#endif
#ifndef MK_STAMP_SEL
#define MK_STAMP_SEL 0
#endif
#ifndef MK_REPS
#define MK_REPS 0
#endif
#ifndef MK_REPL
#define MK_REPL 15
#endif
enum { MK_RB_PRO = 0, MK_RB_NORM = 1, MK_RB_GIN = 2, MK_RB_CORE = 3, MK_RB_GOUT = 4, MK_RB_UP = 5, MK_RB_ACT = 6, MK_RB_DOWN = 7 };
#define REPN(bit) (1 + (((MK_REPS >> (bit)) & 1) & ((MK_REPL >> L) & 1)))
#ifndef MK_STAGGER_TICKS
#define MK_STAGGER_TICKS 0
#endif
#ifndef MK_DOUBLE_BAR
#define MK_DOUBLE_BAR 0
#endif
#ifndef MK_DEFER_CONVERT
#define MK_DEFER_CONVERT 1
#endif
#ifndef MK_DS1
#define MK_DS1 128
#endif
#ifndef MK_DS2
#define MK_DS2 128
#endif
#ifndef MK_DS3
#define MK_DS3 256
#endif
#ifndef MK_DOWN_REV
#define MK_DOWN_REV false
#endif
#ifndef MK_WGM_UP
#define MK_WGM_UP 4
#endif
#ifndef MK_WGM_OUT
#define MK_WGM_OUT 4
#endif
#ifndef MK_WGM_DOWN
#define MK_WGM_DOWN 8
#endif
#ifndef MK_WGM_IN0
#define MK_WGM_IN0 4
#endif
#ifndef MK_WGM_IN1
#define MK_WGM_IN1 4
#endif
#ifndef MK_EPI_PROBE
#define MK_EPI_PROBE 0
#endif
#ifndef MK_RES_BF16
#define MK_RES_BF16 1
#endif
#ifndef MK_NT_B
#define MK_NT_B 0
#endif
#ifndef MK_XSTAG_UP
#define MK_XSTAG_UP 0
#endif
#ifndef MK_XSTAG_IN
#define MK_XSTAG_IN 0
#endif
#ifndef MK_ISTAG_UP
#define MK_ISTAG_UP 0
#endif
#ifndef MK_ISTAG_WAYS
#define MK_ISTAG_WAYS 4
#endif
#ifndef MK_RES_ALLLOADS
#define MK_RES_ALLLOADS 1
#endif
#ifndef MK_TPROBE
#define MK_TPROBE 0
#endif
#ifndef MK_TPROBE_PH
#define MK_TPROBE_PH 1
#endif
#ifndef MK_TPROBE_L
#define MK_TPROBE_L 0
#endif
#ifndef MK_TPROBE_B
#define MK_TPROBE_B 0
#endif
#ifndef MK_TPROBE_UI
#define MK_TPROBE_UI 3
#endif
#ifndef MK_TPROBE_TA
#define MK_TPROBE_TA 2
#endif
#ifndef MK_TPROBE_TB
#define MK_TPROBE_TB 4
#endif
#ifndef MK_TPROBE_TC
#define MK_TPROBE_TC 6
#endif
#ifndef MK_TPROBE_MUL
#define MK_TPROBE_MUL 100
#endif
#ifndef MK_TPROBE_LO
#define MK_TPROBE_LO 0
#endif
#ifndef MK_TPROBE_HI
#define MK_TPROBE_HI 1
#endif
#ifndef MK_NORM_REGMOD
#define MK_NORM_REGMOD 1
#endif
#ifndef MK_CONV33
#define MK_CONV33 1
#endif
#ifndef MK_SPATIAL_LDS
#define MK_SPATIAL_LDS 1
#endif
#ifndef MK_NORM_CTXSPREAD
#define MK_NORM_CTXSPREAD 1
#endif
#ifndef MK_ATTN_CTXSPREAD
#define MK_ATTN_CTXSPREAD 1
#endif
#ifndef MK_DYN_TAIL
#define MK_DYN_TAIL 0
#endif
#ifndef MK_ATTN_ST16
#define MK_ATTN_ST16 1
#endif
#ifndef MK_P0_SHARE
#define MK_P0_SHARE 199
#endif
#ifndef MK_FFN_LD
#define MK_FFN_LD 6144
#endif
#ifndef MK_FFN_HALVES
#define MK_FFN_HALVES 0
#endif
namespace pg8 {
#define PG8_LAS __attribute__((address_space(3)))
typedef unsigned short bf16_t;
typedef short bf16x8 __attribute__((ext_vector_type(8)));
typedef float f32x4 __attribute__((ext_vector_type(4)));
typedef unsigned u32x4 __attribute__((ext_vector_type(4)));
constexpr int BM = 256, BK = 64, HALF = 128, HTB = HALF * BK * 2  , STAGE_BYTES = 8 * HTB, NXCD = 8, WGM = 4;

__host__ __device__ __forceinline__ int lds_byte(int r, int c) { const int st = (r >> 4) * 2 + (c >> 5), rr = r & 15, cc = c & 31, ob = rr * 64 + cc * 2; return st * 1024 + (ob ^ (((ob >> 9) & 1) << 5)); }
__host__ __device__ __forceinline__ void stage_rc(int b, int& R, int& C) { const int st = b / 1024, sb = b % 1024, swz = sb ^ (((sb >> 9) & 1) << 5); R = (st >> 1) * 16 + swz / 64; C = (st & 1) * 32 + (swz % 64) / 2; }
__host__ __device__ __forceinline__ int perm32(int rho) { const int n = rho >> 4, i = rho & 15; return 8 * (i >> 2) + 4 * n + (i & 3); }

struct Unit { int pm, pn, kt0, ktn, ks, which; };
struct Gemm { const bf16_t* A; const bf16_t* Bt; int M, N, K; int panel_rows; const bf16_t* A2; const bf16_t* Bt2; int ldk; };

struct StaticOrder {
    int nM, nN, nwg, G, c, wgm, pm0, imax;
    __host__ __device__ void init(int M, int N, int G_, int c_) { nM = M / BM; nN = N / BM; nwg = nM * nN; G = G_; c = c_; wgm = WGM; pm0 = 0; imax = 1 << 28; }
    __host__ __device__ __forceinline__ bool next(int i, Unit& u) const {
        if (i >= imax) return false;
        const long L = (long)i * G + c; if (L >= nwg) return false;
        int wgid = (int)L; { const int q = nwg / NXCD, r = nwg % NXCD, xcd = wgid % NXCD, off = wgid / NXCD; wgid = (xcd < r ? xcd * (q + 1) : r * (q + 1) + (xcd - r) * q) + off; }
        const int nig = wgm * nN, gid = wgid / nig, fm = gid * wgm, gsz = (nM - fm) < wgm ? (nM - fm) : wgm;
        u.pm = pm0 + fm + ((wgid % nig) % gsz); u.pn = (wgid % nig) / gsz; u.kt0 = 0; u.ktn = 0; u.ks = -1; u.which = 0; return true;
    }
    __device__ __forceinline__ void a_ready(const Unit&) const {}
    __device__ __forceinline__ void done(const Unit&) const {}
};
struct DynOrder {
    StaticOrder st; unsigned* ctr; PG8_LAS unsigned* slot; int base, wv;
    __device__ __forceinline__ bool next(int i, Unit& u) const {
        if (i != 0) return false;
        if (wv == 0 && __builtin_amdgcn_mbcnt_hi(~0u, __builtin_amdgcn_mbcnt_lo(~0u, 0u)) == 0u) *(volatile PG8_LAS unsigned*)slot = __hip_atomic_fetch_add(ctr, 1u, __ATOMIC_RELAXED, __HIP_MEMORY_SCOPE_AGENT);
        __syncthreads();
        const unsigned t = (unsigned)__builtin_amdgcn_readfirstlane((int)*(volatile PG8_LAS unsigned*)slot);
        const long L = (long)base + (long)t; if (L >= st.nwg) return false;
        StaticOrder q = st; q.G = 1; q.c = 0; q.imax = 1 << 28; return q.next((int)L, u);
    }
    __device__ __forceinline__ void a_ready(const Unit&) const {}
    __device__ __forceinline__ void done(const Unit&) const {}
};

struct SplitOrder {
    StaticOrder lat; int nN, S, C, G, c, nlat, nctx; bool rev;
    __host__ __device__ void init(int N, int K, int S_, bool has_ctx, int G_, int c_, int nlatp = 64, int pm0_ = 0) { lat.init(nlatp * BM, N, G_, c_); lat.pm0 = pm0_; nN = N / BM; S = S_; C = K / 128; G = G_; c = c_; nlat = nlatp * nN; nctx = has_ctx ? 2 * nN * S : 0; rev = false; }
    __host__ __device__ __forceinline__ bool next(int i, Unit& u) const {
        const long L = (long)i * G + c;
        if (L < nlat) { const bool ok = lat.next(i, u); if (rev) u.pm = 63 - u.pm; return ok; }
        const int r = (int)(L - nlat); if (r >= nctx) return false;
        const int ks = r % S, q = r / S; u.pn = q % nN; u.pm = 64 + q / nN;
        const int c0 = (C * ks) / S, c1 = (C * (ks + 1)) / S; u.kt0 = 2 * c0; u.ktn = 2 * (c1 - c0); u.ks = ks; u.which = 0; return true;
    }
    __device__ __forceinline__ void a_ready(const Unit&) const {}
    __device__ __forceinline__ void done(const Unit&) const {}
};

__host__ __device__ __forceinline__ void static_map(int nM, int nN, int L, int& pm, int& pn, int wgm) {
    const int nwg = nM * nN; int wgid = L; { const int q = nwg / NXCD, r = nwg % NXCD, xcd = wgid % NXCD, off = wgid / NXCD; wgid = (xcd < r ? xcd * (q + 1) : r * (q + 1) + (xcd - r) * q) + off; }
    const int nig = wgm * nN, gid = wgid / nig, fm = gid * wgm, gsz = (nM - fm) < wgm ? (nM - fm) : wgm;
    pm = fm + ((wgid % nig) % gsz); pn = (wgid % nig) / gsz;
}
struct DualOrder {
    int nN0, nM1, G, c, n0, n1, c0, wgm0, wgm1;
    __host__ __device__ __forceinline__ void init(int N0, int M1, int G_, int c_) { nN0 = N0 / BM; nM1 = M1 / BM; G = G_; c = c_; n0 = 64 * nN0; n1 = 64 * nM1; c0 = 2 * nN0; wgm0 = WGM; wgm1 = WGM; }
    __host__ __device__ __forceinline__ bool next(int i, Unit& u) const {
        int L = i * G + c; int pm = 0, pn = 0, wh = 0; bool ok = true;
        if (L < n0) { static_map(64, nN0, L, pm, pn, wgm0); wh = 0; }
        else if (L < n0 + n1) { static_map(nM1, 64, L - n0, pm, pn, wgm1); wh = 1; }
        else if (L < n0 + n1 + c0) { const int r = L - n0 - n1; pm = 64 + r / nN0; pn = r % nN0; wh = 0; }
        else if (L < n0 + n1 + c0 + 2 * nM1) { const int r = L - n0 - n1 - c0; pm = r % nM1; pn = 64 + r / nM1; wh = 1; }
        else ok = false;
        u.pm = pm; u.pn = pn; u.kt0 = 0; u.ktn = 0; u.ks = -1; u.which = wh; return ok;
    }
    __device__ __forceinline__ void a_ready(const Unit&) const {}
    __device__ __forceinline__ void done(const Unit&) const {}
};

typedef __bf16 bf16v2 __attribute__((ext_vector_type(2)));
typedef float f32x2 __attribute__((ext_vector_type(2)));
__device__ __forceinline__ unsigned cvt_pk_bf16(float lo, float hi) { const f32x2 v = {lo, hi}; return __builtin_bit_cast(unsigned, __builtin_convertvector(v, bf16v2)); }

__device__ __forceinline__ float gelu_tanh(float x) {
    const float y2 = x * (1.5957691216f + 0.0713548163f * x * x);
    return x * __builtin_amdgcn_rcpf(1.0f + __builtin_amdgcn_exp2f(-1.4426950409f * y2));
}
template <int CTRL> __device__ __forceinline__ float dpp(float x) { return __builtin_bit_cast(float, __builtin_amdgcn_mov_dpp(__builtin_bit_cast(int, x), CTRL, 0xf, 0xf, true)); }
__device__ __forceinline__ float row16_sum(float s) { s += dpp<0xB1>(s); s += dpp<0x4E>(s); s += dpp<0x141>(s); s += dpp<0x128>(s); return s; }
__device__ __forceinline__ float xrow16_sum(float x) {
    auto s = __builtin_amdgcn_permlane16_swap(__float_as_uint(x), __float_as_uint(x), false, false); x = __uint_as_float(s[0]) + __uint_as_float(s[1]);
    auto t = __builtin_amdgcn_permlane32_swap(__float_as_uint(x), __float_as_uint(x), false, false); return __uint_as_float(t[0]) + __uint_as_float(t[1]);
}
__device__ __forceinline__ float silu_f(float x) { return x * __builtin_amdgcn_rcpf(1.0f + __builtin_amdgcn_exp2f(-1.4426950409f * x)); }

template <int MODE, bool ACT, bool STATS> struct EpiBf16T {
    static constexpr bool PERM = true, AFTER_DRAIN = false, PERM_A = false, PROBE_TWICE = false, NT_B = false;
    bf16_t* O; int ldc; float* P; PG8_LAS float* part; const float* qg; const float* kg;
    __device__ __forceinline__ void operator()(const f32x4 (&acc)[2][2][4][2], const Unit& u, int wr, int wc, int fr, int fq) const {
        const int row0 = u.pm * BM + wr * 64 + fr; const int col0 = u.pn * BM + wc * 32 + 8 * fq;
        float ss[2][2][4];
        if (STATS) {
#pragma unroll
            for (int bj = 0; bj < 2; ++bj)
#pragma unroll
                for (int n = 0; n < 2; ++n)
#pragma unroll
                    for (int e = 0; e < 4; ++e) ss[bj][n][e] = 0.f;
        }
        f32x4 gn0 = {1.f, 1.f, 1.f, 1.f}, gn1 = gn0;
        if (MODE == 1) {
#pragma unroll
            for (int ai = 0; ai < 2; ++ai)
#pragma unroll
                for (int m = 0; m < 4; ++m)
#pragma unroll
                    for (int bj = 0; bj < 2; ++bj) { const f32x4 a = acc[ai][bj][m][0], b = acc[ai][bj][m][1];
                        float sq = (a[0] * a[0] + a[1] * a[1]) + (a[2] * a[2] + a[3] * a[3]) + (b[0] * b[0] + b[1] * b[1]) + (b[2] * b[2] + b[3] * b[3]);
                        sq = xrow16_sum(sq);
                        if (fq == 0) part[(ai * HALF + wr * 64 + m * 16 + fr) * 8 + bj * 4 + wc] = sq; }
            asm volatile("s_waitcnt lgkmcnt(0)" ::: "memory"); __builtin_amdgcn_s_barrier(); asm volatile("" ::: "memory");
            const float* gp = (u.pn < 8 ? qg : kg) + wc * 32 + 8 * fq; gn0 = *(const f32x4*)gp; gn1 = *(const f32x4*)(gp + 4);
        }
#pragma unroll
        for (int ai = 0; ai < 2; ++ai)
#pragma unroll
            for (int m = 0; m < 4; ++m) { const int row = row0 + ai * HALF + m * 16; bf16_t* rowp = O + (size_t)row * ldc + col0;
#pragma unroll
                for (int bj = 0; bj < 2; ++bj) { f32x4 v0 = acc[ai][bj][m][0], v1 = acc[ai][bj][m][1];
                    bf16_t* dst = rowp + bj * HALF;
                    if (MODE == 1) dst = O + ((size_t)((2 * u.pn + bj) * 8 + 2 * wc + (fq >> 1)) * ldc + row) * 16 + 8 * (fq & 1);
                    if (MODE == 3) { const int tok = col0 + bj * HALF; dst = O + ((size_t)((row >> 5) * (ldc >> 4) + (tok >> 4)) * 32 + (row & 31)) * 16 + (tok & 8); }
                    if (MODE == 2) { const int tok = col0 + bj * HALF; dst = O + ((size_t)((row >> 7) * (ldc >> 3) + (tok >> 3)) * 128 + (row & 127)) * 8; }
                    if (ACT == 1) {
#pragma unroll
                        for (int e = 0; e < 4; ++e) { v0[e] = gelu_tanh(v0[e]); v1[e] = gelu_tanh(v1[e]); } }
                    if (STATS) {
#pragma unroll
                        for (int e = 0; e < 4; ++e) { ss[bj][0][e] += v0[e] * v0[e]; ss[bj][1][e] += v1[e] * v1[e]; } }
                    if (MODE == 1) { const f32x4 p4 = *(const PG8_LAS f32x4*)(part + (ai * HALF + wr * 64 + m * 16 + fr) * 8 + bj * 4);
                        const float rsd = __builtin_amdgcn_rsqf(((p4[0] + p4[1]) + (p4[2] + p4[3])) * (1.0f / 128.0f) + 1e-6f); v0 = v0 * rsd * gn0; v1 = v1 * rsd * gn1; }
                    u32x4 w; w.x = cvt_pk_bf16(v0[0], v0[1]); w.y = cvt_pk_bf16(v0[2], v0[3]); w.z = cvt_pk_bf16(v1[0], v1[1]); w.w = cvt_pk_bf16(v1[2], v1[3]);
                    *(u32x4*)dst = w; } }
        if (STATS) {
#pragma unroll
            for (int bj = 0; bj < 2; ++bj)
#pragma unroll
                for (int n = 0; n < 2; ++n)
#pragma unroll
                    for (int e = 0; e < 4; ++e) { ss[bj][n][e] = row16_sum(ss[bj][n][e]); }
            if (fr == 0) {
                float* pp = P + (size_t)(2 * u.pm + wr) * ldc + col0;
#pragma unroll
                for (int bj = 0; bj < 2; ++bj) { *(f32x4*)(pp + bj * HALF) = (f32x4){ss[bj][0][0], ss[bj][0][1], ss[bj][0][2], ss[bj][0][3]};
                                                 *(f32x4*)(pp + bj * HALF + 4) = (f32x4){ss[bj][1][0], ss[bj][1][1], ss[bj][1][2], ss[bj][1][3]}; }
            }
        }
    }
};

struct EpiBf16R {
    static constexpr bool PERM = true, AFTER_DRAIN = false, PERM_A = false, PROBE_TWICE = false, NT_B = false;
    bf16_t* O; int ldc; float* P; bool ACT, STATS; int MODE; PG8_LAS float* part; const float* qg; const float* kg;
    __device__ __forceinline__ void operator()(const f32x4 (&acc)[2][2][4][2], const Unit& u, int wr, int wc, int fr, int fq) const {
        const int row0 = u.pm * BM + wr * 64 + fr; const int col0 = u.pn * BM + wc * 32 + 8 * fq;
        float ss[2][2][4];
        if (STATS) {
#pragma unroll
            for (int bj = 0; bj < 2; ++bj)
#pragma unroll
                for (int n = 0; n < 2; ++n)
#pragma unroll
                    for (int e = 0; e < 4; ++e) ss[bj][n][e] = 0.f;
        }
        f32x4 gn0 = {1.f, 1.f, 1.f, 1.f}, gn1 = gn0;
        if (MODE == 1) {
#pragma unroll
            for (int ai = 0; ai < 2; ++ai)
#pragma unroll
                for (int m = 0; m < 4; ++m)
#pragma unroll
                    for (int bj = 0; bj < 2; ++bj) { const f32x4 a = acc[ai][bj][m][0], b = acc[ai][bj][m][1];
                        float sq = (a[0] * a[0] + a[1] * a[1]) + (a[2] * a[2] + a[3] * a[3]) + (b[0] * b[0] + b[1] * b[1]) + (b[2] * b[2] + b[3] * b[3]);
                        sq = xrow16_sum(sq);
                        if (fq == 0) part[(ai * HALF + wr * 64 + m * 16 + fr) * 8 + bj * 4 + wc] = sq; }
            asm volatile("s_waitcnt lgkmcnt(0)" ::: "memory"); __builtin_amdgcn_s_barrier(); asm volatile("" ::: "memory");
            const float* gp = (u.pn < 8 ? qg : kg) + wc * 32 + 8 * fq; gn0 = *(const f32x4*)gp; gn1 = *(const f32x4*)(gp + 4);
        }
#pragma unroll
        for (int ai = 0; ai < 2; ++ai)
#pragma unroll
            for (int m = 0; m < 4; ++m) { const int row = row0 + ai * HALF + m * 16; bf16_t* rowp = O + (size_t)row * ldc + col0;
#pragma unroll
                for (int bj = 0; bj < 2; ++bj) { f32x4 v0 = acc[ai][bj][m][0], v1 = acc[ai][bj][m][1];
                    bf16_t* dst = rowp + bj * HALF;
                    if (MODE == 1) dst = O + ((size_t)((2 * u.pn + bj) * 8 + 2 * wc + (fq >> 1)) * ldc + row) * 16 + 8 * (fq & 1);
                    if (MODE == 3) { const int tok = col0 + bj * HALF; dst = O + ((size_t)((row >> 5) * (ldc >> 4) + (tok >> 4)) * 32 + (row & 31)) * 16 + (tok & 8); }
                    if (MODE == 2) { const int tok = col0 + bj * HALF; dst = O + ((size_t)((row >> 7) * (ldc >> 3) + (tok >> 3)) * 128 + (row & 127)) * 8; }
                    if (ACT == 1) {
#pragma unroll
                        for (int e = 0; e < 4; ++e) { v0[e] = gelu_tanh(v0[e]); v1[e] = gelu_tanh(v1[e]); } }
                    if (STATS) {
#pragma unroll
                        for (int e = 0; e < 4; ++e) { ss[bj][0][e] += v0[e] * v0[e]; ss[bj][1][e] += v1[e] * v1[e]; } }
                    if (MODE == 1) { const f32x4 p4 = *(const PG8_LAS f32x4*)(part + (ai * HALF + wr * 64 + m * 16 + fr) * 8 + bj * 4);
                        const float rsd = 1.0f / sqrtf(((p4[0] + p4[1]) + (p4[2] + p4[3])) * (1.0f / 128.0f) + 1e-6f); v0 = v0 * rsd * gn0; v1 = v1 * rsd * gn1; }
                    u32x4 w; w.x = cvt_pk_bf16(v0[0], v0[1]); w.y = cvt_pk_bf16(v0[2], v0[3]); w.z = cvt_pk_bf16(v1[0], v1[1]); w.w = cvt_pk_bf16(v1[2], v1[3]);
                    *(u32x4*)dst = w; } }
        if (STATS) {
#pragma unroll
            for (int bj = 0; bj < 2; ++bj)
#pragma unroll
                for (int n = 0; n < 2; ++n)
#pragma unroll
                    for (int e = 0; e < 4; ++e) { ss[bj][n][e] = row16_sum(ss[bj][n][e]); }
            if (fr == 0) {
                float* pp = P + (size_t)(2 * u.pm + wr) * ldc + col0;
#pragma unroll
                for (int bj = 0; bj < 2; ++bj) { *(f32x4*)(pp + bj * HALF) = (f32x4){ss[bj][0][0], ss[bj][0][1], ss[bj][0][2], ss[bj][0][3]};
                                                 *(f32x4*)(pp + bj * HALF + 4) = (f32x4){ss[bj][1][0], ss[bj][1][1], ss[bj][1][2], ss[bj][1][3]}; }
            }
        }
    }
};

__device__ __forceinline__ void bf8_to_f32(const u32x4 r, f32x4& lo, f32x4& hi) {
    lo = (f32x4){__uint_as_float(r.x << 16), __uint_as_float(r.x & 0xffff0000u), __uint_as_float(r.y << 16), __uint_as_float(r.y & 0xffff0000u)};
    hi = (f32x4){__uint_as_float(r.z << 16), __uint_as_float(r.z & 0xffff0000u), __uint_as_float(r.w << 16), __uint_as_float(r.w & 0xffff0000u)};
}
template <bool IN32, bool OUT32> struct EpiResT {
    static constexpr bool PERM = true, AFTER_DRAIN = false, PERM_A = false, PROBE_TWICE = false, NT_B = (MK_NT_B & 2) != 0;
    const void* xin_lat; const void* xin_ctx; void* xout_lat; void* xout_ctx; const float* gate; float* slab;
    __device__ __forceinline__ void operator()(const f32x4 (&acc)[2][2][4][2], const Unit& u, int wr, int wc, int fr, int fq) const {
        const int col0 = u.pn * BM + wc * 32 + 8 * fq;
        if (u.ks >= 0) {
            float* sp = slab + ((size_t)u.ks * 512 + (u.pm - 64) * BM + wr * 64 + fr) * 2048 + col0;
#pragma unroll
            for (int ai = 0; ai < 2; ++ai)
#pragma unroll
                for (int m = 0; m < 4; ++m)
#pragma unroll
                    for (int bj = 0; bj < 2; ++bj)
#pragma unroll
                        for (int n = 0; n < 2; ++n) *(f32x4*)(sp + (size_t)(ai * HALF + m * 16) * 2048 + bj * HALF + 4 * n) = acc[ai][bj][m][n];
            return;
        }
        const int pm = u.pm; const int ci = pm < 32 ? 0 : (pm < 64 ? 1 : 2);
        const size_t pbase = (size_t)(pm < 64 ? pm : pm - 64) * BM * 2048 + (size_t)(wr * 64 + fr) * 2048 + col0;
        const char* xi = (const char*)(pm < 64 ? xin_lat : xin_ctx) + pbase * (IN32 ? 4 : 2);
        char* xo = (char*)(pm < 64 ? xout_lat : xout_ctx) + pbase * (OUT32 ? 4 : 2);
        f32x4 g4[2][2];
#pragma unroll
        for (int bj = 0; bj < 2; ++bj)
#pragma unroll
            for (int n = 0; n < 2; ++n) g4[bj][n] = *(const f32x4*)(gate + (size_t)ci * 12288 + col0 + bj * HALF + 4 * n);
        if constexpr (!IN32 && MK_RES_ALLLOADS) {
            u32x4 xq[2][4][2];
#pragma unroll
            for (int ai = 0; ai < 2; ++ai)
#pragma unroll
                for (int m = 0; m < 4; ++m)
#pragma unroll
                    for (int bj = 0; bj < 2; ++bj) xq[ai][m][bj] = __builtin_nontemporal_load((const u32x4*)(xi + ((size_t)(ai * HALF + m * 16) * 2048 + bj * HALF) * 2));
#pragma unroll
            for (int ai = 0; ai < 2; ++ai)
#pragma unroll
                for (int m = 0; m < 4; ++m) { const size_t off = (size_t)(ai * HALF + m * 16) * 2048;
#pragma unroll
                    for (int bj = 0; bj < 2; ++bj) {
                        f32x4 a0, a1; bf8_to_f32(xq[ai][m][bj], a0, a1);
                        const f32x4 r0 = a0 + g4[bj][0] * acc[ai][bj][m][0], r1 = a1 + g4[bj][1] * acc[ai][bj][m][1];
                        if (OUT32) { *(f32x4*)(xo + (off + bj * HALF) * 4) = r0; *(f32x4*)(xo + (off + bj * HALF + 4) * 4) = r1; }
                        else { u32x4 w; w.x = cvt_pk_bf16(r0[0], r0[1]); w.y = cvt_pk_bf16(r0[2], r0[3]); w.z = cvt_pk_bf16(r1[0], r1[1]); w.w = cvt_pk_bf16(r1[2], r1[3]); *(u32x4*)(xo + (off + bj * HALF) * 2) = w; } } }
            return;
        }
#pragma unroll
        for (int ai = 0; ai < 2; ++ai) {
            f32x4 xv[4][2][2]; u32x4 xr[4][2];
#pragma unroll
            for (int m = 0; m < 4; ++m) { const size_t off = (size_t)(ai * HALF + m * 16) * 2048;
#pragma unroll
                for (int bj = 0; bj < 2; ++bj) {
                    if (IN32) { xv[m][bj][0] = __builtin_nontemporal_load((const f32x4*)(xi + (off + bj * HALF) * 4)); xv[m][bj][1] = __builtin_nontemporal_load((const f32x4*)(xi + (off + bj * HALF + 4) * 4)); }
                    else xr[m][bj] = __builtin_nontemporal_load((const u32x4*)(xi + (off + bj * HALF) * 2)); } }
#pragma unroll
            for (int m = 0; m < 4; ++m) { const size_t off = (size_t)(ai * HALF + m * 16) * 2048;
#pragma unroll
                for (int bj = 0; bj < 2; ++bj) {
                    f32x4 a0, a1; if (IN32) { a0 = xv[m][bj][0]; a1 = xv[m][bj][1]; } else bf8_to_f32(xr[m][bj], a0, a1);
                    const f32x4 r0 = a0 + g4[bj][0] * acc[ai][bj][m][0], r1 = a1 + g4[bj][1] * acc[ai][bj][m][1];
                    if (OUT32) { *(f32x4*)(xo + (off + bj * HALF) * 4) = r0; *(f32x4*)(xo + (off + bj * HALF + 4) * 4) = r1; }
                    else { u32x4 w; w.x = cvt_pk_bf16(r0[0], r0[1]); w.y = cvt_pk_bf16(r0[2], r0[3]); w.z = cvt_pk_bf16(r1[0], r1[1]); w.w = cvt_pk_bf16(r1[2], r1[3]); *(u32x4*)(xo + (off + bj * HALF) * 2) = w; } } }
        }
    }
};

template <int CTRL> __device__ __forceinline__ float dpp_upd(float old, float src) {
    return __builtin_bit_cast(float, __builtin_amdgcn_update_dpp(__builtin_bit_cast(int, old), __builtin_bit_cast(int, src), CTRL, 0xf, 0xf, false)); }
struct EpiAct {
    static constexpr bool PERM = true, AFTER_DRAIN = false, PERM_A = true, PROBE_TWICE = (MK_EPI_PROBE == 1), NT_B = (MK_NT_B & 1) != 0;
    bf16_t* A; const float* cw; const float* cb; int rows; PG8_LAS float* halo; int ld;
    __device__ __forceinline__ void operator()(const f32x4 (&acc)[2][2][4][2], const Unit& u, int wr, int wc, int fr, int fq) const {
        typedef unsigned u32x2 __attribute__((ext_vector_type(2)));
        const int cl = wc * 32 + 8 * fq;
        if (fr == 0) {
#pragma unroll
            for (int ai = 0; ai < 2; ++ai)
#pragma unroll
                for (int bj = 0; bj < 2; ++bj)
#pragma unroll
                    for (int n = 0; n < 2; ++n) *(PG8_LAS f32x4*)(halo + ((2 * ai + wr) * 2 + 0) * 256 + bj * HALF + cl + 4 * n) = acc[ai][bj][0][n];
        }
        if (fr == 15) {
#pragma unroll
            for (int ai = 0; ai < 2; ++ai)
#pragma unroll
                for (int bj = 0; bj < 2; ++bj)
#pragma unroll
                    for (int n = 0; n < 2; ++n) *(PG8_LAS f32x4*)(halo + ((2 * ai + wr) * 2 + 1) * 256 + bj * HALF + cl + 4 * n) = acc[ai][bj][3][n];
        }
        asm volatile("s_waitcnt lgkmcnt(0)" ::: "memory"); __builtin_amdgcn_s_barrier(); asm volatile("" ::: "memory");
        unsigned pmask = 0u, nmask = 0u, omask = 0u;
#pragma unroll
        for (int ai = 0; ai < 2; ++ai)
#pragma unroll
            for (int m = 0; m < 4; ++m) { const int t = ai * HALF + wr * 64 + 4 * fr + m, g = u.pm * 254 - 1 + t; const unsigned bit = 1u << (ai * 4 + m);
                const int pos = g < 16384 ? (g & 8191) : ((g - 16384) & 255); const int last = g < 16384 ? 8191 : 255;
                if (pos != 0) pmask |= bit; if (pos != last) nmask |= bit; if (t >= 1 && t <= 254 && g >= 0 && g < rows) omask |= bit; }
#pragma unroll
        for (int n = 0; n < 2; ++n) {
            const int f = HALF * u.pn + cl + 4 * n;
            const f32x4 wg0 = *(const f32x4*)(cw + f), wg1 = *(const f32x4*)(cw + 11008 + f), wg2 = *(const f32x4*)(cw + 22016 + f), bg = *(const f32x4*)(cb + f);
            const f32x4 wu0 = *(const f32x4*)(cw + 5504 + f), wu1 = *(const f32x4*)(cw + 11008 + 5504 + f), wu2 = *(const f32x4*)(cw + 22016 + 5504 + f), bu = *(const f32x4*)(cb + 5504 + f);
#pragma unroll
            for (int ai = 0; ai < 2; ++ai) {
                const int seg = 2 * ai + wr, sp = seg > 0 ? seg - 1 : 0, sn = seg < 3 ? seg + 1 : 3;
                const f32x4 hpg = *(const PG8_LAS f32x4*)(halo + (sp * 2 + 1) * 256 + cl + 4 * n), hpu = *(const PG8_LAS f32x4*)(halo + (sp * 2 + 1) * 256 + HALF + cl + 4 * n);
                const f32x4 hng = *(const PG8_LAS f32x4*)(halo + (sn * 2 + 0) * 256 + cl + 4 * n), hnu = *(const PG8_LAS f32x4*)(halo + (sn * 2 + 0) * 256 + HALF + cl + 4 * n);
#pragma unroll
                for (int m = 0; m < 4; ++m) {
                    const unsigned bit = 1u << (ai * 4 + m); const bool pok = (pmask & bit) != 0u, nok = (nmask & bit) != 0u;
                    float o[4];
#pragma unroll
                    for (int e = 0; e < 4; ++e) {
                        const float zg = acc[ai][0][m][n][e], zu = acc[ai][1][m][n][e];
                        const float pg = m > 0 ? acc[ai][0][m > 0 ? m - 1 : 0][n][e] : dpp_upd<0x111>(hpg[e], acc[ai][0][3][n][e]);
                        const float pu = m > 0 ? acc[ai][1][m > 0 ? m - 1 : 0][n][e] : dpp_upd<0x111>(hpu[e], acc[ai][1][3][n][e]);
                        const float ng = m < 3 ? acc[ai][0][m < 3 ? m + 1 : 3][n][e] : dpp_upd<0x101>(hng[e], acc[ai][0][0][n][e]);
                        const float nu = m < 3 ? acc[ai][1][m < 3 ? m + 1 : 3][n][e] : dpp_upd<0x101>(hnu[e], acc[ai][1][0][n][e]);
                        float yg = wg1[e] * zg + bg[e], yu = wu1[e] * zu + bu[e];
                        yg += pok ? wg0[e] * pg : 0.f; yu += pok ? wu0[e] * pu : 0.f;
                        yg += nok ? wg2[e] * ng : 0.f; yu += nok ? wu2[e] * nu : 0.f;
                        o[e] = silu_f(yg) * yu;
                    }
                    if (omask & bit) { const int g = u.pm * 254 - 1 + ai * HALF + wr * 64 + 4 * fr + m;
                        *(u32x2*)(A + (size_t)g * ld + f) = (u32x2){cvt_pk_bf16(o[0], o[1]), cvt_pk_bf16(o[2], o[3])}; }
                }
            }
        }
    }
};

template <int M0, bool A0, bool S0, int M1, bool A1, bool S1> struct EpiDualT {
    static constexpr bool PERM = true, AFTER_DRAIN = false, PERM_A = false, PROBE_TWICE = (MK_EPI_PROBE == 3), NT_B = false;
    EpiBf16T<M0, A0, S0> e0; EpiBf16T<M1, A1, S1> e1;
    __device__ __forceinline__ void operator()(const f32x4 (&acc)[2][2][4][2], const Unit& u, int wr, int wc, int fr_, int fq_) const {
        int fr = fr_, fq = fq_; asm volatile("" : "+v"(fr), "+v"(fq));
        if (u.which == 0) e0(acc, u, wr, wc, fr, fq); else e1(acc, u, wr, wc, fr, fq); }
};

struct EpiDual {
    static constexpr bool PERM = true, AFTER_DRAIN = false, PERM_A = false, PROBE_TWICE = (MK_EPI_PROBE == 3), NT_B = false;
    EpiBf16R e0, e1;
    __device__ __forceinline__ void operator()(const f32x4 (&acc)[2][2][4][2], const Unit& u, int wr, int wc, int fr, int fq) const {
        EpiBf16R e;
        const bool w = u.which != 0;
        e.O = w ? e1.O : e0.O; e.ldc = w ? e1.ldc : e0.ldc; e.P = w ? e1.P : e0.P; e.ACT = w ? e1.ACT : e0.ACT; e.STATS = w ? e1.STATS : e0.STATS; e.MODE = w ? e1.MODE : e0.MODE;
        e.part = e0.part; e.qg = e0.qg; e.kg = e0.kg;
        e(acc, u, wr, wc, fr, fq); }
};
template <class Epi, class Sched, bool ALIGN_EPI = false, bool SP2 = false>
__device__ __forceinline__ void gemm_phase(PG8_LAS unsigned char* lds, const Gemm g, const Sched& S, const Epi& E, const int wave_idx) {
    int tid_ = wave_idx * 64 + (int)__builtin_amdgcn_mbcnt_hi(~0u, __builtin_amdgcn_mbcnt_lo(~0u, 0u)); asm volatile("" : "+v"(tid_)); const int tid = tid_, wid = __builtin_amdgcn_readfirstlane(tid >> 6), lane = tid & 63, wr = wid >> 2, wc = wid & 3, fr = lane & 15, fq = lane >> 4;
    const int K = g.K, nt = K / BK, LD = g.ldk ? g.ldk : g.K;
#if MK_TPROBE
    const bool tp_ = (wid == 0) && (__builtin_amdgcn_readfirstlane(*(volatile PG8_LAS unsigned*)(lds + 131792)) != 0u);
#define PG8_TPS(k) do { const unsigned t__ = (unsigned)__builtin_amdgcn_s_memrealtime(); *(volatile PG8_LAS unsigned*)(lds + 131808 + 4 * (k)) = t__; *(volatile PG8_LAS unsigned*)(lds + 131808 + 64 + 4 * (k)) = (unsigned)__builtin_readcyclecounter(); } while (0)
#endif
    unsigned voffA[2], voffB[2];
#pragma unroll
    for (int i = 0; i < 2; ++i) { int R, C; stage_rc(tid * 16 + i * 8192, R, C); const int Rb = Epi::PERM ? ((R & ~31) + perm32(R & 31)) : R;
        const int Ra = Epi::PERM_A ? ((R & ~63) + 4 * (R & 15) + ((R & 63) >> 4)) : R;
        voffA[i] = (unsigned)(Ra * LD + C) * 2u; voffB[i] = (unsigned)(Rb * LD + C) * 2u; }
    const size_t kstep = (size_t)(BK * 2);
    const size_t hstep = (size_t)HALF * LD * 2;
    const size_t tstep = 2 * hstep; const size_t tstepA = (size_t)g.panel_rows * LD * 2;
    const unsigned ldsw = (unsigned)wid * 1024u;
    const int aoff = lds_byte(wr * 64 + fr, fq * 8), boff = lds_byte(wc * 32 + fr, fq * 8);
#define PG8_SA(b, h) (((b) * 2 + (h)) * HTB)
#define PG8_SB(b, h) ((4 + (b) * 2 + (h)) * HTB)
#define PG8_STAGE_(bufoff, gbase, voff, aux) do { _Pragma("unroll") for (int _i = 0; _i < 2; ++_i) \
        __builtin_amdgcn_global_load_lds((const unsigned*)((const char*)(gbase) + (voff)[_i]), (PG8_LAS unsigned*)(lds + (bufoff) + ldsw + _i * 8192), 16, 0, aux); } while (0)
#define PG8_STAGE(bufoff, gbase, voff) PG8_STAGE_(bufoff, gbase, voff, 0)
#define PG8_STAGEB(bufoff, gbase, voff) do { if (Epi::NT_B) PG8_STAGE_(bufoff, gbase, voff, 2); else PG8_STAGE_(bufoff, gbase, voff, 0); } while (0)
#define PG8_LDA(dst, b, h) do { _Pragma("unroll") for (int m = 0; m < 4; ++m) _Pragma("unroll") for (int k = 0; k < 2; ++k) dst[m][k] = *(const PG8_LAS bf16x8*)(lds + PG8_SA(b, h) + aoff + m * 2048 + k * 1024); } while (0)
#define PG8_LDB(dst, b, h) do { _Pragma("unroll") for (int n = 0; n < 2; ++n) _Pragma("unroll") for (int k = 0; k < 2; ++k) dst[n][k] = *(const PG8_LAS bf16x8*)(lds + PG8_SB(b, h) + boff + n * 2048 + k * 1024); } while (0)
#define PG8_MMA(ai, bj, At, Bt) do { __builtin_amdgcn_s_setprio(1); _Pragma("unroll") for (int m = 0; m < 4; ++m) _Pragma("unroll") for (int n = 0; n < 2; ++n) _Pragma("unroll") for (int k = 0; k < 2; ++k) \
        acc[ai][bj][m][n] = __builtin_amdgcn_mfma_f32_16x16x32_bf16(Bt[n][k], At[m][k], acc[ai][bj][m][n], 0, 0, 0); __builtin_amdgcn_s_setprio(0); } while (0)
#define PG8_WAIT_V(n) asm volatile("s_waitcnt vmcnt(" #n ")" ::: "memory")
#define PG8_WAIT_L(n) asm volatile("s_waitcnt lgkmcnt(" #n ")" ::: "memory")
#define PG8_BAR __builtin_amdgcn_s_barrier()
#define PG8_SCHED __builtin_amdgcn_sched_barrier(0)
    Unit cur, nxt; int ui = 0;
    if (!S.next(0, cur)) return;
    f32x4 acc[2][2][4][2];
#pragma unroll
    for (int a = 0; a < 2; ++a)
#pragma unroll
        for (int b = 0; b < 2; ++b)
#pragma unroll
            for (int m = 0; m < 4; ++m)
#pragma unroll
                for (int n = 0; n < 2; ++n) acc[a][b][m][n] = (f32x4){0.f, 0.f, 0.f, 0.f};
    bf16x8 At[4][2], B0[2][2], B1[2][2];
    const char* cA = (const char*)(cur.which ? g.A2 : g.A) + (size_t)cur.pm * tstepA + (size_t)cur.kt0 * kstep; const char* cB = (const char*)(cur.which ? g.Bt2 : g.Bt) + (size_t)cur.pn * tstep + (size_t)cur.kt0 * kstep;
    S.a_ready(cur);
    if constexpr (SP2) {
        PG8_STAGEB(PG8_SB(0, 0), cB, voffB); PG8_STAGEB(PG8_SB(0, 1), cB + hstep, voffB); PG8_STAGE(PG8_SA(0, 0), cA, voffA); PG8_STAGE(PG8_SA(0, 1), cA + hstep, voffA);
        if (wr == 1) PG8_BAR;
        PG8_WAIT_V(2); PG8_BAR;
        PG8_STAGEB(PG8_SB(1, 0), cB + kstep, voffB); PG8_STAGE(PG8_SA(1, 0), cA + kstep, voffA); PG8_STAGEB(PG8_SB(1, 1), cB + hstep + kstep, voffB);
        PG8_WAIT_V(6); PG8_BAR;
    } else {
        PG8_STAGEB(PG8_SB(0, 0), cB, voffB); PG8_STAGE(PG8_SA(0, 0), cA, voffA); PG8_STAGEB(PG8_SB(0, 1), cB + hstep, voffB); PG8_STAGE(PG8_SA(0, 1), cA + hstep, voffA);
        if (wr == 1) PG8_BAR;
        PG8_WAIT_V(4); PG8_BAR;
        PG8_STAGEB(PG8_SB(1, 0), cB + kstep, voffB); PG8_STAGE(PG8_SA(1, 0), cA + kstep, voffA); PG8_STAGEB(PG8_SB(1, 1), cB + hstep + kstep, voffB);
        PG8_WAIT_V(6); PG8_BAR;
    }
    for (;;) {
        const bool has_next = S.next(ui + 1, nxt);
        const char* nA = has_next ? (const char*)(nxt.which ? g.A2 : g.A) + (size_t)nxt.pm * tstepA + (size_t)nxt.kt0 * kstep : cA; const char* nB = has_next ? (const char*)(nxt.which ? g.Bt2 : g.Bt) + (size_t)nxt.pn * tstep + (size_t)nxt.kt0 * kstep : cB;
        const int ntc = cur.ktn ? cur.ktn : nt;
        for (int t = 0; t < ntc; t += 2) {
            const bool last = (t == ntc - 2);
#if MK_TPROBE
            if (tp_) { if (ui == MK_TPROBE_UI && last) PG8_TPS(0); if (ui == MK_TPROBE_UI + 1) { if (t == MK_TPROBE_TA) PG8_TPS(4); if (t == MK_TPROBE_TB) PG8_TPS(5); if (t == MK_TPROBE_TC) PG8_TPS(6); } }
#endif
            const char* a1 = cA + (size_t)(t + 1) * kstep;
            const char* a2 = last ? nA : cA + (size_t)(t + 2) * kstep; const char* b2 = last ? nB : cB + (size_t)(t + 2) * kstep;
            const char* a3 = a2 + kstep; const char* b3 = b2 + kstep;
            if (last && has_next) S.a_ready(nxt);
            if constexpr (SP2) {
            PG8_LDB(B0, 0, 0); PG8_LDB(B1, 0, 1); PG8_SCHED; PG8_LDA(At, 0, 0); PG8_STAGE(PG8_SA(1, 1), a1 + hstep, voffA);
            PG8_WAIT_V(8); PG8_WAIT_L(0); PG8_BAR; PG8_MMA(0, 0, At, B0); PG8_MMA(0, 1, At, B1); PG8_BAR; PG8_SCHED;
            PG8_LDA(At, 0, 1); PG8_STAGEB(PG8_SB(0, 0), b2, voffB); PG8_STAGEB(PG8_SB(0, 1), b2 + hstep, voffB); PG8_STAGE(PG8_SA(0, 0), a2, voffA);
            PG8_WAIT_V(8); PG8_WAIT_L(0); PG8_BAR; PG8_MMA(1, 0, At, B0); PG8_MMA(1, 1, At, B1); PG8_BAR; PG8_SCHED;
            PG8_LDB(B0, 1, 0); PG8_LDB(B1, 1, 1); PG8_SCHED; PG8_LDA(At, 1, 0); PG8_STAGE(PG8_SA(0, 1), a2 + hstep, voffA);
            PG8_WAIT_V(8); PG8_WAIT_L(0); PG8_BAR; PG8_MMA(0, 0, At, B0); PG8_MMA(0, 1, At, B1); PG8_BAR; PG8_SCHED;
            PG8_LDA(At, 1, 1); PG8_STAGEB(PG8_SB(1, 0), b3, voffB); PG8_STAGEB(PG8_SB(1, 1), b3 + hstep, voffB); PG8_STAGE(PG8_SA(1, 0), a3, voffA);
            PG8_WAIT_V(8); PG8_WAIT_L(0); PG8_BAR; PG8_MMA(1, 0, At, B0); PG8_MMA(1, 1, At, B1); PG8_BAR; PG8_SCHED;
            } else {
            PG8_LDB(B0, 0, 0); PG8_SCHED; PG8_LDA(At, 0, 0); PG8_STAGE(PG8_SA(1, 1), a1 + hstep, voffA);
            PG8_WAIT_L(8); PG8_BAR; PG8_WAIT_L(0); PG8_MMA(0, 0, At, B0); PG8_BAR; PG8_SCHED;
            PG8_LDB(B1, 0, 1); PG8_STAGEB(PG8_SB(0, 0), b2, voffB);
            PG8_BAR; PG8_WAIT_L(0); PG8_MMA(0, 1, At, B1); PG8_BAR;
            PG8_LDA(At, 0, 1); PG8_STAGE(PG8_SA(0, 0), a2, voffA);
            PG8_BAR; PG8_WAIT_L(0); PG8_MMA(1, 0, At, B0); PG8_BAR; PG8_SCHED;
            PG8_STAGEB(PG8_SB(0, 1), b2 + hstep, voffB);
            PG8_WAIT_V(6); PG8_BAR; PG8_MMA(1, 1, At, B1); PG8_BAR;
            PG8_LDB(B0, 1, 0); PG8_SCHED; PG8_LDA(At, 1, 0); PG8_STAGE(PG8_SA(0, 1), a2 + hstep, voffA);
            PG8_WAIT_L(8); PG8_BAR; PG8_WAIT_L(0); PG8_MMA(0, 0, At, B0); PG8_BAR; PG8_SCHED;
            PG8_LDB(B1, 1, 1); PG8_STAGEB(PG8_SB(1, 0), b3, voffB);
            PG8_BAR; PG8_WAIT_L(0); PG8_MMA(0, 1, At, B1); PG8_BAR;
            PG8_LDA(At, 1, 1); PG8_STAGE(PG8_SA(1, 0), a3, voffA);
            PG8_BAR; PG8_WAIT_L(0); PG8_MMA(1, 0, At, B0); PG8_BAR; PG8_SCHED;
            PG8_STAGEB(PG8_SB(1, 1), b3 + hstep, voffB);
            PG8_WAIT_V(6); PG8_BAR; PG8_MMA(1, 1, At, B1); PG8_BAR;
            }
        }
#if MK_TPROBE
        if (tp_ && ui == MK_TPROBE_UI) PG8_TPS(1);
#endif
        if constexpr (ALIGN_EPI) { if (wr == 0) PG8_BAR; }
#if MK_TPROBE
        if (tp_ && ui == MK_TPROBE_UI) PG8_TPS(2);
#endif
        if constexpr (!Epi::AFTER_DRAIN) { E(acc, cur, wr, wc, fr, fq); if constexpr (Epi::PROBE_TWICE) { asm volatile("" ::: "memory"); E(acc, cur, wr, wc, fr, fq); } S.done(cur); }
#if MK_TPROBE
        if (tp_ && ui == MK_TPROBE_UI) PG8_TPS(3);
        if (tp_ && ui == MK_TPROBE_UI + 1) PG8_TPS(7);
#endif
        if (!has_next) break;
#pragma unroll
        for (int a = 0; a < 2; ++a)
#pragma unroll
            for (int b = 0; b < 2; ++b)
#pragma unroll
                for (int m = 0; m < 4; ++m)
#pragma unroll
                    for (int n = 0; n < 2; ++n) acc[a][b][m][n] = (f32x4){0.f, 0.f, 0.f, 0.f};
        cur = nxt; cA = nA; cB = nB; ++ui;
        if constexpr (ALIGN_EPI) { if (wr == 1) PG8_BAR; }
    }
    PG8_WAIT_V(0);
    if constexpr (!ALIGN_EPI) { if (wr == 0) PG8_BAR; }
    PG8_BAR;
    if constexpr (Epi::AFTER_DRAIN) { E.fused(acc, cur, wr, wc, fr, fq, lds, wid, lane); S.done(cur); }
#undef PG8_SA
#undef PG8_SB
#undef PG8_STAGE
#undef PG8_STAGE_
#undef PG8_STAGEB
#undef PG8_LDA
#undef PG8_LDB
#undef PG8_MMA
#undef PG8_WAIT_V
#undef PG8_WAIT_L
#undef PG8_BAR
#undef PG8_SCHED
}
}

constexpr int NWAVES = 8;
constexpr int DM = 2048, NB = 2, SEQ = 8192, DEPTH = 4, CTXL = 256;
constexpr int ML = NB * SEQ;
constexpr int MC = NB * CTXL;
constexpr int MT = ML + MC;
constexpr int NH = 16, HD = 128, GRIDW = 64, GROWS = 128;
constexpr int GMW = 4096, GMG = 16, GMGD = 256, GMC = 128;
constexpr int FFN = 5504, FFN2 = 11008;
constexpr int FFN_LD = MK_FFN_LD;
constexpr float EPS = 1e-6f;
constexpr float LOG2E = 1.4426950408889634f;
constexpr int NMOD = 6 * DM;

enum { I_X = 0, I_C, I_CTX, I_CCTX, I_NMG, I_NFG, I_WADA, I_BADA, I_NAQKV, I_NAQG, I_NAKG, I_NARPB, I_NAWO, I_GMWIN, I_GMVG, I_GMWS, I_GMBS, I_GMWOUT,
       I_SCWIN, I_SCCW, I_SCWOUT, I_FUP, I_FCW, I_FCB, I_FDN, N_IN };

constexpr size_t MiB = 1u << 20;
constexpr size_t WS_CTL = 0, CTL_ZERO_BYTES = 1 * MiB;
constexpr size_t WS_MOD = 1 * MiB;
constexpr size_t WS_WQKV = 2 * MiB;
constexpr size_t WS_WO = 50 * MiB;
constexpr size_t WS_WGIN = 66 * MiB;
constexpr size_t WS_WGS = 98 * MiB;
constexpr size_t WS_WGOUT = 99 * MiB;
constexpr size_t WS_WCIN = 115 * MiB;
constexpr size_t WS_WCOUT = 139 * MiB;
constexpr size_t WS_WUP = 147 * MiB;
constexpr size_t WS_XA = 405 * MiB;
constexpr size_t WS_XB = 537 * MiB;
constexpr size_t WS_H = 669 * MiB + 4096;
constexpr size_t WS_ACT = 738 * MiB;
constexpr size_t WS_PST = 936 * MiB;
constexpr size_t WS_BIG = 939 * MiB;
constexpr size_t WS_SLAB = 1339 * MiB;
constexpr size_t WS_WDN = 1371 * MiB;
constexpr size_t WS_END = 1467 * MiB;
constexpr size_t BIG_QK = 0, BIG_VT = 132 * MiB, BIG_O = 198 * MiB;
constexpr size_t BIG_U = 0, BIG_GVT = 132 * MiB, BIG_G = 264 * MiB;
constexpr size_t BIG_BCX = 0, BIG_T = 198 * MiB;
constexpr size_t BIG_Z = 0;
constexpr int CW_TMO = 0, CW_BAR = 4096, CW_DIAG = 16384, CW_STAMP = 20480, CW_DYN = 32768;

constexpr int RING_OFF = 0, RING_BYTES = 131072;
constexpr int LDSCTL_OFF = RING_BYTES, MISC_OFF = LDSCTL_OFF + 320, HALO_OFF = LDSCTL_OFF + 1024;
constexpr int LDS_BYTES = 147456;

#define GAS __attribute__((address_space(1)))
#define LAS __attribute__((address_space(3)))
typedef unsigned short bf16;
typedef unsigned v4u __attribute__((ext_vector_type(4)));
typedef unsigned v2u __attribute__((ext_vector_type(2)));
typedef float f32x4 __attribute__((ext_vector_type(4)));
typedef float f32x16 __attribute__((ext_vector_type(16)));
typedef short bf16x8 __attribute__((ext_vector_type(8)));
typedef short s16x4 __attribute__((ext_vector_type(4)));
typedef GAS unsigned gu32;
#define RLX_AGENT __ATOMIC_RELAXED, __HIP_MEMORY_SCOPE_AGENT
#define LDS_WAIT() asm volatile("s_waitcnt lgkmcnt(0)" ::: "memory")
__device__ __forceinline__ unsigned pk2(float lo, float hi) { return pg8::cvt_pk_bf16(lo, hi); }
__device__ __forceinline__ float bf2f(bf16 b) { return __uint_as_float(((unsigned)b) << 16); }
__device__ __forceinline__ float bflo(unsigned w) { return __uint_as_float(w << 16); }
__device__ __forceinline__ float bfhi(unsigned w) { return __uint_as_float(w & 0xffff0000u); }
__device__ __forceinline__ float wave_sum(float v) { return pg8::xrow16_sum(pg8::row16_sum(v)); }
__device__ __forceinline__ float swap32_max(float m) { auto rr = __builtin_amdgcn_permlane32_swap(__float_as_uint(m), __float_as_uint(m), false, false); return __builtin_fmaxf(__uint_as_float(rr[0]), __uint_as_float(rr[1])); }
__device__ __forceinline__ float swap32_sum(float m) { auto rr = __builtin_amdgcn_permlane32_swap(__float_as_uint(m), __float_as_uint(m), false, false); return __uint_as_float(rr[0]) + __uint_as_float(rr[1]); }
#define MFMA32(a, b, c) __builtin_amdgcn_mfma_f32_32x32x16_bf16((a), (b), (c), 0, 0, 0)

#define XB_TMO      128
#define XB_XCNT(j)  (256  + 64 * (j))
#define XB_XSUB(j)  (1280 + 64 * (j))
#define XB_XGEN(j)  (2304 + 64 * (j))
#define XB_TOP      3328
#define XB_TOPGEN   3392
#define XCD_BAR_WORDS 3456
#define XB_SPIN_CAP (1u << 18)

__device__ __forceinline__ unsigned xb_ld(unsigned* p)              { return __hip_atomic_load(p, __ATOMIC_RELAXED, __HIP_MEMORY_SCOPE_AGENT); }
__device__ __forceinline__ unsigned xb_add(unsigned* p, unsigned v) { return __hip_atomic_fetch_add(p, v, __ATOMIC_RELAXED, __HIP_MEMORY_SCOPE_AGENT); }
__device__ __forceinline__ unsigned xb_xcc_id() { return (unsigned)__builtin_amdgcn_s_getreg((3 << 11) | 20) & 0xFu; }
#define XB_SPIN(cond, bar) do { unsigned _sp = 0; while (cond) { __builtin_amdgcn_s_sleep(1); \
    if ((++_sp & 255u) == 0u) { if (xb_ld(&(bar)[XB_TMO])) break; if (_sp > XB_SPIN_CAP) { atomicAdd(&(bar)[XB_TMO], 1u); break; } } } } while (0)

struct XcdBarrier {
    unsigned* bar; unsigned x;
    volatile LAS unsigned* st;
};

__device__ __forceinline__ XcdBarrier xcd_barrier_post(unsigned* bar, volatile LAS unsigned* st) {
    XcdBarrier b; b.bar = bar; b.x = xb_xcc_id(); b.st = st;
    if (threadIdx.x == 0) (void)xb_add(&bar[XB_XCNT(b.x)], 1u);
    return b;
}
__device__ __forceinline__ void xcd_barrier_complete(unsigned* bar, unsigned x, unsigned& nloc, unsigned& nx) {
    const unsigned G = gridDim.x * gridDim.y * gridDim.z;
    unsigned sum, cnt, mine, sp = 0u;
    for (;;) {
        sum = 0u; cnt = 0u; mine = 0u;
#pragma unroll
        for (unsigned j = 0; j < 16; ++j) { const unsigned c = xb_ld(&bar[XB_XCNT(j)]); sum += c; cnt += (c > 0u) ? 1u : 0u; mine = (j == x) ? c : mine; }
        if (sum == G) break;
        __builtin_amdgcn_s_sleep(1);
        if ((++sp & 255u) == 0u) { if (xb_ld(&bar[XB_TMO])) break; if (sp > XB_SPIN_CAP) { atomicAdd(&bar[XB_TMO], 1u); break; } }
    }
    nloc = mine > 0u ? mine : 1u; nx = cnt > 0u ? cnt : 1u;
}

__device__ __forceinline__ void xcd_barrier(const XcdBarrier& b) {
    asm volatile("s_waitcnt vmcnt(0)" ::: "memory");
    __syncthreads();
    if (threadIdx.x == 0) {
        unsigned* bar = b.bar;
        __builtin_amdgcn_s_waitcnt(0);
        unsigned nloc = b.st[0], nx = b.st[1];
        if (nloc == 0u) { xcd_barrier_complete(bar, b.x, nloc, nx); b.st[0] = nloc; b.st[1] = nx; }
        const unsigned old = xb_add(&bar[XB_XSUB(b.x)], 1u);
        const unsigned gen = old / nloc;
        if (old + 1u == (gen + 1u) * nloc) {
            __builtin_amdgcn_fence(__ATOMIC_RELEASE, "agent");
            asm volatile("s_waitcnt vmcnt(0)" ::: "memory");
            const unsigned og = xb_add(&bar[XB_TOP], 1u);
            const unsigned tg = og / nx;
            if (og + 1u == (tg + 1u) * nx) xb_add(&bar[XB_TOPGEN], 1u);
            else XB_SPIN(xb_ld(&bar[XB_TOPGEN]) == tg, bar);
            __builtin_amdgcn_fence(__ATOMIC_ACQUIRE, "agent");
            xb_add(&bar[XB_XGEN(b.x)], 1u);
            asm volatile("s_waitcnt vmcnt(0)" ::: "memory");
        } else {
            XB_SPIN(xb_ld(&bar[XB_XGEN(b.x)]) == gen, bar);
            __builtin_amdgcn_fence(__ATOMIC_ACQUIRE, "agent");
            asm volatile("s_waitcnt vmcnt(0)" ::: "memory");
        }
    }
    __syncthreads();
}

struct Frame {
    LAS unsigned char* lds;
    volatile LAS unsigned* MISC;
    gu32* ctl;
    int tid, lane, wave, vcu, G;
    unsigned char* ws;
};
__device__ __forceinline__ int cond_of_row(int r) { return r < SEQ ? 0 : (r < ML ? 1 : 2); }
__device__ __forceinline__ void unpack8(const v4u r, float (&x)[8]) { x[0] = bflo(r.x); x[1] = bfhi(r.x); x[2] = bflo(r.y); x[3] = bfhi(r.y); x[4] = bflo(r.z); x[5] = bfhi(r.z); x[6] = bflo(r.w); x[7] = bfhi(r.w); }

__device__ __forceinline__ int up_perm_row(int n0) {
    return n0 < FFN ? 256 * (n0 / 128) + (n0 % 128) : 256 * ((n0 - FFN) / 128) + 128 + ((n0 - FFN) % 128);
}
__device__ __forceinline__ void p0_transpose_item(const float* W, int K, int N, bf16* WT, bool perm, LAS unsigned* scr, int item, int lane, int ldw = 0) {
    if (ldw == 0) ldw = K;
    const int nblk = N / 64, kb = item / nblk, nb = item % nblk, k0 = 64 * kb, n0 = 64 * nb;
    const int r0 = perm ? up_perm_row(n0) : n0;
    const int rsub = lane >> 4, c4 = lane & 15;
    f32x4 va[8], vb[8];
    const float* src = W + (size_t)(k0 + 2 * rsub) * N + n0 + 4 * c4;
#pragma unroll
    for (int t = 0; t < 8; ++t) { va[t] = __builtin_nontemporal_load((const f32x4*)(src + (size_t)(8 * t) * N)); vb[t] = __builtin_nontemporal_load((const f32x4*)(src + (size_t)(8 * t + 1) * N)); }
#pragma unroll
    for (int t = 0; t < 8; ++t) { const int p = 4 * t + rsub;
#pragma unroll
        for (int e = 0; e < 4; ++e) scr[(4 * c4 + e) * 33 + p] = pk2(va[t][e], vb[t][e]); }
    LDS_WAIT(); asm volatile("" ::: "memory");
    const int r = lane >> 3, c = lane & 7;
#pragma unroll
    for (int j = 0; j < 8; ++j) { const int n = 8 * j + r; const LAS unsigned* sp = scr + n * 33 + 4 * c;
        v4u o; o.x = sp[0]; o.y = sp[1]; o.z = sp[2]; o.w = sp[3];
        *(GAS v4u*)(WT + (size_t)(r0 + n) * ldw + k0 + 8 * c) = o; }
    LDS_WAIT(); asm volatile("" ::: "memory");
}
__device__ __forceinline__ void p0_prologue(Frame& F, const float* c_in, const float* cctx_in, const float* w_ada, const float* b_ada,
                                            const float* na_qkv, const float* na_wo, const float* gm_win, const float* gm_ws, const float* gm_wout,
                                            const float* sc_win, const float* sc_wout, const float* f_up, const float* f_dn) {
    unsigned char* ws = F.ws;
    LAS float* sc = (LAS float*)(F.lds);
    LAS float* red = (LAS float*)(F.lds + 24576);
    __syncthreads();
    for (int i = F.tid; i < 3 * DM; i += NWAVES * 64) { const int ci = i / DM, k = i % DM; const float v = ci < 2 ? c_in[ci * DM + k] : cctx_in[k]; sc[i] = pg8::silu_f(v); }
    __syncthreads();
    float* mod = (float*)(ws + WS_MOD);
    for (int it = F.vcu; it < DEPTH * 192; it += F.G) {
        const int L = it / 192, nb = it % 192, cq = F.tid & 15, ks = F.tid >> 4;
        f32x4 a0 = {0.f, 0.f, 0.f, 0.f}, a1 = a0, a2 = a0;
        const float* wp = w_ada + ((size_t)L * DM + ks * 64) * NMOD + nb * 64 + cq * 4;
#pragma unroll 16
        for (int kk = 0; kk < 64; ++kk) { const f32x4 w = *(const GAS f32x4*)(wp + (size_t)kk * NMOD); const int k = ks * 64 + kk;
            a0 += w * sc[k]; a1 += w * sc[DM + k]; a2 += w * sc[2 * DM + k]; }
        *(LAS f32x4*)(red + (ks * 3 + 0) * 64 + cq * 4) = a0; *(LAS f32x4*)(red + (ks * 3 + 1) * 64 + cq * 4) = a1; *(LAS f32x4*)(red + (ks * 3 + 2) * 64 + cq * 4) = a2;
        __syncthreads();
        if (F.tid < 192) { const int ci = F.tid / 64, col = F.tid % 64; float s = 0.f;
#pragma unroll 8
            for (int q = 0; q < 32; ++q) s += red[(q * 3 + ci) * 64 + col];
            mod[((size_t)L * 3 + ci) * NMOD + nb * 64 + col] = s + b_ada[(size_t)L * NMOD + nb * 64 + col]; }
        __syncthreads();
    }
    { bf16* d = (bf16*)(ws + WS_WGS); const int gt = F.vcu * NWAVES * 64 + F.tid, NT = F.G * NWAVES * 64;
      for (int o = gt; o < GMG * GMC * GMC / 8; o += NT) { const int i = o & 31, h = (o >> 5) & 1, sx = (o >> 6) & 7, ib = (o >> 9) & 3, g = o >> 11;
          const float* src = gm_ws + ((size_t)g * GMC + 32 * ib + i) * GMC + 16 * sx + 8 * h; const f32x4 a = *(const f32x4*)src, b = *(const f32x4*)(src + 4);
          v4u w; w.x = pk2(a.x, a.y); w.y = pk2(a.z, a.w); w.z = pk2(b.x, b.y); w.w = pk2(b.z, b.w); *(GAS v4u*)(d + (size_t)o * 8) = w; } }
}

template <bool X32, bool FX32, bool RES32_>
__device__ __forceinline__ void norm_mod_phase(Frame& F, const void* xlat, const void* xctx, const float* gain, const float* shift0, const float* scale0, bf16* H, int nrows,
                                               const float* slab, int nsl, const void* fx_in, const float* fx_gate, void* fx_out) {
    const int gw = F.vcu * NWAVES + F.wave, NGW = F.G * NWAVES;
#if MK_NORM_REGMOD
    int mci = -1; f32x4 mA[4][2], mB[4][2]; bool have = false; v4u nraw[4];
#pragma unroll
    for (int j = 0; j < 4; ++j) { nraw[j] = (v4u){0u, 0u, 0u, 0u}; mA[j][0] = mA[j][1] = mB[j][0] = mB[j][1] = (f32x4){0.f, 0.f, 0.f, 0.f}; }
#endif
#if MK_NORM_CTXSPREAD
    const int nlat_ = nrows < ML ? nrows : ML; int kk_ = 0, tt_ = 0;
    for (;;) { int row;
        if (gw + kk_ * NGW < nlat_) { row = gw + kk_ * NGW; ++kk_; }
        else if (F.vcu + F.G * (F.wave + NWAVES * tt_) < nrows - ML) { row = ML + F.vcu + F.G * (F.wave + NWAVES * tt_); ++tt_; }
        else break;
#else
    for (int row = gw; row < nrows; row += NGW) {
#endif
        const int ci = cond_of_row(row);
#if MK_NORM_REGMOD
        int lnr_ = F.lane; asm volatile("" : "+v"(lnr_));
#else
        const int lnr_ = F.lane;
#endif
        const float* shp = shift0 + (size_t)ci * NMOD; const float* scp = scale0 + (size_t)ci * NMOD;
        if (slab != nullptr && row >= ML) {
            f32x4 v[8]; float s = 0.f;
            const f32x4* g4 = (const f32x4*)(fx_gate + 2 * (size_t)NMOD) + lnr_;
#pragma unroll
            for (int j = 0; j < 8; ++j) { f32x4 a = {0.f, 0.f, 0.f, 0.f};
                for (int q = 0; q < nsl; ++q) a += *((const GAS f32x4*)(slab + ((size_t)q * MC + (row - ML)) * DM) + lnr_ + 64 * j);
                f32x4 xin;
                if (FX32) xin = *((const GAS f32x4*)((const float*)fx_in + (size_t)(row - ML) * DM) + lnr_ + 64 * j);
                else { const v2u r = *((const GAS v2u*)((const bf16*)fx_in + (size_t)(row - ML) * DM) + lnr_ + 64 * j); xin = (f32x4){bflo(r.x), bfhi(r.x), bflo(r.y), bfhi(r.y)}; }
                v[j] = xin + g4[64 * j] * a;
                if (RES32_) *((GAS f32x4*)((float*)fx_out + (size_t)(row - ML) * DM) + lnr_ + 64 * j) = v[j];
                else { v2u w; w.x = pk2(v[j].x, v[j].y); w.y = pk2(v[j].z, v[j].w); *((GAS v2u*)((bf16*)fx_out + (size_t)(row - ML) * DM) + lnr_ + 64 * j) = w;
                       v[j] = (f32x4){bflo(w.x), bfhi(w.x), bflo(w.y), bfhi(w.y)}; }
                s += (v[j].x * v[j].x + v[j].y * v[j].y) + (v[j].z * v[j].z + v[j].w * v[j].w); }
            const float rstd = 1.0f / sqrtf(wave_sum(s) * (1.0f / DM) + EPS);
            const f32x4* gg = (const f32x4*)gain + lnr_; const f32x4* sh4 = (const f32x4*)shp + lnr_; const f32x4* sc4 = (const f32x4*)scp + lnr_;
            GAS v2u* o8 = (GAS v2u*)(H + (size_t)row * DM) + lnr_;
#pragma unroll
            for (int j = 0; j < 8; ++j) { const f32x4 y = v[j] * rstd * gg[64 * j] * (sc4[64 * j] + 1.0f) + sh4[64 * j]; v2u w; w.x = pk2(y.x, y.y); w.y = pk2(y.z, y.w); o8[64 * j] = w; }
        } else if (X32) {
            const float* src = row < ML ? (const float*)xlat + (size_t)row * DM : (const float*)xctx + (size_t)(row - ML) * DM;
            const GAS f32x4* xr = (const GAS f32x4*)src + lnr_;
            f32x4 v[8]; float s = 0.f;
#pragma unroll
            for (int j = 0; j < 8; ++j) { v[j] = xr[64 * j]; s += (v[j].x * v[j].x + v[j].y * v[j].y) + (v[j].z * v[j].z + v[j].w * v[j].w); }
            const float rstd = 1.0f / sqrtf(wave_sum(s) * (1.0f / DM) + EPS);
            const f32x4* gg = (const f32x4*)gain + lnr_; const f32x4* sh4 = (const f32x4*)shp + lnr_; const f32x4* sc4 = (const f32x4*)scp + lnr_;
            GAS v2u* o8 = (GAS v2u*)(H + (size_t)row * DM) + lnr_;
#pragma unroll
            for (int j = 0; j < 8; ++j) { const f32x4 y = v[j] * rstd * gg[64 * j] * (sc4[64 * j] + 1.0f) + sh4[64 * j]; v2u w; w.x = pk2(y.x, y.y); w.y = pk2(y.z, y.w); o8[64 * j] = w; }
        } else if (MK_NORM_REGMOD) {
#if MK_NORM_REGMOD
            v4u raw[4]; float s = 0.f;
            if (have) {
#pragma unroll
                for (int j = 0; j < 4; ++j) raw[j] = nraw[j];
            } else { const bf16* src = row < ML ? (const bf16*)xlat + (size_t)row * DM : (const bf16*)xctx + (size_t)(row - ML) * DM; const GAS v4u* xr = (const GAS v4u*)src + lnr_;
#pragma unroll
                for (int j = 0; j < 4; ++j) raw[j] = xr[64 * j]; }
            { const int nrow = row + NGW; have = MK_NORM_CTXSPREAD ? (row < ML && nrow < (nrows < ML ? nrows : ML)) : (nrow < nrows && !(slab != nullptr && nrow >= ML));
              if (have) { const bf16* nsrc = nrow < ML ? (const bf16*)xlat + (size_t)nrow * DM : (const bf16*)xctx + (size_t)(nrow - ML) * DM; const GAS v4u* nx = (const GAS v4u*)nsrc + lnr_;
#pragma unroll
                  for (int j = 0; j < 4; ++j) nraw[j] = nx[64 * j]; } }
            if (ci != mci) { mci = ci; int ln_ = lnr_;
#pragma unroll
                for (int j = 0; j < 4; ++j) { const int c = 8 * ln_ + 512 * j;
#pragma unroll
                    for (int hh = 0; hh < 2; ++hh) { const f32x4 g0 = *(const f32x4*)(gain + c + 4 * hh), s0 = *(const f32x4*)(scp + c + 4 * hh); mA[j][hh] = g0 * (s0 + 1.0f); mB[j][hh] = *(const f32x4*)(shp + c + 4 * hh); } } }
#pragma unroll
            for (int j = 0; j < 4; ++j) { float x[8]; unpack8(raw[j], x);
#pragma unroll
                for (int e = 0; e < 8; ++e) s += x[e] * x[e]; }
            const float rstd = 1.0f / sqrtf(wave_sum(s) * (1.0f / DM) + EPS);
            GAS v4u* o16 = (GAS v4u*)(H + (size_t)row * DM) + lnr_;
#pragma unroll
            for (int j = 0; j < 4; ++j) { float x[8]; unpack8(raw[j], x);
                const f32x4 a0 = mA[j][0], a1 = mA[j][1], h0 = mB[j][0], h1 = mB[j][1];
                v4u w; w.x = pk2(x[0] * rstd * a0.x + h0.x, x[1] * rstd * a0.y + h0.y); w.y = pk2(x[2] * rstd * a0.z + h0.z, x[3] * rstd * a0.w + h0.w);
                w.z = pk2(x[4] * rstd * a1.x + h1.x, x[5] * rstd * a1.y + h1.y); w.w = pk2(x[6] * rstd * a1.z + h1.z, x[7] * rstd * a1.w + h1.w);
                o16[64 * j] = w; }
#endif
        } else {
            const bf16* src = row < ML ? (const bf16*)xlat + (size_t)row * DM : (const bf16*)xctx + (size_t)(row - ML) * DM;
            const GAS v4u* xr = (const GAS v4u*)src + lnr_;
            v4u raw[4]; float s = 0.f;
#pragma unroll
            for (int j = 0; j < 4; ++j) raw[j] = xr[64 * j];
#pragma unroll
            for (int j = 0; j < 4; ++j) { float x[8]; unpack8(raw[j], x);
#pragma unroll
                for (int e = 0; e < 8; ++e) s += x[e] * x[e]; }
            const float rstd = 1.0f / sqrtf(wave_sum(s) * (1.0f / DM) + EPS);
            GAS v4u* o16 = (GAS v4u*)(H + (size_t)row * DM) + lnr_;
#pragma unroll
            for (int j = 0; j < 4; ++j) { float x[8]; unpack8(raw[j], x); const int c = 8 * lnr_ + 512 * j;
                const f32x4 g0 = *(const f32x4*)(gain + c), g1 = *(const f32x4*)(gain + c + 4), s0 = *(const f32x4*)(scp + c), s1 = *(const f32x4*)(scp + c + 4), h0 = *(const f32x4*)(shp + c), h1 = *(const f32x4*)(shp + c + 4);
                v4u w; w.x = pk2(x[0] * rstd * g0.x * (s0.x + 1.0f) + h0.x, x[1] * rstd * g0.y * (s0.y + 1.0f) + h0.y); w.y = pk2(x[2] * rstd * g0.z * (s0.z + 1.0f) + h0.z, x[3] * rstd * g0.w * (s0.w + 1.0f) + h0.w);
                w.z = pk2(x[4] * rstd * g1.x * (s1.x + 1.0f) + h1.x, x[5] * rstd * g1.y * (s1.y + 1.0f) + h1.y); w.w = pk2(x[6] * rstd * g1.z * (s1.z + 1.0f) + h1.z, x[7] * rstd * g1.w * (s1.w + 1.0f) + h1.w);
                o16[64 * j] = w; }
        }
    }
}

struct AttnTileDesc { unsigned koff, voff; int boff; bool lat, row_ok; };
#define ALD16(dst, voff, sbase, imm) asm volatile("global_load_dwordx4 %0, %1, %2 offset:" #imm : "=v"(dst) : "v"(voff), "s"(sbase))
#define ALD4(dst, voff, sbase) asm volatile("global_load_dword %0, %1, %2" : "=v"(dst) : "v"(voff), "s"(sbase))
struct AttnBases { const char* kpl[8]; const char* vt; const char* rpb; };
__device__ __forceinline__ void attn_issue_k(const AttnBases& B, unsigned koff, bf16x8 (&kf)[8]) {
    ALD16(kf[0], koff, B.kpl[0], 0); ALD16(kf[1], koff, B.kpl[1], 0); ALD16(kf[2], koff, B.kpl[2], 0); ALD16(kf[3], koff, B.kpl[3], 0);
    ALD16(kf[4], koff, B.kpl[4], 0); ALD16(kf[5], koff, B.kpl[5], 0); ALD16(kf[6], koff, B.kpl[6], 0); ALD16(kf[7], koff, B.kpl[7], 0);
}
__device__ __forceinline__ void attn_issue_v(const AttnBases& B, unsigned voff, bf16x8 (&vf)[4][2]) {
    const unsigned v1 = voff + 4096u;
    ALD16(vf[0][0], voff, B.vt, 0); ALD16(vf[1][0], voff, B.vt, 512); ALD16(vf[2][0], voff, B.vt, 1024); ALD16(vf[3][0], voff, B.vt, 1536);
    ALD16(vf[0][1], v1, B.vt, 0); ALD16(vf[1][1], v1, B.vt, 512); ALD16(vf[2][1], v1, B.vt, 1024); ALD16(vf[3][1], v1, B.vt, 1536);
}
#define AWAIT8(n, a) asm volatile("s_waitcnt vmcnt(" #n ")" : "+v"(a[0]), "+v"(a[1]), "+v"(a[2]), "+v"(a[3]), "+v"(a[4]), "+v"(a[5]), "+v"(a[6]), "+v"(a[7]))
#define AWAITV(n, a) asm volatile("s_waitcnt vmcnt(" #n ")" : "+v"(a[0][0]), "+v"(a[1][0]), "+v"(a[2][0]), "+v"(a[3][0]), "+v"(a[0][1]), "+v"(a[1][1]), "+v"(a[2][1]), "+v"(a[3][1]))
__device__ __forceinline__ void attn_tile(const AttnBases& B, bf16x8 (&kf)[8], bf16x8 (&vf)[4][2], const AttnTileDesc& d, const AttnTileDesc& dn, const LAS float* btab,
                                          const bf16x8 (&qf)[8], f32x16 (&ot)[4], float& m, float& lsum, const unsigned colmask, const float c1) {
    float bvv[16];
#pragma unroll
    for (int i = 0; i < 16; ++i) bvv[i] = btab[d.boff + 16 * (i >> 3) + (i & 7)];
    f32x16 S;
#pragma unroll
    for (int i = 0; i < 16; ++i) S[i] = 0.f;
    AWAIT8(8, kf);
#pragma unroll
    for (int s = 0; s < 8; ++s) S = MFMA32(kf[s], qf[s], S);
    __builtin_amdgcn_sched_barrier(0);
    attn_issue_k(B, dn.koff, kf);
    __builtin_amdgcn_sched_barrier(0);
    float t[16];
    { const unsigned msk = d.lat ? (d.row_ok ? colmask : 0u) : 0xffffu; const float bsc = d.lat ? LOG2E : 0.f;
#pragma unroll
      for (int i = 0; i < 16; ++i) t[i] = ((msk >> i) & 1u) ? S[i] * c1 + bvv[i] * bsc : -__builtin_inff(); }
    float mx = t[0];
#pragma unroll
    for (int i = 1; i < 16; ++i) mx = __builtin_fmaxf(mx, t[i]);
    mx = swap32_max(mx);
    if (__any(mx > m + 8.0f)) {
        const float mn = __builtin_fmaxf(m, mx);
        const float alpha = __builtin_amdgcn_exp2f(m - mn);
        m = mn; lsum *= alpha;
#pragma unroll
        for (int nb = 0; nb < 4; ++nb)
#pragma unroll
            for (int i = 0; i < 16; ++i) ot[nb][i] *= alpha;
    }
    float ps = 0.f; float p[16];
#pragma unroll
    for (int i = 0; i < 16; ++i) { p[i] = __builtin_amdgcn_exp2f(t[i] - m); ps += p[i]; }
    lsum += ps;
    v4u w0, w1; w0.x = pk2(p[0], p[1]); w0.y = pk2(p[2], p[3]); w0.z = pk2(p[4], p[5]); w0.w = pk2(p[6], p[7]);
    w1.x = pk2(p[8], p[9]); w1.y = pk2(p[10], p[11]); w1.z = pk2(p[12], p[13]); w1.w = pk2(p[14], p[15]);
    const bf16x8 pf0 = __builtin_bit_cast(bf16x8, w0), pf1 = __builtin_bit_cast(bf16x8, w1);
    AWAITV(8, vf);
#pragma unroll
    for (int nb = 0; nb < 4; ++nb) { ot[nb] = MFMA32(vf[nb][0], pf0, ot[nb]); ot[nb] = MFMA32(vf[nb][1], pf1, ot[nb]); }
    __builtin_amdgcn_sched_barrier(0);
    attn_issue_v(B, dn.voff, vf);
    __builtin_amdgcn_sched_barrier(0);
}
__device__ __forceinline__ void attn_phase(Frame& F, const bf16* QK, const bf16* VT, bf16* O, const float* rpb, const bool ctx_out) {
    const int lane = F.lane, ql = lane & 31, h = lane >> 5;
    const int gw = F.vcu * NWAVES + F.wave, NGW = F.G * NWAVES;
    const int NU = 8192 + (ctx_out ? 256 : 0);
    const float c1 = 0.08838834764831845f * LOG2E;
#if MK_ATTN_CTXSPREAD
    int kk_ = 0, tt_ = 0;
    for (;;) { int u;
        if (gw + kk_ * NGW < 8192) { u = gw + kk_ * NGW; ++kk_; }
        else if (F.vcu + F.G * (F.wave + NWAVES * tt_) < NU - 8192) { u = 8192 + F.vcu + F.G * (F.wave + NWAVES * tt_); ++tt_; }
        else break;
#else
    for (int u = gw; u < NU; u += NGW) {
#endif
        int b, head, qrow, qr = 0, qc = 0, cw0 = 0, rs0 = 0, rs1e = 0;
        if (u < 8192) { const int g = u & 3, rp = (u >> 2) & 63; head = (u >> 8) & 15; b = u >> 12;
            qr = 2 * rp + (ql >> 4); qc = 16 * g + (ql & 15); qrow = b * SEQ + qr * GRIDW + qc; cw0 = g == 0 ? 0 : (g == 1 ? 8 : (g == 2 ? 24 : 32));
            int a0 = 2 * rp - 4; a0 = a0 < 0 ? 0 : (a0 > GROWS - 8 ? GROWS - 8 : a0); int a1 = 2 * rp - 3; a1 = a1 < 0 ? 0 : (a1 > GROWS - 8 ? GROWS - 8 : a1); rs0 = a0; rs1e = a1 + 8; }
        else { const int u2 = u - 8192, qt = u2 & 7; head = (u2 >> 3) & 15; b = u2 >> 7; qrow = ML + CTXL * b + 32 * qt + ql; }
        int rs = qr - 4; rs = rs < 0 ? 0 : (rs > GROWS - 8 ? GROWS - 8 : rs);
        int cs = qc - 8; cs = cs < 0 ? 0 : (cs > GRIDW - 16 ? GRIDW - 16 : cs);
        unsigned colmask = 0u;
#pragma unroll
        for (int i = 0; i < 16; ++i) { const int kc = cw0 + 8 * h + 16 * (i >> 3) + (i & 7); colmask |= (kc >= cs && kc < cs + 16) ? (1u << i) : 0u; }
        const int dcb = cw0 + 8 * h - qc + 15;
        const float* rpb_h = rpb + (size_t)head * 15 * 31;
        bf16x8 qf[8];
        { const bf16* qp = QK + ((size_t)head * 8 * MT + qrow) * 16 + 8 * h;
#pragma unroll
          for (int s = 0; s < 8; ++s) qf[s] = *(const GAS bf16x8*)(qp + (size_t)s * MT * 16); }
        f32x16 ot[4];
#pragma unroll
        for (int nb = 0; nb < 4; ++nb)
#pragma unroll
            for (int i = 0; i < 16; ++i) ot[nb][i] = 0.f;
        float m = -__builtin_inff(), lsum = 0.f;
        const int qlp = (ql & ~12) | ((ql & 4) << 1) | ((ql & 8) >> 1);
        const unsigned kbase = (unsigned)((((size_t)(16 + head) * 8 * MT + qlp) * 16 + 8 * h) * 2);
        const unsigned vbase = (unsigned)((((size_t)head * (MT / 8) + h) * 128 + ql) * 16);
        const int crow0 = ML + CTXL * b, nt = 8 + (rs1e - rs0);
#define ATT_DESC(t, d) do { const int t__ = (t); const bool ctx__ = t__ < 8; const int kr__ = rs0 + t__ - 8; \
            const int k0__ = ctx__ ? crow0 + 32 * t__ : b * SEQ + kr__ * GRIDW + cw0;                                      \
            d.koff = kbase + (unsigned)k0__ * 32u; d.voff = vbase + (unsigned)(k0__ >> 3) * 2048u; d.lat = !ctx__; \
            d.row_ok = !ctx__ && kr__ >= rs && kr__ < rs + 8; d.boff = d.row_ok ? (kr__ - qr + 7) * 31 + dcb : 15; } while (0)
        AttnBases B;
#pragma unroll
        for (int sx = 0; sx < 8; ++sx) B.kpl[sx] = (const char*)QK + (size_t)sx * (MT * 32);
        B.vt = (const char*)VT; B.rpb = (const char*)rpb_h;
        LAS float* btab = (LAS float*)(F.lds + F.wave * 2304) + 16;
#pragma unroll
        for (int q = 0; q < 8; ++q) { const int idx = lane + 64 * q; if (idx < 465) btab[idx] = rpb_h[idx]; }
        bf16x8 kf[8], vf[4][2]; AttnTileDesc dA, dB;
        asm volatile("s_waitcnt vmcnt(0) lgkmcnt(0)" : "+v"(qf[0]), "+v"(qf[1]), "+v"(qf[2]), "+v"(qf[3]), "+v"(qf[4]), "+v"(qf[5]), "+v"(qf[6]), "+v"(qf[7]) :: "memory");
        ATT_DESC(0, dA); attn_issue_k(B, dA.koff, kf); attn_issue_v(B, dA.voff, vf);
        for (int t = 0; t < nt; ++t) {
            ATT_DESC(t + 1 < nt ? t + 1 : t, dB);
            attn_tile(B, kf, vf, dA, dB, btab, qf, ot, m, lsum, colmask, c1);
            dA = dB;
        }
        AWAIT8(0, kf); AWAITV(0, vf);
#undef ATT_DESC
        const float inv = 1.0f / swap32_sum(lsum);
#if MK_ATTN_ST16
        bf16* op = O + (size_t)qrow * DM + head * HD + 8 * h;
#pragma unroll
        for (int nb = 0; nb < 4; ++nb)
#pragma unroll
            for (int pp = 0; pp < 2; ++pp) { const int ga = 2 * pp, gb = 2 * pp + 1;
                const unsigned ax = pk2(ot[nb][4 * ga] * inv, ot[nb][4 * ga + 1] * inv), ay = pk2(ot[nb][4 * ga + 2] * inv, ot[nb][4 * ga + 3] * inv);
                const unsigned bx = pk2(ot[nb][4 * gb] * inv, ot[nb][4 * gb + 1] * inv), by = pk2(ot[nb][4 * gb + 2] * inv, ot[nb][4 * gb + 3] * inv);
                auto sx = __builtin_amdgcn_permlane32_swap(ax, bx, false, false); auto sy = __builtin_amdgcn_permlane32_swap(ay, by, false, false);
                v4u o; o.x = sx[0]; o.y = sy[0]; o.z = sx[1]; o.w = sy[1];
                *(GAS v4u*)(op + 32 * nb + 16 * pp) = o; }
#else
        bf16* op = O + (size_t)qrow * DM + head * HD + 4 * h;
#pragma unroll
        for (int nb = 0; nb < 4; ++nb)
#pragma unroll
            for (int g4 = 0; g4 < 4; ++g4) { v2u w; w.x = pk2(ot[nb][4 * g4] * inv, ot[nb][4 * g4 + 1] * inv); w.y = pk2(ot[nb][4 * g4 + 2] * inv, ot[nb][4 * g4 + 3] * inv);
                *(GAS v2u*)(op + 32 * nb + 8 * g4) = w; }
#endif
    }
}

__device__ __forceinline__ void gm_spatial_phase(Frame& F, const bf16* U, const bf16* VT, bf16* G, const bf16* WS, const float* PST, const float* vg, const float* bs) {
#if MK_SPATIAL_LDS
    const int w = F.wave;
    LAS float* rsd = (LAS float*)(F.lds);
    LAS unsigned char* wsb = F.lds + 4096;
    constexpr int NUNITS = (MT / GMC) * GMG;
    const int u0 = (int)((long)F.vcu * NUNITS / F.G), u1 = (int)((long)(F.vcu + 1) * NUNITS / F.G);
    int cprev = -1;
    v4u araw[8];
#pragma unroll
    for (int s = 0; s < 8; ++s) araw[s] = (v4u){0u, 0u, 0u, 0u};
    if (u0 < u1) { const GAS v4u* src = (const GAS v4u*)(WS + (size_t)(u0 & 15) * 16384) + F.tid; LAS v4u* d = (LAS v4u*)wsb + F.tid;
#pragma unroll
        for (int k = 0; k < 4; ++k) d[512 * k] = src[512 * k];
        const int ql = F.lane & 31, h = F.lane >> 5;
        const bf16* ap = VT + ((size_t)(8 * (u0 & 15) + w) * (MT / 16) + 8 * (u0 >> 4)) * 512 + ql * 16 + 8 * h;
#pragma unroll
        for (int s = 0; s < 8; ++s) araw[s] = *(const GAS v4u*)(ap + 512 * s); }
    for (int u = u0; u < u1; ++u) {
        const int c = u >> 4, g = u & 15, buf = (u - u0) & 1; const bool more = u + 1 < u1;
        int lo_ = F.lane; asm volatile("" : "+v"(lo_)); const int lane = lo_, ql = lo_ & 31, h = lo_ >> 5;
        if (c != cprev) { cprev = c;
            __syncthreads();
            if (lane < 16) { const int tok = GMC * c + 16 * w + lane; float s = 0.f;
#pragma unroll
                for (int q = 0; q < 2; ++q) { float ps[16];
#pragma unroll
                    for (int p = 0; p < 16; ++p) ps[p] = PST[(size_t)(16 * q + p) * MT + tok];
#pragma unroll
                    for (int p = 0; p < 16; ++p) s += ps[p]; }
                rsd[16 * w + lane] = 1.0f / sqrtf(s * (1.0f / GMW) + EPS); }
        }
        v4u wt[4];
#pragma unroll
        for (int k = 0; k < 4; ++k) wt[k] = (v4u){0u, 0u, 0u, 0u};
        if (more) { const GAS v4u* src = (const GAS v4u*)(WS + (size_t)((u + 1) & 15) * 16384) + F.tid;
#pragma unroll
            for (int k = 0; k < 4; ++k) wt[k] = src[512 * k]; }
        v2u uu[4][4]; f32x4 v4[4]; float bsv[4];
#pragma unroll
        for (int g4 = 0; g4 < 4; ++g4) v4[g4] = *(const f32x4*)(vg + GMGD * g + 32 * w + 8 * g4 + 4 * h);
        v4u ul[4][2];
#pragma unroll
        for (int ib = 0; ib < 4; ++ib) { const int i = 32 * ib + ql; const size_t row = (size_t)GMC * c + i; bsv[ib] = bs[g * GMC + i];
#pragma unroll
            for (int pp = 0; pp < 2; ++pp) ul[ib][pp] = *(const GAS v4u*)(U + row * GMW + GMGD * g + 32 * w + 16 * pp + 8 * h); }
        LDS_WAIT(); asm volatile("" ::: "memory"); __builtin_amdgcn_s_barrier(); asm volatile("" ::: "memory");
        bf16x8 af[8];
#pragma unroll
        for (int s = 0; s < 8; ++s) { const v4u raw = araw[s]; const f32x4 r0 = *(const LAS f32x4*)(rsd + 16 * s + 8 * h), r1 = *(const LAS f32x4*)(rsd + 16 * s + 8 * h + 4);
            v4u o; o.x = pk2(bflo(raw.x) * r0.x, bfhi(raw.x) * r0.y); o.y = pk2(bflo(raw.y) * r0.z, bfhi(raw.y) * r0.w);
            o.z = pk2(bflo(raw.z) * r1.x, bfhi(raw.z) * r1.y); o.w = pk2(bflo(raw.w) * r1.z, bfhi(raw.w) * r1.w);
            af[s] = __builtin_bit_cast(bf16x8, o); }
        if (more) { const int un = u + 1; const bf16* ap = VT + ((size_t)(8 * (un & 15) + w) * (MT / 16) + 8 * (un >> 4)) * 512 + ql * 16 + 8 * h;
#pragma unroll
            for (int s = 0; s < 8; ++s) araw[s] = *(const GAS v4u*)(ap + 512 * s); }
        f32x16 acc[4];
#pragma unroll
        for (int ib = 0; ib < 4; ++ib)
#pragma unroll
            for (int i = 0; i < 16; ++i) acc[ib][i] = 0.f;
        const LAS unsigned char* wb = wsb + buf * 32768 + lane * 16;
#pragma unroll
        for (int ib = 0; ib < 4; ++ib)
#pragma unroll
            for (int s = 0; s < 8; ++s) { const bf16x8 bfr = *(const LAS bf16x8*)(wb + (ib * 8 + s) * 1024); acc[ib] = MFMA32(af[s], bfr, acc[ib]); }
#pragma unroll
        for (int ib = 0; ib < 4; ++ib) { const int i = 32 * ib + ql; const size_t row = (size_t)GMC * c + i;
#pragma unroll
            for (int pp = 0; pp < 2; ++pp) {
                auto sx = __builtin_amdgcn_permlane32_swap(ul[ib][pp].x, ul[ib][pp].z, false, false); auto sy = __builtin_amdgcn_permlane32_swap(ul[ib][pp].y, ul[ib][pp].w, false, false);
                uu[ib][2 * pp].x = sx[0]; uu[ib][2 * pp + 1].x = sx[1]; uu[ib][2 * pp].y = sy[0]; uu[ib][2 * pp + 1].y = sy[1]; }
            v2u wv[4];
#pragma unroll
            for (int g4 = 0; g4 < 4; ++g4) { const v2u ux = uu[ib][g4];
                const float o0 = bflo(ux.x) * (v4[g4].x * acc[ib][4 * g4] + bsv[ib]), o1 = bfhi(ux.x) * (v4[g4].y * acc[ib][4 * g4 + 1] + bsv[ib]);
                const float o2 = bflo(ux.y) * (v4[g4].z * acc[ib][4 * g4 + 2] + bsv[ib]), o3 = bfhi(ux.y) * (v4[g4].w * acc[ib][4 * g4 + 3] + bsv[ib]);
                wv[g4].x = pk2(o0, o1); wv[g4].y = pk2(o2, o3); }
#pragma unroll
            for (int pp = 0; pp < 2; ++pp) {
                auto sx = __builtin_amdgcn_permlane32_swap(wv[2 * pp].x, wv[2 * pp + 1].x, false, false); auto sy = __builtin_amdgcn_permlane32_swap(wv[2 * pp].y, wv[2 * pp + 1].y, false, false);
                v4u o; o.x = sx[0]; o.y = sy[0]; o.z = sx[1]; o.w = sy[1];
                *(GAS v4u*)(G + row * GMW + GMGD * g + 32 * w + 16 * pp + 8 * h) = o; } }
        if (more) { LAS v4u* d = (LAS v4u*)(wsb + (buf ^ 1) * 32768) + F.tid;
#pragma unroll
            for (int k = 0; k < 4; ++k) d[512 * k] = wt[k]; }
    }
    __syncthreads();
#else
    const int lane = F.lane, ql = lane & 31, h = lane >> 5, w = F.wave;
    LAS float* rsd = (LAS float*)(F.lds);
    constexpr int NUNITS = (MT / GMC) * GMG;
    const int u0 = (int)((long)F.vcu * NUNITS / F.G), u1 = (int)((long)(F.vcu + 1) * NUNITS / F.G);
    int cprev = -1;
    for (int u = u0; u < u1; ++u) {
        const int c = u >> 4, g = u & 15;
        if (c != cprev) { cprev = c;
            __syncthreads();
            if (lane < 16) { const int tok = GMC * c + 16 * w + lane; float s = 0.f;
#pragma unroll 8
                for (int p = 0; p < 32; ++p) s += PST[(size_t)p * MT + tok];
                rsd[16 * w + lane] = 1.0f / sqrtf(s * (1.0f / GMW) + EPS); }
            __syncthreads();
        }
        bf16x8 af[8];
        { const bf16* ap = VT + ((size_t)(8 * g + w) * (MT / 16) + 8 * c) * 512 + ql * 16 + 8 * h;
#pragma unroll
          for (int s = 0; s < 8; ++s) { const v4u raw = *(const GAS v4u*)(ap + 512 * s); const f32x4 r0 = *(const LAS f32x4*)(rsd + 16 * s + 8 * h), r1 = *(const LAS f32x4*)(rsd + 16 * s + 8 * h + 4);
              v4u o; o.x = pk2(bflo(raw.x) * r0.x, bfhi(raw.x) * r0.y); o.y = pk2(bflo(raw.y) * r0.z, bfhi(raw.y) * r0.w);
              o.z = pk2(bflo(raw.z) * r1.x, bfhi(raw.z) * r1.y); o.w = pk2(bflo(raw.w) * r1.z, bfhi(raw.w) * r1.w);
              af[s] = __builtin_bit_cast(bf16x8, o); } }
        f32x16 acc[4];
#pragma unroll
        for (int ib = 0; ib < 4; ++ib)
#pragma unroll
            for (int i = 0; i < 16; ++i) acc[ib][i] = 0.f;
#pragma unroll
        for (int ib = 0; ib < 4; ++ib) { const bf16* bp = WS + ((size_t)(g * 4 + ib) * 8) * 512 + lane * 8;
#pragma unroll
            for (int s = 0; s < 8; ++s) { const bf16x8 bfr = *(const GAS bf16x8*)(bp + 512 * s); acc[ib] = MFMA32(af[s], bfr, acc[ib]); } }
#pragma unroll
        for (int ib = 0; ib < 4; ++ib) { const int i = 32 * ib + ql; const size_t row = (size_t)GMC * c + i; const float bsv = bs[g * GMC + i];
#pragma unroll
            for (int g4 = 0; g4 < 4; ++g4) { const int col = GMGD * g + 32 * w + 8 * g4 + 4 * h; const f32x4 v4 = *(const f32x4*)(vg + col);
                const v2u uu = *(const GAS v2u*)(U + row * GMW + col);
                const float o0 = bflo(uu.x) * (v4.x * acc[ib][4 * g4] + bsv), o1 = bfhi(uu.x) * (v4.y * acc[ib][4 * g4 + 1] + bsv);
                const float o2 = bflo(uu.y) * (v4.z * acc[ib][4 * g4 + 2] + bsv), o3 = bfhi(uu.y) * (v4.w * acc[ib][4 * g4 + 3] + bsv);
                v2u wv; wv.x = pk2(o0, o1); wv.y = pk2(o2, o3); *(GAS v2u*)(G + row * GMW + col) = wv; } }
        LDS_WAIT(); asm volatile("" ::: "memory");
    }
#endif
}

__device__ __forceinline__ bool has_prev(int r) { return r < ML ? (r & (SEQ - 1)) != 0 : ((r - ML) & (CTXL - 1)) != 0; }
__device__ __forceinline__ bool has_next(int r) { return r < ML ? (r & (SEQ - 1)) != SEQ - 1 : ((r - ML) & (CTXL - 1)) != CTXL - 1; }

__device__ __forceinline__ void sc_conv_phase(Frame& F, const bf16* BCX, bf16* T, const float* cw  ) {
#if MK_CONV33
    const int gt = F.vcu * NWAVES * 64 + F.tid, NT = F.G * NWAVES * 64;
    constexpr int RB = 33, CH = 11, NOC = DM / 8;
    for (int it = gt; it < (MT / RB) * NOC; it += NT) {
        const int rb = it / NOC, oc = it % NOC, c0 = 8 * oc, r0 = rb * RB;
        float w0[8], w1[8], w2[8];
        { const f32x4 a0 = *(const f32x4*)(cw + c0), a1 = *(const f32x4*)(cw + c0 + 4), b0 = *(const f32x4*)(cw + DM + c0), b1 = *(const f32x4*)(cw + DM + c0 + 4), d0 = *(const f32x4*)(cw + 2 * DM + c0), d1 = *(const f32x4*)(cw + 2 * DM + c0 + 4);
#pragma unroll
          for (int e = 0; e < 4; ++e) { w0[e] = a0[e]; w0[4 + e] = a1[e]; w1[e] = b0[e]; w1[4 + e] = b1[e]; w2[e] = d0[e]; w2[4 + e] = d1[e]; } }
        for (int ch = 0; ch < RB / CH; ++ch) {
            int q0 = r0 + ch * CH; asm volatile("" : "+v"(q0));
            v4u cr[CH + 2], xr[CH + 2], br[CH];
#pragma unroll
            for (int i = 0; i < CH + 2; ++i) { int r = q0 - 1 + i; r = r < 0 ? 0 : (r > MT - 1 ? MT - 1 : r); const bf16* rp = BCX + (size_t)r * 6144 + c0;
                cr[i] = *(const GAS v4u*)(rp + DM); xr[i] = *(const GAS v4u*)(rp + 2 * DM); if (i >= 1 && i <= CH) br[i - 1] = *(const GAS v4u*)rp; }
            float pv[8], cv[8], nv[8];
            { float a[8], b[8]; unpack8(cr[0], a); unpack8(xr[0], b); const float f = has_prev(q0) ? 1.f : 0.f;
#pragma unroll
              for (int e = 0; e < 8; ++e) pv[e] = a[e] * b[e] * f; }
            { float a[8], b[8]; unpack8(cr[1], a); unpack8(xr[1], b);
#pragma unroll
              for (int e = 0; e < 8; ++e) cv[e] = a[e] * b[e]; }
#pragma unroll
            for (int i = 0; i < CH; ++i) { const int r = q0 + i;
                { float a[8], b[8]; unpack8(cr[i + 2], a); unpack8(xr[i + 2], b); const float f = has_next(r) ? 1.f : 0.f;
#pragma unroll
                  for (int e = 0; e < 8; ++e) nv[e] = a[e] * b[e] * f; }
                float bg[8]; unpack8(br[i], bg);
                float y[8];
#pragma unroll
                for (int e = 0; e < 8; ++e) y[e] = bg[e] * (pv[e] * w0[e] + cv[e] * w1[e] + nv[e] * w2[e]);
                v4u o; o.x = pk2(y[0], y[1]); o.y = pk2(y[2], y[3]); o.z = pk2(y[4], y[5]); o.w = pk2(y[6], y[7]);
                *(GAS v4u*)(T + (size_t)r * DM + c0) = o;
                if (has_next(r)) {
#pragma unroll
                    for (int e = 0; e < 8; ++e) { pv[e] = cv[e]; cv[e] = nv[e]; }
                } else {
                    float a[8], b[8]; unpack8(cr[i + 2], a); unpack8(xr[i + 2], b);
#pragma unroll
                    for (int e = 0; e < 8; ++e) { pv[e] = 0.f; cv[e] = a[e] * b[e]; } } }
        }
    }
#else
    const int gt = F.vcu * NWAVES * 64 + F.tid, NT = F.G * NWAVES * 64;
    constexpr int RB = 16, NOC = DM / 8;
    for (int it = gt; it < (MT / RB) * NOC; it += NT) {
        const int rb = it / NOC, oc = it % NOC, c0 = 8 * oc, r0 = rb * RB;
        float w0[8], w1[8], w2[8];
#pragma unroll
        for (int e = 0; e < 8; ++e) { w0[e] = cw[c0 + e]; w1[e] = cw[DM + c0 + e]; w2[e] = cw[2 * DM + c0 + e]; }
        float pv[8], cv[8], nv[8];
        auto ld = [&](int r, float (&o)[8]) { float a[8], b[8]; unpack8(*(const GAS v4u*)(BCX + (size_t)r * 6144 + DM + c0), a); unpack8(*(const GAS v4u*)(BCX + (size_t)r * 6144 + 2 * DM + c0), b);
#pragma unroll
            for (int e = 0; e < 8; ++e) o[e] = a[e] * b[e]; };
        if (has_prev(r0)) ld(r0 - 1, pv); else {
#pragma unroll
            for (int e = 0; e < 8; ++e) pv[e] = 0.f; }
        ld(r0, cv);
        for (int i = 0; i < RB; ++i) { const int r = r0 + i;
            if (has_next(r)) ld(r + 1, nv); else {
#pragma unroll
                for (int e = 0; e < 8; ++e) nv[e] = 0.f; }
            float bg[8]; unpack8(*(const GAS v4u*)(BCX + (size_t)r * 6144 + c0), bg);
            float y[8];
#pragma unroll
            for (int e = 0; e < 8; ++e) y[e] = bg[e] * (pv[e] * w0[e] + cv[e] * w1[e] + nv[e] * w2[e]);
            v4u o; o.x = pk2(y[0], y[1]); o.y = pk2(y[2], y[3]); o.z = pk2(y[4], y[5]); o.w = pk2(y[6], y[7]);
            *(GAS v4u*)(T + (size_t)r * DM + c0) = o;
#pragma unroll
            for (int e = 0; e < 8; ++e) { pv[e] = cv[e]; cv[e] = nv[e]; } }
    }
#endif
}

__device__ __forceinline__ void ffn_act_phase(Frame& F, const bf16* Z, bf16* A, const float* cw  , const float* cb  , int nrows) {
    const int gt = F.vcu * NWAVES * 64 + F.tid, NT = F.G * NWAVES * 64;
    constexpr int RB = 16, NOC = FFN / 8;
    for (int it = gt; it < (nrows / RB) * NOC; it += NT) {
        const int rb = it / NOC, oc = it % NOC, f0 = 8 * oc, r0 = rb * RB;
        const int zg = 256 * (f0 >> 7) + (f0 & 127), zu = zg + 128;
        float wg0[8], wg1[8], wg2[8], wu0[8], wu1[8], wu2[8], bg[8], bu[8];
#pragma unroll
        for (int e = 0; e < 8; ++e) { wg0[e] = cw[f0 + e]; wg1[e] = cw[FFN2 + f0 + e]; wg2[e] = cw[2 * FFN2 + f0 + e]; bg[e] = cb[f0 + e];
            wu0[e] = cw[FFN + f0 + e]; wu1[e] = cw[FFN2 + FFN + f0 + e]; wu2[e] = cw[2 * FFN2 + FFN + f0 + e]; bu[e] = cb[FFN + f0 + e]; }
        float pg[8], cg[8], ng[8], pu[8], cu[8], nu[8];
        auto ld = [&](int r, float (&og)[8], float (&ou)[8]) { unpack8(*(const GAS v4u*)(Z + (size_t)r * FFN2 + zg), og); unpack8(*(const GAS v4u*)(Z + (size_t)r * FFN2 + zu), ou); };
        if (has_prev(r0)) ld(r0 - 1, pg, pu); else {
#pragma unroll
            for (int e = 0; e < 8; ++e) { pg[e] = 0.f; pu[e] = 0.f; } }
        ld(r0, cg, cu);
        for (int i = 0; i < RB; ++i) { const int r = r0 + i;
            if (has_next(r)) ld(r + 1, ng, nu); else {
#pragma unroll
                for (int e = 0; e < 8; ++e) { ng[e] = 0.f; nu[e] = 0.f; } }
            float y[8];
#pragma unroll
            for (int e = 0; e < 8; ++e) { const float yg = pg[e] * wg0[e] + cg[e] * wg1[e] + ng[e] * wg2[e] + bg[e]; const float yu = pu[e] * wu0[e] + cu[e] * wu1[e] + nu[e] * wu2[e] + bu[e]; y[e] = pg8::silu_f(yg) * yu; }
            v4u o; o.x = pk2(y[0], y[1]); o.y = pk2(y[2], y[3]); o.z = pk2(y[4], y[5]); o.w = pk2(y[6], y[7]);
            *(GAS v4u*)(A + (size_t)r * FFN + f0) = o;
#pragma unroll
            for (int e = 0; e < 8; ++e) { pg[e] = cg[e]; cg[e] = ng[e]; pu[e] = cu[e]; cu[e] = nu[e]; } }
    }
}

constexpr int PH_PER_LAYER = MK_FFN_HALVES ? 10 : 8;
constexpr bool RES32 = !MK_RES_BF16;
constexpr size_t CTXOFF = (size_t)ML * DM * (RES32 ? 4 : 2);
constexpr int NPHASES = 1 + DEPTH * PH_PER_LAYER;
struct Args { const float* in[N_IN]; float* out; unsigned char* ws; int ph_lo, ph_hi; };

__device__ __forceinline__ unsigned long long tab_ld(int i) {
    extern __shared__ __attribute__((aligned(16))) unsigned char lds_[];
    volatile LAS unsigned* t = (volatile LAS unsigned*)((LAS unsigned char*)lds_ + LDSCTL_OFF) + 2 * i;
    const unsigned lo = __builtin_amdgcn_readfirstlane(t[0]), hi = __builtin_amdgcn_readfirstlane(t[1]);
    return ((unsigned long long)hi << 32) | lo;
}
#define INP(i) ((const float*)(const GAS float*)tab_ld(i))
#define OUTP() ((float*)(GAS float*)tab_ld(N_IN))
#define WSP() ((unsigned char*)(GAS unsigned char*)tab_ld(N_IN + 1))
#define FRAME() Frame F; { extern __shared__ __attribute__((aligned(16))) unsigned char lds_[]; int t_ = wv_ * 64 + (int)__builtin_amdgcn_mbcnt_hi(~0u, __builtin_amdgcn_mbcnt_lo(~0u, 0u)); asm volatile("" : "+v"(t_)); int bx_ = blockIdx.x; asm volatile("" : "+s"(bx_)); \
    F.lds = (LAS unsigned char*)lds_; F.MISC = (volatile LAS unsigned*)(F.lds + MISC_OFF); F.tid = t_; F.lane = t_ & 63; F.wave = __builtin_amdgcn_readfirstlane(t_ >> 6); \
    F.G = gridDim.x; F.vcu = (F.G % 8 == 0) ? (bx_ % 8) * (F.G / 8) + bx_ / 8 : bx_; F.ws = WSP(); F.ctl = (gu32*)(F.ws + WS_CTL); }

template <int Lw> __device__ __forceinline__ void convert_layer(Frame& F, int lo, int hi, int rank, int nranks) {
    unsigned char* ws = F.ws;
    LAS unsigned* scr = (LAS unsigned*)(F.lds + RING_OFF + F.wave * 16384);
    constexpr int I_QKV = 32 * 96, I_O = 32 * 32, I_GIN = 32 * 128, I_GOUT = 64 * 32, I_CIN = 32 * 96, I_COUT = 32 * 32, I_UP = 32 * 172, I_DN = 86 * 32;
    constexpr int mxw = Lw % 3, jxw = Lw / 3;
    constexpr int nA = mxw == 0 ? I_QKV : (mxw == 1 ? I_GIN : I_CIN), nB = mxw == 0 ? I_O : (mxw == 1 ? I_GOUT : I_COUT), T = nA + nB + I_UP + I_DN;
    const int it0 = (int)((long)T * lo / 256), it1 = (int)((long)T * hi / 256);
    for (int it = it0 + rank; it < it1; it += nranks) {
        int r = it;
        if (r < nA) { if (mxw == 0) p0_transpose_item(INP(I_NAQKV) + (size_t)jxw * DM * 6144, DM, 6144, (bf16*)(ws + WS_WQKV) + (size_t)jxw * 6144 * DM, false, scr, r, F.lane);
                      else if (mxw == 1) p0_transpose_item(INP(I_GMWIN), DM, 8192, (bf16*)(ws + WS_WGIN), false, scr, r, F.lane);
                      else p0_transpose_item(INP(I_SCWIN), DM, 6144, (bf16*)(ws + WS_WCIN), false, scr, r, F.lane);
                      continue; } r -= nA;
        if (r < nB) { if (mxw == 0) p0_transpose_item(INP(I_NAWO) + (size_t)jxw * DM * DM, DM, DM, (bf16*)(ws + WS_WO) + (size_t)jxw * DM * DM, false, scr, r, F.lane);
                      else if (mxw == 1) p0_transpose_item(INP(I_GMWOUT), GMW, DM, (bf16*)(ws + WS_WGOUT), false, scr, r, F.lane);
                      else p0_transpose_item(INP(I_SCWOUT), DM, DM, (bf16*)(ws + WS_WCOUT), false, scr, r, F.lane);
                      continue; } r -= nB;
        if (r < I_UP) { p0_transpose_item(INP(I_FUP) + (size_t)Lw * DM * FFN2, DM, FFN2, (bf16*)(ws + WS_WUP) + (size_t)Lw * FFN2 * DM, true, scr, r, F.lane); continue; } r -= I_UP;
        p0_transpose_item(INP(I_FDN) + (size_t)Lw * FFN * DM, FFN, DM, (bf16*)(ws + WS_WDN) + (size_t)Lw * DM * FFN_LD, false, scr, r, F.lane, FFN_LD);
    }
}
__device__ __forceinline__ void idle_rank(int nunits, int G, int c, int& rank, int& nidle) {
    const int rounds = (nunits + G - 1) / G, rem = nunits - (rounds - 1) * G;
    if (rem == G) { rank = c; nidle = G; } else { rank = c >= rem ? c - rem : -1; nidle = G - rem; }
}

__global__ void __launch_bounds__(NWAVES * 64, 2) mk_fwd(Args args) {
    extern __shared__ __attribute__((aligned(16))) unsigned char lds[];
    for (int u = threadIdx.x; u < (LDS_BYTES - LDSCTL_OFF) / 4; u += NWAVES * 64) ((LAS unsigned*)((LAS unsigned char*)lds + LDSCTL_OFF))[u] = 0u;
    __syncthreads();
    if (threadIdx.x == 0) { LAS unsigned long long* t = (LAS unsigned long long*)((LAS unsigned char*)lds + LDSCTL_OFF);
#pragma unroll
        for (int i = 0; i < N_IN; ++i) t[i] = (unsigned long long)args.in[i];
        t[N_IN] = (unsigned long long)args.out; t[N_IN + 1] = (unsigned long long)args.ws; }
    __syncthreads();
    const int lo = args.ph_lo, hi = args.ph_hi;
    const int wv_ = __builtin_amdgcn_readfirstlane((int)threadIdx.x >> 6);
    if (hi - lo > 1) { (void)xcd_barrier_post((unsigned*)(WSP() + WS_CTL) + CW_BAR, (volatile LAS unsigned*)((LAS unsigned char*)lds + MISC_OFF) + 8); }
#define IN(k) (lo <= (k) && (k) < hi)
#if MK_TPROBE
#define TP_ARM(ph) do { if (MK_TPROBE_PH == (ph) && L == MK_TPROBE_L && (int)blockIdx.x == MK_TPROBE_B && wv_ == 0) { F.MISC[100] = 1u; F.MISC[101] = 1u; F.MISC[104 + 8] = (unsigned)__builtin_amdgcn_s_memrealtime(); } } while (0)
#define TP_OFF() do { if (wv_ == 0) { if (F.MISC[100] != 0u) F.MISC[104 + 9] = (unsigned)__builtin_amdgcn_s_memrealtime(); F.MISC[100] = 0u; } } while (0)
#define TP_PRE() do { if (wv_ == 0) { volatile LAS unsigned* ms_ = (volatile LAS unsigned*)((LAS unsigned char*)lds + MISC_OFF); if (ms_[101] != 0u) ms_[104 + 11] = (unsigned)__builtin_amdgcn_s_memrealtime(); } } while (0)
#define TP_END() do { if (wv_ == 0) { volatile LAS unsigned* ms_ = (volatile LAS unsigned*)((LAS unsigned char*)lds + MISC_OFF); if (ms_[101] != 0u) ms_[104 + 10] = (unsigned)__builtin_amdgcn_s_memrealtime(); ms_[101] = 0u; } } while (0)
#else
#define TP_ARM(ph) do { } while (0)
#define TP_OFF() do { } while (0)
#define TP_END() do { } while (0)
#define TP_PRE() do { } while (0)
#endif
#if MK_STAMP
#define STAMP(k) do { if (blockIdx.x == 0 && threadIdx.x == 0) ((unsigned long long*)(WSP() + WS_CTL + 4 * CW_STAMP))[k] = __builtin_amdgcn_s_memrealtime(); } while (0)
#else
#define STAMP(k) do { } while (0)
#endif
#define SEAM(k) do { if (IN((k) + 1)) { XcdBarrier bar_; bar_.bar = (unsigned*)(WSP() + WS_CTL) + CW_BAR; bar_.x = xb_xcc_id(); bar_.st = (volatile LAS unsigned*)((LAS unsigned char*)lds + MISC_OFF) + 8; xcd_barrier(bar_); if (MK_DOUBLE_BAR) xcd_barrier(bar_); } } while (0)
#define WSPTRS() unsigned char* ws = F.ws; float* mod = (float*)(ws + WS_MOD); unsigned char* XA = ws + WS_XA; unsigned char* XB = ws + WS_XB; \
    bf16* H = (bf16*)(ws + WS_H); bf16* ACT = (bf16*)(ws + WS_ACT); float* PST = (float*)(ws + WS_PST); unsigned char* BIG = ws + WS_BIG; \
    const float* modL = mod + (size_t)L * 3 * NMOD; const void* xin_lat = L == 0 ? (const void*)INP(I_X) : (const void*)XA; const void* xin_ctx = L == 0 ? (const void*)INP(I_CTX) : (const void*)(XA + CTXOFF); \
    (void)mod; (void)XA; (void)XB; (void)H; (void)ACT; (void)PST; (void)BIG; (void)modL; (void)xin_lat; (void)xin_ctx;

    if (IN(0)) {
        STAMP(0); FRAME();
        _Pragma("unroll") for (int rep_ = 0; rep_ < 1 + ((MK_REPS >> 0) & 1); ++rep_)
        p0_prologue(F, INP(I_C), INP(I_CCTX), INP(I_WADA), INP(I_BADA), INP(I_NAQKV), INP(I_NAWO), INP(I_GMWIN), INP(I_GMWS), INP(I_GMWOUT),
                    INP(I_SCWIN), INP(I_SCWOUT), INP(I_FUP), INP(I_FDN));
        __syncthreads();
        convert_layer<0>(F, 0, MK_P0_SHARE, F.vcu * NWAVES + F.wave, F.G * NWAVES);
#if !MK_DEFER_CONVERT
        convert_layer<1>(F, 0, 256, F.vcu * NWAVES + F.wave, F.G * NWAVES); convert_layer<2>(F, 0, 256, F.vcu * NWAVES + F.wave, F.G * NWAVES); convert_layer<3>(F, 0, 256, F.vcu * NWAVES + F.wave, F.G * NWAVES);
#endif
        SEAM(0);
    }
    { constexpr int L = 0;
        const int base = 1 + PH_PER_LAYER * L, mx = L % 3, jx = L / 3;
        const bool last = (L == DEPTH - 1);
        constexpr int rows = (L == DEPTH - 1) ? ML : MT;
        if (IN(base + 0)) { STAMP(base + 0); FRAME(); WSPTRS();
            const float* modP = mod + (size_t)(L > 0 ? L - 1 : 0) * 3 * NMOD;
            _Pragma("unroll") for (int rep_ = 0; rep_ < REPN(MK_RB_NORM); ++rep_) norm_mod_phase<(L == 0) || RES32, RES32, RES32>(F, xin_lat, xin_ctx, INP(I_NMG) + (size_t)L * DM, modL + 0 * DM, modL + 1 * DM, H, MT,
                L > 0 ? (const float*)(ws + WS_SLAB) : nullptr, 8, XB + CTXOFF, modP + 5 * DM, XA + CTXOFF);
            SEAM(base + 0); }
        if (IN(base + 1)) { STAMP(base + 1); FRAME(); WSPTRS();
            const bf16* Wa; int Na; bf16* Oa; bool acta; int modea = 0, modeb = 0, ldca;
            const bf16* Wb; int Mb; bf16* Ob; bool actb, statb;
            if (mx == 0) { Wa = (const bf16*)(ws + WS_WQKV) + (size_t)jx * 6144 * DM; Na = 4096; Oa = (bf16*)(BIG + BIG_QK); acta = false; modea = 1; modeb = 2;
                           Wb = Wa + (size_t)4096 * DM; Mb = 2048; Ob = (bf16*)(BIG + BIG_VT); actb = false; statb = false; }
            else if (mx == 1) { Wa = (const bf16*)(ws + WS_WGIN); Na = 4096; Oa = (bf16*)(BIG + BIG_U); acta = true;
                           Wb = Wa + (size_t)4096 * DM; Mb = 4096; Ob = (bf16*)(BIG + BIG_GVT); actb = true; statb = true; modeb = 3; }
            else { Wa = (const bf16*)(ws + WS_WCIN); Na = 6144; Oa = (bf16*)(BIG + BIG_BCX); acta = false; Wb = nullptr; Mb = 0; Ob = nullptr; actb = false; statb = false; }
            ldca = modea == 1 ? MT : Na;
            pg8::Gemm g{H, Wa, MT, Na, DM, 256, Wb, H, 0}; pg8::DualOrder S; S.init(Na, Mb, F.G, (int)blockIdx.x); S.wgm0 = MK_WGM_IN0; S.wgm1 = MK_WGM_IN1;
            if (MK_XSTAG_IN > 0) { const unsigned long long d_ = (unsigned long long)(xb_xcc_id() & 7u) * MK_XSTAG_IN, t0_ = __builtin_amdgcn_s_memrealtime(); while (__builtin_amdgcn_s_memrealtime() - t0_ < d_) __builtin_amdgcn_s_sleep(4); }
            TP_ARM(1);
            if constexpr (L % 3 == 1) {
                pg8::EpiDual E{ pg8::EpiBf16R{Oa, ldca, nullptr, acta, false, modea, (PG8_LAS float*)(F.lds + HALO_OFF), INP(I_NAQG) + jx * HD, INP(I_NAKG) + jx * HD},
                                pg8::EpiBf16R{Ob, MT, PST, actb, statb, modeb, nullptr, nullptr, nullptr} };
                _Pragma("unroll") for (int rep_ = 0; rep_ < REPN(MK_RB_GIN); ++rep_)
                pg8::gemm_phase<pg8::EpiDual, pg8::DualOrder, true, true>(F.lds + RING_OFF, g, S, E, wv_);
            } else {
                constexpr int kM0 = (L % 3 == 0) ? 1 : 0, kM1 = (L % 3 == 0) ? 2 : 0;
                typedef pg8::EpiDualT<kM0, false, false, kM1, false, false> EpiIn;
                EpiIn E{ pg8::EpiBf16T<kM0, false, false>{Oa, ldca, nullptr, (PG8_LAS float*)(F.lds + HALO_OFF), INP(I_NAQG) + jx * HD, INP(I_NAKG) + jx * HD},
                         pg8::EpiBf16T<kM1, false, false>{Ob, MT, PST, nullptr, nullptr, nullptr} };
                _Pragma("unroll") for (int rep_ = 0; rep_ < REPN(MK_RB_GIN); ++rep_)
                pg8::gemm_phase<EpiIn, pg8::DualOrder, true, true>(F.lds + RING_OFF, g, S, E, wv_);
            }
            TP_OFF();
#if MK_DEFER_CONVERT
            if (L + 1 < DEPTH) { int rk, ni; idle_rank(S.n0 + S.n1 + S.c0 + 2 * S.nM1, F.G, (int)blockIdx.x, rk, ni);
                if (rk >= 0) { if (L == 0 && MK_P0_SHARE < 256) convert_layer<0>(F, MK_P0_SHARE, 256, rk * NWAVES + F.wave, ni * NWAVES);
                               convert_layer<(L + 1 < DEPTH ? L + 1 : 0)>(F, 0, MK_DS1, rk * NWAVES + F.wave, ni * NWAVES); } }
#endif
            TP_PRE();
            SEAM(base + 1);
            TP_END();
        }
        if (IN(base + 3)) { STAMP(base + 3); FRAME(); WSPTRS();
            _Pragma("unroll") for (int rep_ = 0; rep_ < REPN(MK_RB_CORE); ++rep_) {
            if (mx == 0) attn_phase(F, (const bf16*)(BIG + BIG_QK), (const bf16*)(BIG + BIG_VT), (bf16*)(BIG + BIG_O), INP(I_NARPB) + (size_t)jx * NH * 15 * 31, !last);
            else if (mx == 1) gm_spatial_phase(F, (const bf16*)(BIG + BIG_U), (const bf16*)(BIG + BIG_GVT), (bf16*)(BIG + BIG_G), (const bf16*)(ws + WS_WGS), PST, INP(I_GMVG), INP(I_GMBS));
            else sc_conv_phase(F, (const bf16*)(BIG + BIG_BCX), (bf16*)(BIG + BIG_T), INP(I_SCCW));
            }
            SEAM(base + 3);
        }
        if (IN(base + 4)) { STAMP(base + 4); FRAME(); WSPTRS();
            const bf16* Ao; const bf16* Wo; int Ko;
            if (mx == 0) { Ao = (const bf16*)(BIG + BIG_O); Wo = (const bf16*)(ws + WS_WO) + (size_t)jx * DM * DM; Ko = DM; }
            else if (mx == 1) { Ao = (const bf16*)(BIG + BIG_G); Wo = (const bf16*)(ws + WS_WGOUT); Ko = GMW; }
            else { Ao = (const bf16*)(BIG + BIG_T); Wo = (const bf16*)(ws + WS_WCOUT); Ko = DM; }
            pg8::Gemm g{Ao, Wo, rows, DM, Ko, 256, nullptr, nullptr, 0}; pg8::SplitOrder S; S.init(DM, Ko, mx == 1 ? 8 : 4, !last, F.G, (int)blockIdx.x); S.lat.wgm = MK_WGM_OUT;
            if (MK_STAGGER_TICKS > 0 && (blockIdx.x & 1)) { const unsigned long long t0_ = __builtin_amdgcn_s_memrealtime(); while (__builtin_amdgcn_s_memrealtime() - t0_ < (unsigned long long)MK_STAGGER_TICKS) __builtin_amdgcn_s_sleep(8); }
            TP_ARM(4);
            pg8::EpiResT<(L == 0) || RES32, RES32> E{xin_lat, xin_ctx, XB, XB + CTXOFF, modL + 2 * DM, (float*)(ws + WS_SLAB)};
            _Pragma("unroll") for (int rep_ = 0; rep_ < REPN(MK_RB_GOUT); ++rep_)
            pg8::gemm_phase<pg8::EpiResT<(L == 0) || RES32, RES32>, pg8::SplitOrder, true, true>(F.lds + RING_OFF, g, S, E, wv_);
            TP_OFF();
#if MK_DEFER_CONVERT
            if (L + 1 < DEPTH) { int rk, ni; idle_rank(S.nlat + S.nctx, F.G, (int)blockIdx.x, rk, ni);
                if (rk >= 0) convert_layer<(L + 1 < DEPTH ? L + 1 : 0)>(F, MK_DS1, MK_DS2, rk * NWAVES + F.wave, ni * NWAVES); }
#endif
            TP_PRE();
            SEAM(base + 4);
            TP_END();
        }
        if (IN(base + 5)) { STAMP(base + 5); FRAME(); WSPTRS();
            _Pragma("unroll") for (int rep_ = 0; rep_ < REPN(MK_RB_NORM); ++rep_) norm_mod_phase<RES32, (L == 0) || RES32, RES32>(F, XB, XB + CTXOFF, INP(I_NFG) + (size_t)L * DM, modL + 3 * DM, modL + 4 * DM, H, rows,
                !last ? (const float*)(ws + WS_SLAB) : nullptr, mx == 1 ? 8 : 4, xin_ctx, modL + 2 * DM, XB + CTXOFF);
            SEAM(base + 5); }
#if MK_FFN_HALVES
        if (IN(base + 6)) { STAMP(base + 6); FRAME(); WSPTRS();
            constexpr int npan = (rows + 253) / 254, pan0 = 0, pan1 = 33;
            pg8::Gemm g{H - DM, (const bf16*)(ws + WS_WUP) + (size_t)L * FFN2 * DM, npan * 256, FFN2, DM, 254, nullptr, nullptr, 0}; pg8::StaticOrder S; S.init((pan1 - pan0) * 256, FFN2, F.G, (int)blockIdx.x); S.wgm = MK_WGM_UP; S.pm0 = pan0;
            pg8::EpiAct E{ACT, INP(I_FCW) + (size_t)L * 3 * FFN2, INP(I_FCB) + (size_t)L * FFN2, rows, (PG8_LAS float*)(F.lds + HALO_OFF), FFN_LD};
            _Pragma("unroll") for (int rep_ = 0; rep_ < REPN(MK_RB_UP); ++rep_)
            pg8::gemm_phase<pg8::EpiAct, pg8::StaticOrder, true, true>(F.lds + RING_OFF, g, S, E, wv_);
#if MK_DEFER_CONVERT
            if (L + 1 < DEPTH) { int rk, ni; idle_rank((pan1 - pan0) * (FFN2 / 256), F.G, (int)blockIdx.x, rk, ni);
                if (rk >= 0) convert_layer<(L + 1 < DEPTH ? L + 1 : 0)>(F, MK_DS2, (MK_DS2 + MK_DS3) / 2, rk * NWAVES + F.wave, ni * NWAVES); }
#endif
            TP_PRE();
            SEAM(base + 6);
            TP_END();
        }
        if (IN(base + 7)) { STAMP(base + 7); FRAME(); WSPTRS();
            pg8::Gemm g{ACT, (const bf16*)(ws + WS_WDN) + (size_t)L * DM * FFN_LD, rows, DM, FFN, 256, nullptr, nullptr, FFN_LD}; pg8::SplitOrder S; S.init(DM, FFN, 8, false, F.G, (int)blockIdx.x, 32, 0); S.lat.wgm = MK_WGM_DOWN;
            void* xo_lat = last ? (void*)OUTP() : (void*)XA;
            pg8::EpiResT<RES32, (L == DEPTH - 1) || RES32> E{XB, XB + CTXOFF, xo_lat, XA + CTXOFF, modL + 5 * DM, (float*)(ws + WS_SLAB)};
            _Pragma("unroll") for (int rep_ = 0; rep_ < REPN(MK_RB_DOWN); ++rep_)
            pg8::gemm_phase<pg8::EpiResT<RES32, (L == DEPTH - 1) || RES32>, pg8::SplitOrder, true, true>(F.lds + RING_OFF, g, S, E, wv_);
            TP_PRE();
            SEAM(base + 7);
            TP_END();
        }
        if (IN(base + 8)) { STAMP(base + 8); FRAME(); WSPTRS();
            constexpr int npan = (rows + 253) / 254, pan0 = 33, pan1 = npan;
            pg8::Gemm g{H - DM, (const bf16*)(ws + WS_WUP) + (size_t)L * FFN2 * DM, npan * 256, FFN2, DM, 254, nullptr, nullptr, 0}; pg8::StaticOrder S; S.init((pan1 - pan0) * 256, FFN2, F.G, (int)blockIdx.x); S.wgm = MK_WGM_UP; S.pm0 = pan0;
            pg8::EpiAct E{ACT, INP(I_FCW) + (size_t)L * 3 * FFN2, INP(I_FCB) + (size_t)L * FFN2, rows, (PG8_LAS float*)(F.lds + HALO_OFF), FFN_LD};
            _Pragma("unroll") for (int rep_ = 0; rep_ < REPN(MK_RB_UP); ++rep_)
            pg8::gemm_phase<pg8::EpiAct, pg8::StaticOrder, true, true>(F.lds + RING_OFF, g, S, E, wv_);
#if MK_DEFER_CONVERT
            if (L + 1 < DEPTH) { int rk, ni; idle_rank((pan1 - pan0) * (FFN2 / 256), F.G, (int)blockIdx.x, rk, ni);
                if (rk >= 0) convert_layer<(L + 1 < DEPTH ? L + 1 : 0)>(F, (MK_DS2 + MK_DS3) / 2, MK_DS3, rk * NWAVES + F.wave, ni * NWAVES); }
#endif
            SEAM(base + 8);
        }
        if (IN(base + 9)) { STAMP(base + 9); FRAME(); WSPTRS();
            pg8::Gemm g{ACT, (const bf16*)(ws + WS_WDN) + (size_t)L * DM * FFN_LD, rows, DM, FFN, 256, nullptr, nullptr, FFN_LD}; pg8::SplitOrder S; S.init(DM, FFN, 8, !last, F.G, (int)blockIdx.x, 32, 32); S.lat.wgm = MK_WGM_DOWN;
            void* xo_lat = last ? (void*)OUTP() : (void*)XA;
            pg8::EpiResT<RES32, (L == DEPTH - 1) || RES32> E{XB, XB + CTXOFF, xo_lat, XA + CTXOFF, modL + 5 * DM, (float*)(ws + WS_SLAB)};
            _Pragma("unroll") for (int rep_ = 0; rep_ < REPN(MK_RB_DOWN); ++rep_)
            pg8::gemm_phase<pg8::EpiResT<RES32, (L == DEPTH - 1) || RES32>, pg8::SplitOrder, true, true>(F.lds + RING_OFF, g, S, E, wv_);
            SEAM(base + 9);
        }
#else
        if (IN(base + 6)) { STAMP(base + 6); FRAME(); WSPTRS();
            constexpr int npan = (rows + 253) / 254;
            pg8::Gemm g{H - DM, (const bf16*)(ws + WS_WUP) + (size_t)L * FFN2 * DM, npan * 256, FFN2, DM, 254, nullptr, nullptr, 0}; pg8::StaticOrder S; S.init(npan * 256, FFN2, F.G, (int)blockIdx.x); S.wgm = MK_WGM_UP;
            if (MK_ISTAG_UP > 0) { const unsigned long long d_ = (unsigned long long)(((unsigned)blockIdx.x >> 3) & (MK_ISTAG_WAYS - 1)) * MK_ISTAG_UP, t0_ = __builtin_amdgcn_s_memrealtime(); while (__builtin_amdgcn_s_memrealtime() - t0_ < d_) __builtin_amdgcn_s_sleep(4); }
            if (MK_XSTAG_UP > 0) { const unsigned long long d_ = (unsigned long long)(xb_xcc_id() & 7u) * MK_XSTAG_UP, t0_ = __builtin_amdgcn_s_memrealtime(); while (__builtin_amdgcn_s_memrealtime() - t0_ < d_) __builtin_amdgcn_s_sleep(4); }
            TP_ARM(2);
            pg8::EpiAct E{ACT, INP(I_FCW) + (size_t)L * 3 * FFN2, INP(I_FCB) + (size_t)L * FFN2, rows, (PG8_LAS float*)(F.lds + HALO_OFF), FFN_LD};
#if MK_DYN_TAIL
            S.imax = (npan * (FFN2 / 256)) / F.G;
#endif
            _Pragma("unroll") for (int rep_ = 0; rep_ < REPN(MK_RB_UP); ++rep_)
            pg8::gemm_phase<pg8::EpiAct, pg8::StaticOrder, true, true>(F.lds + RING_OFF, g, S, E, wv_);
            TP_OFF();
#if MK_DEFER_CONVERT
            if (L + 1 < DEPTH) { int rk, ni; idle_rank(npan * (FFN2 / 256), F.G, (int)blockIdx.x, rk, ni);
                if (rk >= 0) convert_layer<(L + 1 < DEPTH ? L + 1 : 0)>(F, MK_DS2, MK_DS3, rk * NWAVES + F.wave, ni * NWAVES); }
#endif
            TP_PRE();
#if MK_DYN_TAIL
            { pg8::DynOrder D{S, (unsigned*)(ws + WS_CTL) + CW_DYN + 64 * L, (PG8_LAS unsigned*)(F.lds + MISC_OFF + 4 * 90), S.imax * F.G, wv_};
              pg8::gemm_phase<pg8::EpiAct, pg8::DynOrder, true, true>(F.lds + RING_OFF, g, D, E, wv_); }
#endif
            SEAM(base + 6);
            TP_END();
        }
        if (IN(base + 7)) { STAMP(base + 7); FRAME(); WSPTRS();
            pg8::Gemm g{ACT, (const bf16*)(ws + WS_WDN) + (size_t)L * DM * FFN_LD, rows, DM, FFN, 256, nullptr, nullptr, FFN_LD}; pg8::SplitOrder S; S.init(DM, FFN, 8, !last, F.G, (int)blockIdx.x); S.rev = MK_DOWN_REV; S.lat.wgm = MK_WGM_DOWN;
            void* xo_lat = last ? (void*)OUTP() : (void*)XA;
            if (MK_STAGGER_TICKS > 0 && (blockIdx.x & 1)) { const unsigned long long t0_ = __builtin_amdgcn_s_memrealtime(); while (__builtin_amdgcn_s_memrealtime() - t0_ < (unsigned long long)MK_STAGGER_TICKS) __builtin_amdgcn_s_sleep(8); }
            TP_ARM(3);
            pg8::EpiResT<RES32, (L == DEPTH - 1) || RES32> E{XB, XB + CTXOFF, xo_lat, XA + CTXOFF, modL + 5 * DM, (float*)(ws + WS_SLAB)};
            _Pragma("unroll") for (int rep_ = 0; rep_ < REPN(MK_RB_DOWN); ++rep_)
            pg8::gemm_phase<pg8::EpiResT<RES32, (L == DEPTH - 1) || RES32>, pg8::SplitOrder, true, true>(F.lds + RING_OFF, g, S, E, wv_);
            TP_OFF();
#if MK_DEFER_CONVERT
            if (L + 1 < DEPTH) { int rk, ni; idle_rank(S.nlat + S.nctx, F.G, (int)blockIdx.x, rk, ni);
                if (rk >= 0) convert_layer<(L + 1 < DEPTH ? L + 1 : 0)>(F, MK_DS3, 256, rk * NWAVES + F.wave, ni * NWAVES); }
#endif
            TP_PRE();
            SEAM(base + 7);
            TP_END();
        }
#endif
    }
    { constexpr int L = 1;
        const int base = 1 + PH_PER_LAYER * L, mx = L % 3, jx = L / 3;
        const bool last = (L == DEPTH - 1);
        constexpr int rows = (L == DEPTH - 1) ? ML : MT;
        if (IN(base + 0)) { STAMP(base + 0); FRAME(); WSPTRS();
            const float* modP = mod + (size_t)(L > 0 ? L - 1 : 0) * 3 * NMOD;
            _Pragma("unroll") for (int rep_ = 0; rep_ < REPN(MK_RB_NORM); ++rep_) norm_mod_phase<(L == 0) || RES32, RES32, RES32>(F, xin_lat, xin_ctx, INP(I_NMG) + (size_t)L * DM, modL + 0 * DM, modL + 1 * DM, H, MT,
                L > 0 ? (const float*)(ws + WS_SLAB) : nullptr, 8, XB + CTXOFF, modP + 5 * DM, XA + CTXOFF);
            SEAM(base + 0); }
        if (IN(base + 1)) { STAMP(base + 1); FRAME(); WSPTRS();
            const bf16* Wa; int Na; bf16* Oa; bool acta; int modea = 0, modeb = 0, ldca;
            const bf16* Wb; int Mb; bf16* Ob; bool actb, statb;
            if (mx == 0) { Wa = (const bf16*)(ws + WS_WQKV) + (size_t)jx * 6144 * DM; Na = 4096; Oa = (bf16*)(BIG + BIG_QK); acta = false; modea = 1; modeb = 2;
                           Wb = Wa + (size_t)4096 * DM; Mb = 2048; Ob = (bf16*)(BIG + BIG_VT); actb = false; statb = false; }
            else if (mx == 1) { Wa = (const bf16*)(ws + WS_WGIN); Na = 4096; Oa = (bf16*)(BIG + BIG_U); acta = true;
                           Wb = Wa + (size_t)4096 * DM; Mb = 4096; Ob = (bf16*)(BIG + BIG_GVT); actb = true; statb = true; modeb = 3; }
            else { Wa = (const bf16*)(ws + WS_WCIN); Na = 6144; Oa = (bf16*)(BIG + BIG_BCX); acta = false; Wb = nullptr; Mb = 0; Ob = nullptr; actb = false; statb = false; }
            ldca = modea == 1 ? MT : Na;
            pg8::Gemm g{H, Wa, MT, Na, DM, 256, Wb, H, 0}; pg8::DualOrder S; S.init(Na, Mb, F.G, (int)blockIdx.x); S.wgm0 = MK_WGM_IN0; S.wgm1 = MK_WGM_IN1;
            if (MK_XSTAG_IN > 0) { const unsigned long long d_ = (unsigned long long)(xb_xcc_id() & 7u) * MK_XSTAG_IN, t0_ = __builtin_amdgcn_s_memrealtime(); while (__builtin_amdgcn_s_memrealtime() - t0_ < d_) __builtin_amdgcn_s_sleep(4); }
            TP_ARM(1);
            if constexpr (L % 3 == 1) {
                pg8::EpiDual E{ pg8::EpiBf16R{Oa, ldca, nullptr, acta, false, modea, (PG8_LAS float*)(F.lds + HALO_OFF), INP(I_NAQG) + jx * HD, INP(I_NAKG) + jx * HD},
                                pg8::EpiBf16R{Ob, MT, PST, actb, statb, modeb, nullptr, nullptr, nullptr} };
                _Pragma("unroll") for (int rep_ = 0; rep_ < REPN(MK_RB_GIN); ++rep_)
                pg8::gemm_phase<pg8::EpiDual, pg8::DualOrder, true, true>(F.lds + RING_OFF, g, S, E, wv_);
            } else {
                constexpr int kM0 = (L % 3 == 0) ? 1 : 0, kM1 = (L % 3 == 0) ? 2 : 0;
                typedef pg8::EpiDualT<kM0, false, false, kM1, false, false> EpiIn;
                EpiIn E{ pg8::EpiBf16T<kM0, false, false>{Oa, ldca, nullptr, (PG8_LAS float*)(F.lds + HALO_OFF), INP(I_NAQG) + jx * HD, INP(I_NAKG) + jx * HD},
                         pg8::EpiBf16T<kM1, false, false>{Ob, MT, PST, nullptr, nullptr, nullptr} };
                _Pragma("unroll") for (int rep_ = 0; rep_ < REPN(MK_RB_GIN); ++rep_)
                pg8::gemm_phase<EpiIn, pg8::DualOrder, true, true>(F.lds + RING_OFF, g, S, E, wv_);
            }
            TP_OFF();
#if MK_DEFER_CONVERT
            if (L + 1 < DEPTH) { int rk, ni; idle_rank(S.n0 + S.n1 + S.c0 + 2 * S.nM1, F.G, (int)blockIdx.x, rk, ni);
                if (rk >= 0) { if (L == 0 && MK_P0_SHARE < 256) convert_layer<0>(F, MK_P0_SHARE, 256, rk * NWAVES + F.wave, ni * NWAVES);
                               convert_layer<(L + 1 < DEPTH ? L + 1 : 0)>(F, 0, MK_DS1, rk * NWAVES + F.wave, ni * NWAVES); } }
#endif
            TP_PRE();
            SEAM(base + 1);
            TP_END();
        }
        if (IN(base + 3)) { STAMP(base + 3); FRAME(); WSPTRS();
            _Pragma("unroll") for (int rep_ = 0; rep_ < REPN(MK_RB_CORE); ++rep_) {
            if (mx == 0) attn_phase(F, (const bf16*)(BIG + BIG_QK), (const bf16*)(BIG + BIG_VT), (bf16*)(BIG + BIG_O), INP(I_NARPB) + (size_t)jx * NH * 15 * 31, !last);
            else if (mx == 1) gm_spatial_phase(F, (const bf16*)(BIG + BIG_U), (const bf16*)(BIG + BIG_GVT), (bf16*)(BIG + BIG_G), (const bf16*)(ws + WS_WGS), PST, INP(I_GMVG), INP(I_GMBS));
            else sc_conv_phase(F, (const bf16*)(BIG + BIG_BCX), (bf16*)(BIG + BIG_T), INP(I_SCCW));
            }
            SEAM(base + 3);
        }
        if (IN(base + 4)) { STAMP(base + 4); FRAME(); WSPTRS();
            const bf16* Ao; const bf16* Wo; int Ko;
            if (mx == 0) { Ao = (const bf16*)(BIG + BIG_O); Wo = (const bf16*)(ws + WS_WO) + (size_t)jx * DM * DM; Ko = DM; }
            else if (mx == 1) { Ao = (const bf16*)(BIG + BIG_G); Wo = (const bf16*)(ws + WS_WGOUT); Ko = GMW; }
            else { Ao = (const bf16*)(BIG + BIG_T); Wo = (const bf16*)(ws + WS_WCOUT); Ko = DM; }
            pg8::Gemm g{Ao, Wo, rows, DM, Ko, 256, nullptr, nullptr, 0}; pg8::SplitOrder S; S.init(DM, Ko, mx == 1 ? 8 : 4, !last, F.G, (int)blockIdx.x); S.lat.wgm = MK_WGM_OUT;
            if (MK_STAGGER_TICKS > 0 && (blockIdx.x & 1)) { const unsigned long long t0_ = __builtin_amdgcn_s_memrealtime(); while (__builtin_amdgcn_s_memrealtime() - t0_ < (unsigned long long)MK_STAGGER_TICKS) __builtin_amdgcn_s_sleep(8); }
            TP_ARM(4);
            pg8::EpiResT<(L == 0) || RES32, RES32> E{xin_lat, xin_ctx, XB, XB + CTXOFF, modL + 2 * DM, (float*)(ws + WS_SLAB)};
            _Pragma("unroll") for (int rep_ = 0; rep_ < REPN(MK_RB_GOUT); ++rep_)
            pg8::gemm_phase<pg8::EpiResT<(L == 0) || RES32, RES32>, pg8::SplitOrder, true, true>(F.lds + RING_OFF, g, S, E, wv_);
            TP_OFF();
#if MK_DEFER_CONVERT
            if (L + 1 < DEPTH) { int rk, ni; idle_rank(S.nlat + S.nctx, F.G, (int)blockIdx.x, rk, ni);
                if (rk >= 0) convert_layer<(L + 1 < DEPTH ? L + 1 : 0)>(F, MK_DS1, MK_DS2, rk * NWAVES + F.wave, ni * NWAVES); }
#endif
            TP_PRE();
            SEAM(base + 4);
            TP_END();
        }
        if (IN(base + 5)) { STAMP(base + 5); FRAME(); WSPTRS();
            _Pragma("unroll") for (int rep_ = 0; rep_ < REPN(MK_RB_NORM); ++rep_) norm_mod_phase<RES32, (L == 0) || RES32, RES32>(F, XB, XB + CTXOFF, INP(I_NFG) + (size_t)L * DM, modL + 3 * DM, modL + 4 * DM, H, rows,
                !last ? (const float*)(ws + WS_SLAB) : nullptr, mx == 1 ? 8 : 4, xin_ctx, modL + 2 * DM, XB + CTXOFF);
            SEAM(base + 5); }
#if MK_FFN_HALVES
        if (IN(base + 6)) { STAMP(base + 6); FRAME(); WSPTRS();
            constexpr int npan = (rows + 253) / 254, pan0 = 0, pan1 = 33;
            pg8::Gemm g{H - DM, (const bf16*)(ws + WS_WUP) + (size_t)L * FFN2 * DM, npan * 256, FFN2, DM, 254, nullptr, nullptr, 0}; pg8::StaticOrder S; S.init((pan1 - pan0) * 256, FFN2, F.G, (int)blockIdx.x); S.wgm = MK_WGM_UP; S.pm0 = pan0;
            pg8::EpiAct E{ACT, INP(I_FCW) + (size_t)L * 3 * FFN2, INP(I_FCB) + (size_t)L * FFN2, rows, (PG8_LAS float*)(F.lds + HALO_OFF), FFN_LD};
            _Pragma("unroll") for (int rep_ = 0; rep_ < REPN(MK_RB_UP); ++rep_)
            pg8::gemm_phase<pg8::EpiAct, pg8::StaticOrder, true, true>(F.lds + RING_OFF, g, S, E, wv_);
#if MK_DEFER_CONVERT
            if (L + 1 < DEPTH) { int rk, ni; idle_rank((pan1 - pan0) * (FFN2 / 256), F.G, (int)blockIdx.x, rk, ni);
                if (rk >= 0) convert_layer<(L + 1 < DEPTH ? L + 1 : 0)>(F, MK_DS2, (MK_DS2 + MK_DS3) / 2, rk * NWAVES + F.wave, ni * NWAVES); }
#endif
            TP_PRE();
            SEAM(base + 6);
            TP_END();
        }
        if (IN(base + 7)) { STAMP(base + 7); FRAME(); WSPTRS();
            pg8::Gemm g{ACT, (const bf16*)(ws + WS_WDN) + (size_t)L * DM * FFN_LD, rows, DM, FFN, 256, nullptr, nullptr, FFN_LD}; pg8::SplitOrder S; S.init(DM, FFN, 8, false, F.G, (int)blockIdx.x, 32, 0); S.lat.wgm = MK_WGM_DOWN;
            void* xo_lat = last ? (void*)OUTP() : (void*)XA;
            pg8::EpiResT<RES32, (L == DEPTH - 1) || RES32> E{XB, XB + CTXOFF, xo_lat, XA + CTXOFF, modL + 5 * DM, (float*)(ws + WS_SLAB)};
            _Pragma("unroll") for (int rep_ = 0; rep_ < REPN(MK_RB_DOWN); ++rep_)
            pg8::gemm_phase<pg8::EpiResT<RES32, (L == DEPTH - 1) || RES32>, pg8::SplitOrder, true, true>(F.lds + RING_OFF, g, S, E, wv_);
            TP_PRE();
            SEAM(base + 7);
            TP_END();
        }
        if (IN(base + 8)) { STAMP(base + 8); FRAME(); WSPTRS();
            constexpr int npan = (rows + 253) / 254, pan0 = 33, pan1 = npan;
            pg8::Gemm g{H - DM, (const bf16*)(ws + WS_WUP) + (size_t)L * FFN2 * DM, npan * 256, FFN2, DM, 254, nullptr, nullptr, 0}; pg8::StaticOrder S; S.init((pan1 - pan0) * 256, FFN2, F.G, (int)blockIdx.x); S.wgm = MK_WGM_UP; S.pm0 = pan0;
            pg8::EpiAct E{ACT, INP(I_FCW) + (size_t)L * 3 * FFN2, INP(I_FCB) + (size_t)L * FFN2, rows, (PG8_LAS float*)(F.lds + HALO_OFF), FFN_LD};
            _Pragma("unroll") for (int rep_ = 0; rep_ < REPN(MK_RB_UP); ++rep_)
            pg8::gemm_phase<pg8::EpiAct, pg8::StaticOrder, true, true>(F.lds + RING_OFF, g, S, E, wv_);
#if MK_DEFER_CONVERT
            if (L + 1 < DEPTH) { int rk, ni; idle_rank((pan1 - pan0) * (FFN2 / 256), F.G, (int)blockIdx.x, rk, ni);
                if (rk >= 0) convert_layer<(L + 1 < DEPTH ? L + 1 : 0)>(F, (MK_DS2 + MK_DS3) / 2, MK_DS3, rk * NWAVES + F.wave, ni * NWAVES); }
#endif
            SEAM(base + 8);
        }
        if (IN(base + 9)) { STAMP(base + 9); FRAME(); WSPTRS();
            pg8::Gemm g{ACT, (const bf16*)(ws + WS_WDN) + (size_t)L * DM * FFN_LD, rows, DM, FFN, 256, nullptr, nullptr, FFN_LD}; pg8::SplitOrder S; S.init(DM, FFN, 8, !last, F.G, (int)blockIdx.x, 32, 32); S.lat.wgm = MK_WGM_DOWN;
            void* xo_lat = last ? (void*)OUTP() : (void*)XA;
            pg8::EpiResT<RES32, (L == DEPTH - 1) || RES32> E{XB, XB + CTXOFF, xo_lat, XA + CTXOFF, modL + 5 * DM, (float*)(ws + WS_SLAB)};
            _Pragma("unroll") for (int rep_ = 0; rep_ < REPN(MK_RB_DOWN); ++rep_)
            pg8::gemm_phase<pg8::EpiResT<RES32, (L == DEPTH - 1) || RES32>, pg8::SplitOrder, true, true>(F.lds + RING_OFF, g, S, E, wv_);
            SEAM(base + 9);
        }
#else
        if (IN(base + 6)) { STAMP(base + 6); FRAME(); WSPTRS();
            constexpr int npan = (rows + 253) / 254;
            pg8::Gemm g{H - DM, (const bf16*)(ws + WS_WUP) + (size_t)L * FFN2 * DM, npan * 256, FFN2, DM, 254, nullptr, nullptr, 0}; pg8::StaticOrder S; S.init(npan * 256, FFN2, F.G, (int)blockIdx.x); S.wgm = MK_WGM_UP;
            if (MK_ISTAG_UP > 0) { const unsigned long long d_ = (unsigned long long)(((unsigned)blockIdx.x >> 3) & (MK_ISTAG_WAYS - 1)) * MK_ISTAG_UP, t0_ = __builtin_amdgcn_s_memrealtime(); while (__builtin_amdgcn_s_memrealtime() - t0_ < d_) __builtin_amdgcn_s_sleep(4); }
            if (MK_XSTAG_UP > 0) { const unsigned long long d_ = (unsigned long long)(xb_xcc_id() & 7u) * MK_XSTAG_UP, t0_ = __builtin_amdgcn_s_memrealtime(); while (__builtin_amdgcn_s_memrealtime() - t0_ < d_) __builtin_amdgcn_s_sleep(4); }
            TP_ARM(2);
            pg8::EpiAct E{ACT, INP(I_FCW) + (size_t)L * 3 * FFN2, INP(I_FCB) + (size_t)L * FFN2, rows, (PG8_LAS float*)(F.lds + HALO_OFF), FFN_LD};
#if MK_DYN_TAIL
            S.imax = (npan * (FFN2 / 256)) / F.G;
#endif
            _Pragma("unroll") for (int rep_ = 0; rep_ < REPN(MK_RB_UP); ++rep_)
            pg8::gemm_phase<pg8::EpiAct, pg8::StaticOrder, true, true>(F.lds + RING_OFF, g, S, E, wv_);
            TP_OFF();
#if MK_DEFER_CONVERT
            if (L + 1 < DEPTH) { int rk, ni; idle_rank(npan * (FFN2 / 256), F.G, (int)blockIdx.x, rk, ni);
                if (rk >= 0) convert_layer<(L + 1 < DEPTH ? L + 1 : 0)>(F, MK_DS2, MK_DS3, rk * NWAVES + F.wave, ni * NWAVES); }
#endif
            TP_PRE();
#if MK_DYN_TAIL
            { pg8::DynOrder D{S, (unsigned*)(ws + WS_CTL) + CW_DYN + 64 * L, (PG8_LAS unsigned*)(F.lds + MISC_OFF + 4 * 90), S.imax * F.G, wv_};
              pg8::gemm_phase<pg8::EpiAct, pg8::DynOrder, true, true>(F.lds + RING_OFF, g, D, E, wv_); }
#endif
            SEAM(base + 6);
            TP_END();
        }
        if (IN(base + 7)) { STAMP(base + 7); FRAME(); WSPTRS();
            pg8::Gemm g{ACT, (const bf16*)(ws + WS_WDN) + (size_t)L * DM * FFN_LD, rows, DM, FFN, 256, nullptr, nullptr, FFN_LD}; pg8::SplitOrder S; S.init(DM, FFN, 8, !last, F.G, (int)blockIdx.x); S.rev = MK_DOWN_REV; S.lat.wgm = MK_WGM_DOWN;
            void* xo_lat = last ? (void*)OUTP() : (void*)XA;
            if (MK_STAGGER_TICKS > 0 && (blockIdx.x & 1)) { const unsigned long long t0_ = __builtin_amdgcn_s_memrealtime(); while (__builtin_amdgcn_s_memrealtime() - t0_ < (unsigned long long)MK_STAGGER_TICKS) __builtin_amdgcn_s_sleep(8); }
            TP_ARM(3);
            pg8::EpiResT<RES32, (L == DEPTH - 1) || RES32> E{XB, XB + CTXOFF, xo_lat, XA + CTXOFF, modL + 5 * DM, (float*)(ws + WS_SLAB)};
            _Pragma("unroll") for (int rep_ = 0; rep_ < REPN(MK_RB_DOWN); ++rep_)
            pg8::gemm_phase<pg8::EpiResT<RES32, (L == DEPTH - 1) || RES32>, pg8::SplitOrder, true, true>(F.lds + RING_OFF, g, S, E, wv_);
            TP_OFF();
#if MK_DEFER_CONVERT
            if (L + 1 < DEPTH) { int rk, ni; idle_rank(S.nlat + S.nctx, F.G, (int)blockIdx.x, rk, ni);
                if (rk >= 0) convert_layer<(L + 1 < DEPTH ? L + 1 : 0)>(F, MK_DS3, 256, rk * NWAVES + F.wave, ni * NWAVES); }
#endif
            TP_PRE();
            SEAM(base + 7);
            TP_END();
        }
#endif
    }
    { constexpr int L = 2;
        const int base = 1 + PH_PER_LAYER * L, mx = L % 3, jx = L / 3;
        const bool last = (L == DEPTH - 1);
        constexpr int rows = (L == DEPTH - 1) ? ML : MT;
        if (IN(base + 0)) { STAMP(base + 0); FRAME(); WSPTRS();
            const float* modP = mod + (size_t)(L > 0 ? L - 1 : 0) * 3 * NMOD;
            _Pragma("unroll") for (int rep_ = 0; rep_ < REPN(MK_RB_NORM); ++rep_) norm_mod_phase<(L == 0) || RES32, RES32, RES32>(F, xin_lat, xin_ctx, INP(I_NMG) + (size_t)L * DM, modL + 0 * DM, modL + 1 * DM, H, MT,
                L > 0 ? (const float*)(ws + WS_SLAB) : nullptr, 8, XB + CTXOFF, modP + 5 * DM, XA + CTXOFF);
            SEAM(base + 0); }
        if (IN(base + 1)) { STAMP(base + 1); FRAME(); WSPTRS();
            const bf16* Wa; int Na; bf16* Oa; bool acta; int modea = 0, modeb = 0, ldca;
            const bf16* Wb; int Mb; bf16* Ob; bool actb, statb;
            if (mx == 0) { Wa = (const bf16*)(ws + WS_WQKV) + (size_t)jx * 6144 * DM; Na = 4096; Oa = (bf16*)(BIG + BIG_QK); acta = false; modea = 1; modeb = 2;
                           Wb = Wa + (size_t)4096 * DM; Mb = 2048; Ob = (bf16*)(BIG + BIG_VT); actb = false; statb = false; }
            else if (mx == 1) { Wa = (const bf16*)(ws + WS_WGIN); Na = 4096; Oa = (bf16*)(BIG + BIG_U); acta = true;
                           Wb = Wa + (size_t)4096 * DM; Mb = 4096; Ob = (bf16*)(BIG + BIG_GVT); actb = true; statb = true; modeb = 3; }
            else { Wa = (const bf16*)(ws + WS_WCIN); Na = 6144; Oa = (bf16*)(BIG + BIG_BCX); acta = false; Wb = nullptr; Mb = 0; Ob = nullptr; actb = false; statb = false; }
            ldca = modea == 1 ? MT : Na;
            pg8::Gemm g{H, Wa, MT, Na, DM, 256, Wb, H, 0}; pg8::DualOrder S; S.init(Na, Mb, F.G, (int)blockIdx.x); S.wgm0 = MK_WGM_IN0; S.wgm1 = MK_WGM_IN1;
            if (MK_XSTAG_IN > 0) { const unsigned long long d_ = (unsigned long long)(xb_xcc_id() & 7u) * MK_XSTAG_IN, t0_ = __builtin_amdgcn_s_memrealtime(); while (__builtin_amdgcn_s_memrealtime() - t0_ < d_) __builtin_amdgcn_s_sleep(4); }
            TP_ARM(1);
            if constexpr (L % 3 == 1) {
                pg8::EpiDual E{ pg8::EpiBf16R{Oa, ldca, nullptr, acta, false, modea, (PG8_LAS float*)(F.lds + HALO_OFF), INP(I_NAQG) + jx * HD, INP(I_NAKG) + jx * HD},
                                pg8::EpiBf16R{Ob, MT, PST, actb, statb, modeb, nullptr, nullptr, nullptr} };
                _Pragma("unroll") for (int rep_ = 0; rep_ < REPN(MK_RB_GIN); ++rep_)
                pg8::gemm_phase<pg8::EpiDual, pg8::DualOrder, true, true>(F.lds + RING_OFF, g, S, E, wv_);
            } else {
                constexpr int kM0 = (L % 3 == 0) ? 1 : 0, kM1 = (L % 3 == 0) ? 2 : 0;
                typedef pg8::EpiDualT<kM0, false, false, kM1, false, false> EpiIn;
                EpiIn E{ pg8::EpiBf16T<kM0, false, false>{Oa, ldca, nullptr, (PG8_LAS float*)(F.lds + HALO_OFF), INP(I_NAQG) + jx * HD, INP(I_NAKG) + jx * HD},
                         pg8::EpiBf16T<kM1, false, false>{Ob, MT, PST, nullptr, nullptr, nullptr} };
                _Pragma("unroll") for (int rep_ = 0; rep_ < REPN(MK_RB_GIN); ++rep_)
                pg8::gemm_phase<EpiIn, pg8::DualOrder, true, true>(F.lds + RING_OFF, g, S, E, wv_);
            }
            TP_OFF();
#if MK_DEFER_CONVERT
            if (L + 1 < DEPTH) { int rk, ni; idle_rank(S.n0 + S.n1 + S.c0 + 2 * S.nM1, F.G, (int)blockIdx.x, rk, ni);
                if (rk >= 0) { if (L == 0 && MK_P0_SHARE < 256) convert_layer<0>(F, MK_P0_SHARE, 256, rk * NWAVES + F.wave, ni * NWAVES);
                               convert_layer<(L + 1 < DEPTH ? L + 1 : 0)>(F, 0, MK_DS1, rk * NWAVES + F.wave, ni * NWAVES); } }
#endif
            TP_PRE();
            SEAM(base + 1);
            TP_END();
        }
        if (IN(base + 3)) { STAMP(base + 3); FRAME(); WSPTRS();
            _Pragma("unroll") for (int rep_ = 0; rep_ < REPN(MK_RB_CORE); ++rep_) {
            if (mx == 0) attn_phase(F, (const bf16*)(BIG + BIG_QK), (const bf16*)(BIG + BIG_VT), (bf16*)(BIG + BIG_O), INP(I_NARPB) + (size_t)jx * NH * 15 * 31, !last);
            else if (mx == 1) gm_spatial_phase(F, (const bf16*)(BIG + BIG_U), (const bf16*)(BIG + BIG_GVT), (bf16*)(BIG + BIG_G), (const bf16*)(ws + WS_WGS), PST, INP(I_GMVG), INP(I_GMBS));
            else sc_conv_phase(F, (const bf16*)(BIG + BIG_BCX), (bf16*)(BIG + BIG_T), INP(I_SCCW));
            }
            SEAM(base + 3);
        }
        if (IN(base + 4)) { STAMP(base + 4); FRAME(); WSPTRS();
            const bf16* Ao; const bf16* Wo; int Ko;
            if (mx == 0) { Ao = (const bf16*)(BIG + BIG_O); Wo = (const bf16*)(ws + WS_WO) + (size_t)jx * DM * DM; Ko = DM; }
            else if (mx == 1) { Ao = (const bf16*)(BIG + BIG_G); Wo = (const bf16*)(ws + WS_WGOUT); Ko = GMW; }
            else { Ao = (const bf16*)(BIG + BIG_T); Wo = (const bf16*)(ws + WS_WCOUT); Ko = DM; }
            pg8::Gemm g{Ao, Wo, rows, DM, Ko, 256, nullptr, nullptr, 0}; pg8::SplitOrder S; S.init(DM, Ko, mx == 1 ? 8 : 4, !last, F.G, (int)blockIdx.x); S.lat.wgm = MK_WGM_OUT;
            if (MK_STAGGER_TICKS > 0 && (blockIdx.x & 1)) { const unsigned long long t0_ = __builtin_amdgcn_s_memrealtime(); while (__builtin_amdgcn_s_memrealtime() - t0_ < (unsigned long long)MK_STAGGER_TICKS) __builtin_amdgcn_s_sleep(8); }
            TP_ARM(4);
            pg8::EpiResT<(L == 0) || RES32, RES32> E{xin_lat, xin_ctx, XB, XB + CTXOFF, modL + 2 * DM, (float*)(ws + WS_SLAB)};
            _Pragma("unroll") for (int rep_ = 0; rep_ < REPN(MK_RB_GOUT); ++rep_)
            pg8::gemm_phase<pg8::EpiResT<(L == 0) || RES32, RES32>, pg8::SplitOrder, true, true>(F.lds + RING_OFF, g, S, E, wv_);
            TP_OFF();
#if MK_DEFER_CONVERT
            if (L + 1 < DEPTH) { int rk, ni; idle_rank(S.nlat + S.nctx, F.G, (int)blockIdx.x, rk, ni);
                if (rk >= 0) convert_layer<(L + 1 < DEPTH ? L + 1 : 0)>(F, MK_DS1, MK_DS2, rk * NWAVES + F.wave, ni * NWAVES); }
#endif
            TP_PRE();
            SEAM(base + 4);
            TP_END();
        }
        if (IN(base + 5)) { STAMP(base + 5); FRAME(); WSPTRS();
            _Pragma("unroll") for (int rep_ = 0; rep_ < REPN(MK_RB_NORM); ++rep_) norm_mod_phase<RES32, (L == 0) || RES32, RES32>(F, XB, XB + CTXOFF, INP(I_NFG) + (size_t)L * DM, modL + 3 * DM, modL + 4 * DM, H, rows,
                !last ? (const float*)(ws + WS_SLAB) : nullptr, mx == 1 ? 8 : 4, xin_ctx, modL + 2 * DM, XB + CTXOFF);
            SEAM(base + 5); }
#if MK_FFN_HALVES
        if (IN(base + 6)) { STAMP(base + 6); FRAME(); WSPTRS();
            constexpr int npan = (rows + 253) / 254, pan0 = 0, pan1 = 33;
            pg8::Gemm g{H - DM, (const bf16*)(ws + WS_WUP) + (size_t)L * FFN2 * DM, npan * 256, FFN2, DM, 254, nullptr, nullptr, 0}; pg8::StaticOrder S; S.init((pan1 - pan0) * 256, FFN2, F.G, (int)blockIdx.x); S.wgm = MK_WGM_UP; S.pm0 = pan0;
            pg8::EpiAct E{ACT, INP(I_FCW) + (size_t)L * 3 * FFN2, INP(I_FCB) + (size_t)L * FFN2, rows, (PG8_LAS float*)(F.lds + HALO_OFF), FFN_LD};
            _Pragma("unroll") for (int rep_ = 0; rep_ < REPN(MK_RB_UP); ++rep_)
            pg8::gemm_phase<pg8::EpiAct, pg8::StaticOrder, true, true>(F.lds + RING_OFF, g, S, E, wv_);
#if MK_DEFER_CONVERT
            if (L + 1 < DEPTH) { int rk, ni; idle_rank((pan1 - pan0) * (FFN2 / 256), F.G, (int)blockIdx.x, rk, ni);
                if (rk >= 0) convert_layer<(L + 1 < DEPTH ? L + 1 : 0)>(F, MK_DS2, (MK_DS2 + MK_DS3) / 2, rk * NWAVES + F.wave, ni * NWAVES); }
#endif
            TP_PRE();
            SEAM(base + 6);
            TP_END();
        }
        if (IN(base + 7)) { STAMP(base + 7); FRAME(); WSPTRS();
            pg8::Gemm g{ACT, (const bf16*)(ws + WS_WDN) + (size_t)L * DM * FFN_LD, rows, DM, FFN, 256, nullptr, nullptr, FFN_LD}; pg8::SplitOrder S; S.init(DM, FFN, 8, false, F.G, (int)blockIdx.x, 32, 0); S.lat.wgm = MK_WGM_DOWN;
            void* xo_lat = last ? (void*)OUTP() : (void*)XA;
            pg8::EpiResT<RES32, (L == DEPTH - 1) || RES32> E{XB, XB + CTXOFF, xo_lat, XA + CTXOFF, modL + 5 * DM, (float*)(ws + WS_SLAB)};
            _Pragma("unroll") for (int rep_ = 0; rep_ < REPN(MK_RB_DOWN); ++rep_)
            pg8::gemm_phase<pg8::EpiResT<RES32, (L == DEPTH - 1) || RES32>, pg8::SplitOrder, true, true>(F.lds + RING_OFF, g, S, E, wv_);
            TP_PRE();
            SEAM(base + 7);
            TP_END();
        }
        if (IN(base + 8)) { STAMP(base + 8); FRAME(); WSPTRS();
            constexpr int npan = (rows + 253) / 254, pan0 = 33, pan1 = npan;
            pg8::Gemm g{H - DM, (const bf16*)(ws + WS_WUP) + (size_t)L * FFN2 * DM, npan * 256, FFN2, DM, 254, nullptr, nullptr, 0}; pg8::StaticOrder S; S.init((pan1 - pan0) * 256, FFN2, F.G, (int)blockIdx.x); S.wgm = MK_WGM_UP; S.pm0 = pan0;
            pg8::EpiAct E{ACT, INP(I_FCW) + (size_t)L * 3 * FFN2, INP(I_FCB) + (size_t)L * FFN2, rows, (PG8_LAS float*)(F.lds + HALO_OFF), FFN_LD};
            _Pragma("unroll") for (int rep_ = 0; rep_ < REPN(MK_RB_UP); ++rep_)
            pg8::gemm_phase<pg8::EpiAct, pg8::StaticOrder, true, true>(F.lds + RING_OFF, g, S, E, wv_);
#if MK_DEFER_CONVERT
            if (L + 1 < DEPTH) { int rk, ni; idle_rank((pan1 - pan0) * (FFN2 / 256), F.G, (int)blockIdx.x, rk, ni);
                if (rk >= 0) convert_layer<(L + 1 < DEPTH ? L + 1 : 0)>(F, (MK_DS2 + MK_DS3) / 2, MK_DS3, rk * NWAVES + F.wave, ni * NWAVES); }
#endif
            SEAM(base + 8);
        }
        if (IN(base + 9)) { STAMP(base + 9); FRAME(); WSPTRS();
            pg8::Gemm g{ACT, (const bf16*)(ws + WS_WDN) + (size_t)L * DM * FFN_LD, rows, DM, FFN, 256, nullptr, nullptr, FFN_LD}; pg8::SplitOrder S; S.init(DM, FFN, 8, !last, F.G, (int)blockIdx.x, 32, 32); S.lat.wgm = MK_WGM_DOWN;
            void* xo_lat = last ? (void*)OUTP() : (void*)XA;
            pg8::EpiResT<RES32, (L == DEPTH - 1) || RES32> E{XB, XB + CTXOFF, xo_lat, XA + CTXOFF, modL + 5 * DM, (float*)(ws + WS_SLAB)};
            _Pragma("unroll") for (int rep_ = 0; rep_ < REPN(MK_RB_DOWN); ++rep_)
            pg8::gemm_phase<pg8::EpiResT<RES32, (L == DEPTH - 1) || RES32>, pg8::SplitOrder, true, true>(F.lds + RING_OFF, g, S, E, wv_);
            SEAM(base + 9);
        }
#else
        if (IN(base + 6)) { STAMP(base + 6); FRAME(); WSPTRS();
            constexpr int npan = (rows + 253) / 254;
            pg8::Gemm g{H - DM, (const bf16*)(ws + WS_WUP) + (size_t)L * FFN2 * DM, npan * 256, FFN2, DM, 254, nullptr, nullptr, 0}; pg8::StaticOrder S; S.init(npan * 256, FFN2, F.G, (int)blockIdx.x); S.wgm = MK_WGM_UP;
            if (MK_ISTAG_UP > 0) { const unsigned long long d_ = (unsigned long long)(((unsigned)blockIdx.x >> 3) & (MK_ISTAG_WAYS - 1)) * MK_ISTAG_UP, t0_ = __builtin_amdgcn_s_memrealtime(); while (__builtin_amdgcn_s_memrealtime() - t0_ < d_) __builtin_amdgcn_s_sleep(4); }
            if (MK_XSTAG_UP > 0) { const unsigned long long d_ = (unsigned long long)(xb_xcc_id() & 7u) * MK_XSTAG_UP, t0_ = __builtin_amdgcn_s_memrealtime(); while (__builtin_amdgcn_s_memrealtime() - t0_ < d_) __builtin_amdgcn_s_sleep(4); }
            TP_ARM(2);
            pg8::EpiAct E{ACT, INP(I_FCW) + (size_t)L * 3 * FFN2, INP(I_FCB) + (size_t)L * FFN2, rows, (PG8_LAS float*)(F.lds + HALO_OFF), FFN_LD};
#if MK_DYN_TAIL
            S.imax = (npan * (FFN2 / 256)) / F.G;
#endif
            _Pragma("unroll") for (int rep_ = 0; rep_ < REPN(MK_RB_UP); ++rep_)
            pg8::gemm_phase<pg8::EpiAct, pg8::StaticOrder, true, true>(F.lds + RING_OFF, g, S, E, wv_);
            TP_OFF();
#if MK_DEFER_CONVERT
            if (L + 1 < DEPTH) { int rk, ni; idle_rank(npan * (FFN2 / 256), F.G, (int)blockIdx.x, rk, ni);
                if (rk >= 0) convert_layer<(L + 1 < DEPTH ? L + 1 : 0)>(F, MK_DS2, MK_DS3, rk * NWAVES + F.wave, ni * NWAVES); }
#endif
            TP_PRE();
#if MK_DYN_TAIL
            { pg8::DynOrder D{S, (unsigned*)(ws + WS_CTL) + CW_DYN + 64 * L, (PG8_LAS unsigned*)(F.lds + MISC_OFF + 4 * 90), S.imax * F.G, wv_};
              pg8::gemm_phase<pg8::EpiAct, pg8::DynOrder, true, true>(F.lds + RING_OFF, g, D, E, wv_); }
#endif
            SEAM(base + 6);
            TP_END();
        }
        if (IN(base + 7)) { STAMP(base + 7); FRAME(); WSPTRS();
            pg8::Gemm g{ACT, (const bf16*)(ws + WS_WDN) + (size_t)L * DM * FFN_LD, rows, DM, FFN, 256, nullptr, nullptr, FFN_LD}; pg8::SplitOrder S; S.init(DM, FFN, 8, !last, F.G, (int)blockIdx.x); S.rev = MK_DOWN_REV; S.lat.wgm = MK_WGM_DOWN;
            void* xo_lat = last ? (void*)OUTP() : (void*)XA;
            if (MK_STAGGER_TICKS > 0 && (blockIdx.x & 1)) { const unsigned long long t0_ = __builtin_amdgcn_s_memrealtime(); while (__builtin_amdgcn_s_memrealtime() - t0_ < (unsigned long long)MK_STAGGER_TICKS) __builtin_amdgcn_s_sleep(8); }
            TP_ARM(3);
            pg8::EpiResT<RES32, (L == DEPTH - 1) || RES32> E{XB, XB + CTXOFF, xo_lat, XA + CTXOFF, modL + 5 * DM, (float*)(ws + WS_SLAB)};
            _Pragma("unroll") for (int rep_ = 0; rep_ < REPN(MK_RB_DOWN); ++rep_)
            pg8::gemm_phase<pg8::EpiResT<RES32, (L == DEPTH - 1) || RES32>, pg8::SplitOrder, true, true>(F.lds + RING_OFF, g, S, E, wv_);
            TP_OFF();
#if MK_DEFER_CONVERT
            if (L + 1 < DEPTH) { int rk, ni; idle_rank(S.nlat + S.nctx, F.G, (int)blockIdx.x, rk, ni);
                if (rk >= 0) convert_layer<(L + 1 < DEPTH ? L + 1 : 0)>(F, MK_DS3, 256, rk * NWAVES + F.wave, ni * NWAVES); }
#endif
            TP_PRE();
            SEAM(base + 7);
            TP_END();
        }
#endif
    }
    { constexpr int L = 3;
        const int base = 1 + PH_PER_LAYER * L, mx = L % 3, jx = L / 3;
        const bool last = (L == DEPTH - 1);
        constexpr int rows = (L == DEPTH - 1) ? ML : MT;
        if (IN(base + 0)) { STAMP(base + 0); FRAME(); WSPTRS();
            const float* modP = mod + (size_t)(L > 0 ? L - 1 : 0) * 3 * NMOD;
            _Pragma("unroll") for (int rep_ = 0; rep_ < REPN(MK_RB_NORM); ++rep_) norm_mod_phase<(L == 0) || RES32, RES32, RES32>(F, xin_lat, xin_ctx, INP(I_NMG) + (size_t)L * DM, modL + 0 * DM, modL + 1 * DM, H, MT,
                L > 0 ? (const float*)(ws + WS_SLAB) : nullptr, 8, XB + CTXOFF, modP + 5 * DM, XA + CTXOFF);
            SEAM(base + 0); }
        if (IN(base + 1)) { STAMP(base + 1); FRAME(); WSPTRS();
            const bf16* Wa; int Na; bf16* Oa; bool acta; int modea = 0, modeb = 0, ldca;
            const bf16* Wb; int Mb; bf16* Ob; bool actb, statb;
            if (mx == 0) { Wa = (const bf16*)(ws + WS_WQKV) + (size_t)jx * 6144 * DM; Na = 4096; Oa = (bf16*)(BIG + BIG_QK); acta = false; modea = 1; modeb = 2;
                           Wb = Wa + (size_t)4096 * DM; Mb = 2048; Ob = (bf16*)(BIG + BIG_VT); actb = false; statb = false; }
            else if (mx == 1) { Wa = (const bf16*)(ws + WS_WGIN); Na = 4096; Oa = (bf16*)(BIG + BIG_U); acta = true;
                           Wb = Wa + (size_t)4096 * DM; Mb = 4096; Ob = (bf16*)(BIG + BIG_GVT); actb = true; statb = true; modeb = 3; }
            else { Wa = (const bf16*)(ws + WS_WCIN); Na = 6144; Oa = (bf16*)(BIG + BIG_BCX); acta = false; Wb = nullptr; Mb = 0; Ob = nullptr; actb = false; statb = false; }
            ldca = modea == 1 ? MT : Na;
            pg8::Gemm g{H, Wa, MT, Na, DM, 256, Wb, H, 0}; pg8::DualOrder S; S.init(Na, Mb, F.G, (int)blockIdx.x); S.wgm0 = MK_WGM_IN0; S.wgm1 = MK_WGM_IN1;
            if (MK_XSTAG_IN > 0) { const unsigned long long d_ = (unsigned long long)(xb_xcc_id() & 7u) * MK_XSTAG_IN, t0_ = __builtin_amdgcn_s_memrealtime(); while (__builtin_amdgcn_s_memrealtime() - t0_ < d_) __builtin_amdgcn_s_sleep(4); }
            TP_ARM(1);
            if constexpr (L % 3 == 1) {
                pg8::EpiDual E{ pg8::EpiBf16R{Oa, ldca, nullptr, acta, false, modea, (PG8_LAS float*)(F.lds + HALO_OFF), INP(I_NAQG) + jx * HD, INP(I_NAKG) + jx * HD},
                                pg8::EpiBf16R{Ob, MT, PST, actb, statb, modeb, nullptr, nullptr, nullptr} };
                _Pragma("unroll") for (int rep_ = 0; rep_ < REPN(MK_RB_GIN); ++rep_)
                pg8::gemm_phase<pg8::EpiDual, pg8::DualOrder, true, true>(F.lds + RING_OFF, g, S, E, wv_);
            } else {
                constexpr int kM0 = (L % 3 == 0) ? 1 : 0, kM1 = (L % 3 == 0) ? 2 : 0;
                typedef pg8::EpiDualT<kM0, false, false, kM1, false, false> EpiIn;
                EpiIn E{ pg8::EpiBf16T<kM0, false, false>{Oa, ldca, nullptr, (PG8_LAS float*)(F.lds + HALO_OFF), INP(I_NAQG) + jx * HD, INP(I_NAKG) + jx * HD},
                         pg8::EpiBf16T<kM1, false, false>{Ob, MT, PST, nullptr, nullptr, nullptr} };
                _Pragma("unroll") for (int rep_ = 0; rep_ < REPN(MK_RB_GIN); ++rep_)
                pg8::gemm_phase<EpiIn, pg8::DualOrder, true, true>(F.lds + RING_OFF, g, S, E, wv_);
            }
            TP_OFF();
#if MK_DEFER_CONVERT
            if (L + 1 < DEPTH) { int rk, ni; idle_rank(S.n0 + S.n1 + S.c0 + 2 * S.nM1, F.G, (int)blockIdx.x, rk, ni);
                if (rk >= 0) { if (L == 0 && MK_P0_SHARE < 256) convert_layer<0>(F, MK_P0_SHARE, 256, rk * NWAVES + F.wave, ni * NWAVES);
                               convert_layer<(L + 1 < DEPTH ? L + 1 : 0)>(F, 0, MK_DS1, rk * NWAVES + F.wave, ni * NWAVES); } }
#endif
            TP_PRE();
            SEAM(base + 1);
            TP_END();
        }
        if (IN(base + 3)) { STAMP(base + 3); FRAME(); WSPTRS();
            _Pragma("unroll") for (int rep_ = 0; rep_ < REPN(MK_RB_CORE); ++rep_) {
            if (mx == 0) attn_phase(F, (const bf16*)(BIG + BIG_QK), (const bf16*)(BIG + BIG_VT), (bf16*)(BIG + BIG_O), INP(I_NARPB) + (size_t)jx * NH * 15 * 31, !last);
            else if (mx == 1) gm_spatial_phase(F, (const bf16*)(BIG + BIG_U), (const bf16*)(BIG + BIG_GVT), (bf16*)(BIG + BIG_G), (const bf16*)(ws + WS_WGS), PST, INP(I_GMVG), INP(I_GMBS));
            else sc_conv_phase(F, (const bf16*)(BIG + BIG_BCX), (bf16*)(BIG + BIG_T), INP(I_SCCW));
            }
            SEAM(base + 3);
        }
        if (IN(base + 4)) { STAMP(base + 4); FRAME(); WSPTRS();
            const bf16* Ao; const bf16* Wo; int Ko;
            if (mx == 0) { Ao = (const bf16*)(BIG + BIG_O); Wo = (const bf16*)(ws + WS_WO) + (size_t)jx * DM * DM; Ko = DM; }
            else if (mx == 1) { Ao = (const bf16*)(BIG + BIG_G); Wo = (const bf16*)(ws + WS_WGOUT); Ko = GMW; }
            else { Ao = (const bf16*)(BIG + BIG_T); Wo = (const bf16*)(ws + WS_WCOUT); Ko = DM; }
            pg8::Gemm g{Ao, Wo, rows, DM, Ko, 256, nullptr, nullptr, 0}; pg8::SplitOrder S; S.init(DM, Ko, mx == 1 ? 8 : 4, !last, F.G, (int)blockIdx.x); S.lat.wgm = MK_WGM_OUT;
            if (MK_STAGGER_TICKS > 0 && (blockIdx.x & 1)) { const unsigned long long t0_ = __builtin_amdgcn_s_memrealtime(); while (__builtin_amdgcn_s_memrealtime() - t0_ < (unsigned long long)MK_STAGGER_TICKS) __builtin_amdgcn_s_sleep(8); }
            TP_ARM(4);
            pg8::EpiResT<(L == 0) || RES32, RES32> E{xin_lat, xin_ctx, XB, XB + CTXOFF, modL + 2 * DM, (float*)(ws + WS_SLAB)};
            _Pragma("unroll") for (int rep_ = 0; rep_ < REPN(MK_RB_GOUT); ++rep_)
            pg8::gemm_phase<pg8::EpiResT<(L == 0) || RES32, RES32>, pg8::SplitOrder, true, true>(F.lds + RING_OFF, g, S, E, wv_);
            TP_OFF();
#if MK_DEFER_CONVERT
            if (L + 1 < DEPTH) { int rk, ni; idle_rank(S.nlat + S.nctx, F.G, (int)blockIdx.x, rk, ni);
                if (rk >= 0) convert_layer<(L + 1 < DEPTH ? L + 1 : 0)>(F, MK_DS1, MK_DS2, rk * NWAVES + F.wave, ni * NWAVES); }
#endif
            TP_PRE();
            SEAM(base + 4);
            TP_END();
        }
        if (IN(base + 5)) { STAMP(base + 5); FRAME(); WSPTRS();
            _Pragma("unroll") for (int rep_ = 0; rep_ < REPN(MK_RB_NORM); ++rep_) norm_mod_phase<RES32, (L == 0) || RES32, RES32>(F, XB, XB + CTXOFF, INP(I_NFG) + (size_t)L * DM, modL + 3 * DM, modL + 4 * DM, H, rows,
                !last ? (const float*)(ws + WS_SLAB) : nullptr, mx == 1 ? 8 : 4, xin_ctx, modL + 2 * DM, XB + CTXOFF);
            SEAM(base + 5); }
#if MK_FFN_HALVES
        if (IN(base + 6)) { STAMP(base + 6); FRAME(); WSPTRS();
            constexpr int npan = (rows + 253) / 254, pan0 = 0, pan1 = 33;
            pg8::Gemm g{H - DM, (const bf16*)(ws + WS_WUP) + (size_t)L * FFN2 * DM, npan * 256, FFN2, DM, 254, nullptr, nullptr, 0}; pg8::StaticOrder S; S.init((pan1 - pan0) * 256, FFN2, F.G, (int)blockIdx.x); S.wgm = MK_WGM_UP; S.pm0 = pan0;
            pg8::EpiAct E{ACT, INP(I_FCW) + (size_t)L * 3 * FFN2, INP(I_FCB) + (size_t)L * FFN2, rows, (PG8_LAS float*)(F.lds + HALO_OFF), FFN_LD};
            _Pragma("unroll") for (int rep_ = 0; rep_ < REPN(MK_RB_UP); ++rep_)
            pg8::gemm_phase<pg8::EpiAct, pg8::StaticOrder, true, true>(F.lds + RING_OFF, g, S, E, wv_);
#if MK_DEFER_CONVERT
            if (L + 1 < DEPTH) { int rk, ni; idle_rank((pan1 - pan0) * (FFN2 / 256), F.G, (int)blockIdx.x, rk, ni);
                if (rk >= 0) convert_layer<(L + 1 < DEPTH ? L + 1 : 0)>(F, MK_DS2, (MK_DS2 + MK_DS3) / 2, rk * NWAVES + F.wave, ni * NWAVES); }
#endif
            TP_PRE();
            SEAM(base + 6);
            TP_END();
        }
        if (IN(base + 7)) { STAMP(base + 7); FRAME(); WSPTRS();
            pg8::Gemm g{ACT, (const bf16*)(ws + WS_WDN) + (size_t)L * DM * FFN_LD, rows, DM, FFN, 256, nullptr, nullptr, FFN_LD}; pg8::SplitOrder S; S.init(DM, FFN, 8, false, F.G, (int)blockIdx.x, 32, 0); S.lat.wgm = MK_WGM_DOWN;
            void* xo_lat = last ? (void*)OUTP() : (void*)XA;
            pg8::EpiResT<RES32, (L == DEPTH - 1) || RES32> E{XB, XB + CTXOFF, xo_lat, XA + CTXOFF, modL + 5 * DM, (float*)(ws + WS_SLAB)};
            _Pragma("unroll") for (int rep_ = 0; rep_ < REPN(MK_RB_DOWN); ++rep_)
            pg8::gemm_phase<pg8::EpiResT<RES32, (L == DEPTH - 1) || RES32>, pg8::SplitOrder, true, true>(F.lds + RING_OFF, g, S, E, wv_);
            TP_PRE();
            SEAM(base + 7);
            TP_END();
        }
        if (IN(base + 8)) { STAMP(base + 8); FRAME(); WSPTRS();
            constexpr int npan = (rows + 253) / 254, pan0 = 33, pan1 = npan;
            pg8::Gemm g{H - DM, (const bf16*)(ws + WS_WUP) + (size_t)L * FFN2 * DM, npan * 256, FFN2, DM, 254, nullptr, nullptr, 0}; pg8::StaticOrder S; S.init((pan1 - pan0) * 256, FFN2, F.G, (int)blockIdx.x); S.wgm = MK_WGM_UP; S.pm0 = pan0;
            pg8::EpiAct E{ACT, INP(I_FCW) + (size_t)L * 3 * FFN2, INP(I_FCB) + (size_t)L * FFN2, rows, (PG8_LAS float*)(F.lds + HALO_OFF), FFN_LD};
            _Pragma("unroll") for (int rep_ = 0; rep_ < REPN(MK_RB_UP); ++rep_)
            pg8::gemm_phase<pg8::EpiAct, pg8::StaticOrder, true, true>(F.lds + RING_OFF, g, S, E, wv_);
#if MK_DEFER_CONVERT
            if (L + 1 < DEPTH) { int rk, ni; idle_rank((pan1 - pan0) * (FFN2 / 256), F.G, (int)blockIdx.x, rk, ni);
                if (rk >= 0) convert_layer<(L + 1 < DEPTH ? L + 1 : 0)>(F, (MK_DS2 + MK_DS3) / 2, MK_DS3, rk * NWAVES + F.wave, ni * NWAVES); }
#endif
            SEAM(base + 8);
        }
        if (IN(base + 9)) { STAMP(base + 9); FRAME(); WSPTRS();
            pg8::Gemm g{ACT, (const bf16*)(ws + WS_WDN) + (size_t)L * DM * FFN_LD, rows, DM, FFN, 256, nullptr, nullptr, FFN_LD}; pg8::SplitOrder S; S.init(DM, FFN, 8, !last, F.G, (int)blockIdx.x, 32, 32); S.lat.wgm = MK_WGM_DOWN;
            void* xo_lat = last ? (void*)OUTP() : (void*)XA;
            pg8::EpiResT<RES32, (L == DEPTH - 1) || RES32> E{XB, XB + CTXOFF, xo_lat, XA + CTXOFF, modL + 5 * DM, (float*)(ws + WS_SLAB)};
            _Pragma("unroll") for (int rep_ = 0; rep_ < REPN(MK_RB_DOWN); ++rep_)
            pg8::gemm_phase<pg8::EpiResT<RES32, (L == DEPTH - 1) || RES32>, pg8::SplitOrder, true, true>(F.lds + RING_OFF, g, S, E, wv_);
            SEAM(base + 9);
        }
#else
        if (IN(base + 6)) { STAMP(base + 6); FRAME(); WSPTRS();
            constexpr int npan = (rows + 253) / 254;
            pg8::Gemm g{H - DM, (const bf16*)(ws + WS_WUP) + (size_t)L * FFN2 * DM, npan * 256, FFN2, DM, 254, nullptr, nullptr, 0}; pg8::StaticOrder S; S.init(npan * 256, FFN2, F.G, (int)blockIdx.x); S.wgm = MK_WGM_UP;
            if (MK_ISTAG_UP > 0) { const unsigned long long d_ = (unsigned long long)(((unsigned)blockIdx.x >> 3) & (MK_ISTAG_WAYS - 1)) * MK_ISTAG_UP, t0_ = __builtin_amdgcn_s_memrealtime(); while (__builtin_amdgcn_s_memrealtime() - t0_ < d_) __builtin_amdgcn_s_sleep(4); }
            if (MK_XSTAG_UP > 0) { const unsigned long long d_ = (unsigned long long)(xb_xcc_id() & 7u) * MK_XSTAG_UP, t0_ = __builtin_amdgcn_s_memrealtime(); while (__builtin_amdgcn_s_memrealtime() - t0_ < d_) __builtin_amdgcn_s_sleep(4); }
            TP_ARM(2);
            pg8::EpiAct E{ACT, INP(I_FCW) + (size_t)L * 3 * FFN2, INP(I_FCB) + (size_t)L * FFN2, rows, (PG8_LAS float*)(F.lds + HALO_OFF), FFN_LD};
#if MK_DYN_TAIL
            S.imax = (npan * (FFN2 / 256)) / F.G;
#endif
            _Pragma("unroll") for (int rep_ = 0; rep_ < REPN(MK_RB_UP); ++rep_)
            pg8::gemm_phase<pg8::EpiAct, pg8::StaticOrder, true, true>(F.lds + RING_OFF, g, S, E, wv_);
            TP_OFF();
#if MK_DEFER_CONVERT
            if (L + 1 < DEPTH) { int rk, ni; idle_rank(npan * (FFN2 / 256), F.G, (int)blockIdx.x, rk, ni);
                if (rk >= 0) convert_layer<(L + 1 < DEPTH ? L + 1 : 0)>(F, MK_DS2, MK_DS3, rk * NWAVES + F.wave, ni * NWAVES); }
#endif
            TP_PRE();
#if MK_DYN_TAIL
            { pg8::DynOrder D{S, (unsigned*)(ws + WS_CTL) + CW_DYN + 64 * L, (PG8_LAS unsigned*)(F.lds + MISC_OFF + 4 * 90), S.imax * F.G, wv_};
              pg8::gemm_phase<pg8::EpiAct, pg8::DynOrder, true, true>(F.lds + RING_OFF, g, D, E, wv_); }
#endif
            SEAM(base + 6);
            TP_END();
        }
        if (IN(base + 7)) { STAMP(base + 7); FRAME(); WSPTRS();
            pg8::Gemm g{ACT, (const bf16*)(ws + WS_WDN) + (size_t)L * DM * FFN_LD, rows, DM, FFN, 256, nullptr, nullptr, FFN_LD}; pg8::SplitOrder S; S.init(DM, FFN, 8, !last, F.G, (int)blockIdx.x); S.rev = MK_DOWN_REV; S.lat.wgm = MK_WGM_DOWN;
            void* xo_lat = last ? (void*)OUTP() : (void*)XA;
            if (MK_STAGGER_TICKS > 0 && (blockIdx.x & 1)) { const unsigned long long t0_ = __builtin_amdgcn_s_memrealtime(); while (__builtin_amdgcn_s_memrealtime() - t0_ < (unsigned long long)MK_STAGGER_TICKS) __builtin_amdgcn_s_sleep(8); }
            TP_ARM(3);
            pg8::EpiResT<RES32, (L == DEPTH - 1) || RES32> E{XB, XB + CTXOFF, xo_lat, XA + CTXOFF, modL + 5 * DM, (float*)(ws + WS_SLAB)};
            _Pragma("unroll") for (int rep_ = 0; rep_ < REPN(MK_RB_DOWN); ++rep_)
            pg8::gemm_phase<pg8::EpiResT<RES32, (L == DEPTH - 1) || RES32>, pg8::SplitOrder, true, true>(F.lds + RING_OFF, g, S, E, wv_);
            TP_OFF();
#if MK_DEFER_CONVERT
            if (L + 1 < DEPTH) { int rk, ni; idle_rank(S.nlat + S.nctx, F.G, (int)blockIdx.x, rk, ni);
                if (rk >= 0) convert_layer<(L + 1 < DEPTH ? L + 1 : 0)>(F, MK_DS3, 256, rk * NWAVES + F.wave, ni * NWAVES); }
#endif
            TP_PRE();
            SEAM(base + 7);
            TP_END();
        }
#endif
    }
#if MK_STAMP
    { XcdBarrier bar_; bar_.bar = (unsigned*)(WSP() + WS_CTL) + CW_BAR; bar_.x = xb_xcc_id(); bar_.st = (volatile LAS unsigned*)((LAS unsigned char*)lds + MISC_OFF) + 8; xcd_barrier(bar_); }
    STAMP(NPHASES);
    if (blockIdx.x == 0 && threadIdx.x == 0) {
        const unsigned long long* st = (const unsigned long long*)(WSP() + WS_CTL + 4 * CW_STAMP); unsigned long long tot = 0;
        for (int k = 0; k < NPHASES; ++k) { const int j = k == 0 ? -1 : (k - 1) % PH_PER_LAYER, L = k == 0 ? -1 : (k - 1) / PH_PER_LAYER; int cat;
            if (k == 0) cat = 0; else if (j == 0 || j == 5) cat = 1; else if (j == 1) cat = 2; else if (j == 2) cat = -5; else if (j == 3) cat = (L % 3 == 0) ? 4 : (L % 3 == 1 ? 5 : 6); else if (j == 4) cat = 7; else if (j == 6) cat = 8; else if (j == 7) cat = 9; else cat = 10;
            if (cat == MK_STAMP_SEL || (MK_STAMP_SEL == 11 && (cat == 2 || cat == 7 || cat == 8 || cat == 10)) || (MK_STAMP_SEL == 12 && (cat == 1 || cat == 3 || cat == 9))) tot += (j == 1 ? st[k + 2] : st[k + 1]) - st[k]; }
        { const unsigned long long t0_ = __builtin_amdgcn_s_memrealtime(); while (__builtin_amdgcn_s_memrealtime() - t0_ < tot * MK_STAMP_MUL) __builtin_amdgcn_s_sleep(16); }
    }
#endif
#if MK_TPROBE
    if ((int)blockIdx.x == MK_TPROBE_B && wv_ == 0) { volatile LAS unsigned* ms_ = (volatile LAS unsigned*)((LAS unsigned char*)lds + MISC_OFF);
        const unsigned d_ = ms_[104 + MK_TPROBE_HI] - ms_[104 + MK_TPROBE_LO]; unsigned long long w_ = (unsigned long long)d_ * (unsigned long long)MK_TPROBE_MUL; if (w_ > 3000000ull) w_ = 3000000ull; const unsigned long long t0_ = __builtin_amdgcn_s_memrealtime();
        while (__builtin_amdgcn_s_memrealtime() - t0_ < w_) __builtin_amdgcn_s_sleep(16); }
#endif
#undef IN
#undef SEAM
}

extern "C" void kernel_launch(void* const* d_in, const int* in_sizes, int n_in, void* d_out, int out_size, void* d_ws, size_t ws_size, hipStream_t stream) {
    static int grid = 0;
    if (grid == 0) {
        if (n_in != N_IN || in_sizes[0] != ML * DM || out_size != ML * DM || ws_size < WS_END) {
            fprintf(stderr, "kernel_launch: unexpected problem: n_in %d in0 %d out %d ws %zu (need %zu); nothing launched\n", n_in, n_in > 0 ? in_sizes[0] : -1, out_size, ws_size, (size_t)WS_END); grid = -1; return; }
        int dev = 0, cus = 0, per_cu = 0;
        if (hipGetDevice(&dev) != hipSuccess || hipDeviceGetAttribute(&cus, hipDeviceAttributeMultiprocessorCount, dev) != hipSuccess) { grid = -1; return; }
        if (hipFuncSetAttribute((const void*)mk_fwd, hipFuncAttributeMaxDynamicSharedMemorySize, LDS_BYTES) != hipSuccess) { fprintf(stderr, "kernel_launch: hipFuncSetAttribute failed\n"); grid = -1; return; }
        if (hipOccupancyMaxActiveBlocksPerMultiprocessor(&per_cu, (const void*)mk_fwd, NWAVES * 64, LDS_BYTES) != hipSuccess || per_cu < 1) { fprintf(stderr, "kernel_launch: occupancy query says %d blocks per CU\n", per_cu); }
        (void)hipGetLastError();
        grid = cus;
    }
    if (grid < 0) return;
    if (hipMemsetAsync((char*)d_ws + WS_CTL, 0, CTL_ZERO_BYTES, stream) != hipSuccess) return;
    Args a{};
    for (int i = 0; i < N_IN; ++i) a.in[i] = (const float*)d_in[i];
    a.out = (float*)d_out; a.ws = (unsigned char*)d_ws;
    a.ph_lo = 0; a.ph_hi = NPHASES;
    hipLaunchKernelGGL(mk_fwd, dim3(grid), dim3(NWAVES * 64), LDS_BYTES, stream, a);
    const hipError_t le = hipPeekAtLastError();
    if (le != hipSuccess) fprintf(stderr, "kernel_launch: launch failed: %s\n", hipGetErrorName(le));
}
```
